# Optimizing an MI355X kernel written in HIP

```python
import jax, jax.numpy as jnp
from jax import lax
import numpy as np

D_MODEL = 1024
BATCH = 2
SEQ = 16384
DEPTH = 4

MEM_LEN = 256
MIX_WIDTH = D_MODEL
D_FF = ((8 * D_MODEL // 3 + 255) // 256) * 256
XATTN_HEADS = 4
XATTN_HEAD_DIM = D_MODEL // XATTN_HEADS
POOL_WINDOWS = (2, 4, 8, 16)
POOL_GROUPS = 4
POOL_WIDTH = MIX_WIDTH // 2
POOL_GROUP_DIM = POOL_WIDTH // POOL_GROUPS
SGU_WIDTH = MIX_WIDTH // 2
SGU_HEADS = 4
SGU_CHUNK = 128
EVEN_IN = POOL_WIDTH + 2 * SGU_WIDTH
RWKV_WIDTH = MIX_WIDTH // 2
RWKV_HEAD_DIM = 64
RWKV_HEADS = RWKV_WIDTH // RWKV_HEAD_DIM
DECAY_RANK = 64
A_RANK = 64
GATE_RANK = 128
RWKV_IN = 3 * RWKV_WIDTH + DECAY_RANK + A_RANK + GATE_RANK
RWKV_GN_EPS = 64e-5
LRU_WIDTH = MIX_WIDTH // 2
LRU_BLOCKS = 8
LRU_BLOCK_DIM = LRU_WIDTH // LRU_BLOCKS
LRU_C = 8.0
CONV_WIDTH = 4
ODD_IN = RWKV_IN + 2 * LRU_WIDTH

N_EVEN = (DEPTH + 1) // 2
N_ODD = DEPTH // 2
LN_EPS = 1e-5
DEEPNORM_ALPHA = (2 * DEPTH) ** 0.25
DEEPNORM_BETA = (8 * DEPTH) ** -0.25
MACARON_WEIGHT = 0.5

kernel_name = "hybrid_pool_sgu_rwkv7_rglru_macaron_deepnorm"


def layer_norm(x, g, b, eps=LN_EPS):
    xf = x.astype(jnp.float32)
    mu = jnp.mean(xf, -1, keepdims=True)
    var = jnp.mean(jnp.square(xf - mu), -1, keepdims=True)
    return ((xf - mu) * lax.rsqrt(var + eps)).astype(x.dtype) * g + b


def shift_right(y):
    return jnp.pad(y[:, :-1], ((0, 0), (1, 0), (0, 0)))


def swiglu_ffn(x, w_in, w_out):
    gate, up = jnp.split(x @ w_in, 2, axis=-1)
    return (jax.nn.silu(gate) * up) @ w_out


def multiscale_pool(xa, pool_w, pool_scale):
    B, S, _ = xa.shape
    xg = xa.reshape(B, S, POOL_GROUPS, POOL_GROUP_DIM)
    csum = jnp.cumsum(xg.astype(jnp.float32), axis=1)
    pos = jnp.arange(1, S + 1, dtype=jnp.float32)[None, :, None]
    means = []
    for g, win in enumerate(POOL_WINDOWS):
        c = csum[:, :, g]
        lagged = jnp.pad(c[:, :-win], ((0, 0), (win, 0), (0, 0)))
        means.append((c - lagged) / jnp.minimum(pos, win))
    pooled = jnp.stack(means, axis=2).astype(xa.dtype) - xg
    y = jnp.einsum('bsgc,gcd->bsgd', pooled, pool_w).reshape(B, S, POOL_WIDTH)
    return y * pool_scale


def spatial_gating(u, v, ln_g, ln_b, w_s, b_s):
    B, S, W = v.shape
    v = layer_norm(v, ln_g, ln_b)
    vc = v.reshape(B, S // SGU_CHUNK, SGU_CHUNK, SGU_HEADS, W // SGU_HEADS)
    ws = jnp.tril(w_s)
    mixed = jnp.einsum('hts,bnshd->bnthd', ws, vc) + b_s.T[None, None, :, :, None]
    return u * mixed.reshape(B, S, W)


def even_mixer(x, w_in, w_out, pool_w, pool_scale, sgu_ln_g, sgu_ln_b, sgu_w, sgu_b):
    h = x @ w_in
    xa, u, v = jnp.split(h, [POOL_WIDTH, POOL_WIDTH + SGU_WIDTH], axis=-1)
    ya = multiscale_pool(xa, pool_w, pool_scale)
    yb = spatial_gating(jax.nn.gelu(u), jax.nn.gelu(v), sgu_ln_g, sgu_ln_b, sgu_w, sgu_b)
    return jnp.concatenate([ya, yb], axis=-1) @ w_out


def rwkv7_step(state, inp):
    r, w, k, v, a, b = inp
    sa = jnp.einsum('bhij,bhj->bhi', state, a)
    state = (state * w[:, :, None, :] + sa[..., None] * b[:, :, None, :]
             + v[..., None] * k[:, :, None, :])
    return state, jnp.einsum('bhij,bhj->bhi', state, r)


def rwkv7_time_mix(r, k, v, wd, ad, gd, w0, w_up, a0, a_up, g_up, k_k, k_a, r_k, gn_g, gn_b):
    B, S, W = r.shape
    H, N = RWKV_HEADS, RWKV_HEAD_DIM
    f32 = jnp.float32
    heads = lambda t: t.reshape(B, S, H, N)
    logw = -jax.nn.softplus(-(w0 + jnp.tanh(wd) @ w_up)) - 0.5
    decay = jnp.exp(-jnp.exp(logw.astype(f32)))
    a = jax.nn.sigmoid(a0 + ad @ a_up)
    g = jax.nn.sigmoid(gd) @ g_up
    kk = heads(k * k_k).astype(f32)
    kk = kk * lax.rsqrt(jnp.maximum(jnp.sum(kk * kk, -1, keepdims=True), 1e-24))
    k = k * (1 + (a - 1) * k_a)
    rh, kh, vh = heads(r), heads(k), heads(v)
    seq_first = lambda t: jnp.moveaxis(t.astype(f32), 1, 0)
    xs = (seq_first(rh), seq_first(heads(decay)), seq_first(kh), seq_first(vh),
          seq_first(-kk), seq_first(kk * heads(a).astype(f32)))
    state0 = jnp.zeros((B, H, N, N), f32)
    _, y = lax.scan(rwkv7_step, state0, xs)
    y = jnp.moveaxis(y, 0, 1)
    mu = jnp.mean(y, -1, keepdims=True)
    var = jnp.mean(jnp.square(y - mu), -1, keepdims=True)
    y = ((y - mu) * lax.rsqrt(var + RWKV_GN_EPS)).reshape(B, S, W).astype(r.dtype) * gn_g + gn_b
    bonus = jnp.sum(rh * kh * r_k, -1, keepdims=True) * vh
    return (y + bonus.reshape(B, S, W)) * g


def _linear_recurrence_combine(c1, c2):
    a1, b1 = c1
    a2, b2 = c2
    return a1 * a2, a2 * b1 + b2


def rglru_branch(xr, gate, conv_w, conv_b, w_a, b_a, w_x, b_x, lam):
    B, S, W = xr.shape
    f32 = jnp.float32
    xc = lax.conv_general_dilated(xr, conv_w[:, None, :], window_strides=(1,),
                                  padding=[(CONV_WIDTH - 1, 0)],
                                  dimension_numbers=('NWC', 'WIO', 'NWC'),
                                  feature_group_count=W) + conv_b
    xb = xc.reshape(B, S, LRU_BLOCKS, LRU_BLOCK_DIM)
    rec = jax.nn.sigmoid(jnp.einsum('bshi,hij->bshj', xb, w_a).reshape(B, S, W) + b_a)
    inp = jax.nn.sigmoid(jnp.einsum('bshi,hij->bshj', xb, w_x).reshape(B, S, W) + b_x)
    log_a = -LRU_C * rec.astype(f32) * jax.nn.softplus(-lam.astype(f32))
    a = jnp.exp(log_a)
    bx = jnp.sqrt(-jnp.expm1(2 * log_a)) * (inp * xc).astype(f32)
    _, h = lax.associative_scan(_linear_recurrence_combine, (a, bx), axis=1)
    return h.astype(xr.dtype) * jax.nn.gelu(gate)


def odd_mixer(x, w_in, w_out, mu, w0, w_up, a0, a_up, g_up, k_k, k_a, r_k, gn_g, gn_b,
              conv_w, conv_b, w_a, b_a, w_x, b_x, lam):
    h = x @ w_in
    hc, hd = h[..., :RWKV_IN], h[..., RWKV_IN:]
    hc = hc + mu * (shift_right(hc) - hc)
    sizes = [RWKV_WIDTH, RWKV_WIDTH, RWKV_WIDTH, DECAY_RANK, A_RANK, GATE_RANK]
    r, k, v, wd, ad, gd = jnp.split(hc, np.cumsum(sizes)[:-1].tolist(), axis=-1)
    yc = rwkv7_time_mix(r, k, v, wd, ad, gd, w0, w_up, a0, a_up, g_up, k_k, k_a, r_k, gn_g, gn_b)
    gate, xr = jnp.split(hd, 2, axis=-1)
    yd = rglru_branch(xr, gate, conv_w, conv_b, w_a, b_a, w_x, b_x, lam)
    return jnp.concatenate([yc, yd], axis=-1) @ w_out


def memory_cross_attention(x, mem, w_q, w_kv, w_o):
    B, S, _ = x.shape
    M = mem.shape[1]
    q = (x @ w_q).reshape(B, S, XATTN_HEADS, XATTN_HEAD_DIM)
    k, v = jnp.split(mem @ w_kv, 2, axis=-1)
    k = k.reshape(B, M, XATTN_HEADS, XATTN_HEAD_DIM)
    v = v.reshape(B, M, XATTN_HEADS, XATTN_HEAD_DIM)
    s = jnp.einsum('bshd,bmhd->bhsm', q, k, preferred_element_type=jnp.float32) * (XATTN_HEAD_DIM ** -0.5)
    p = jax.nn.softmax(s, axis=-1).astype(x.dtype)
    o = jnp.einsum('bhsm,bmhd->bshd', p, v).reshape(B, S, D_MODEL)
    return o @ w_o


def setup_inputs(seed: int = 0) -> dict:
    key = jax.random.key(seed)
    keys = jax.random.split(key, 64)
    ks = iter([keys[i] for i in range(64)])

    def nrm(shape, scale):
        return jax.random.normal(next(ks), shape, jnp.float32) * scale

    def unif(shape, lo, hi):
        return jax.random.uniform(next(ks), shape, jnp.float32, lo, hi)

    L, E, O = DEPTH, N_EVEN, N_ODD
    D, F = D_MODEL, D_FF
    beta = DEEPNORM_BETA
    x = nrm((BATCH, SEQ, D), 1.0)
    mem = nrm((BATCH, MEM_LEN, D), 1.0)
    ffn1_w_in = nrm((L, D, 2 * F), D ** -0.5)
    ffn1_w_out = nrm((L, F, D), F ** -0.5 * beta)
    ffn2_w_in = nrm((L, D, 2 * F), D ** -0.5)
    ffn2_w_out = nrm((L, F, D), F ** -0.5 * beta)
    ln_g = 1.0 + nrm((L, 4, D), 0.02)
    ln_b = nrm((L, 4, D), 0.02)
    xattn_w_q = nrm((L, D, D), D ** -0.5)
    xattn_w_kv = jnp.concatenate([nrm((L, D, D), D ** -0.5), nrm((L, D, D), D ** -0.5 * beta)], axis=-1)
    xattn_w_o = nrm((L, D, D), D ** -0.5 * beta)
    even_w_in = nrm((E, D, EVEN_IN), D ** -0.5)
    even_w_out = nrm((E, MIX_WIDTH, D), MIX_WIDTH ** -0.5 * beta)
    pool_w = nrm((E, POOL_GROUPS, POOL_GROUP_DIM, POOL_GROUP_DIM), POOL_GROUP_DIM ** -0.5)
    pool_scale = 1.0 + nrm((E, POOL_WIDTH), 0.1)
    sgu_ln_g = 1.0 + nrm((E, SGU_WIDTH), 0.02)
    sgu_ln_b = nrm((E, SGU_WIDTH), 0.02)
    sgu_w = nrm((E, SGU_HEADS, SGU_CHUNK, SGU_CHUNK), 0.02)
    sgu_b = 1.0 + nrm((E, SGU_HEADS, SGU_CHUNK), 0.01)
    odd_w_in = nrm((O, D, ODD_IN), D ** -0.5)
    odd_w_out = nrm((O, MIX_WIDTH, D), MIX_WIDTH ** -0.5 * beta)
    rwkv_mu = unif((O, RWKV_IN), 0.0, 1.0)
    rwkv_w0 = unif((O, RWKV_WIDTH), -6.0, -1.0)
    rwkv_w_up = nrm((O, DECAY_RANK, RWKV_WIDTH), 0.1 * DECAY_RANK ** -0.5)
    rwkv_a0 = nrm((O, RWKV_WIDTH), 0.1)
    rwkv_a_up = nrm((O, A_RANK, RWKV_WIDTH), 0.1 * A_RANK ** -0.5)
    rwkv_g_up = nrm((O, GATE_RANK, RWKV_WIDTH), GATE_RANK ** -0.5)
    rwkv_k_k = 0.85 + nrm((O, RWKV_WIDTH), 0.02)
    rwkv_k_a = 1.0 + nrm((O, RWKV_WIDTH), 0.02)
    rwkv_r_k = nrm((O, RWKV_HEADS, RWKV_HEAD_DIM), 0.1)
    rwkv_gn_g = 1.0 + nrm((O, RWKV_WIDTH), 0.02)
    rwkv_gn_b = nrm((O, RWKV_WIDTH), 0.02)
    lru_conv_w = nrm((O, CONV_WIDTH, LRU_WIDTH), CONV_WIDTH ** -0.5)
    lru_conv_b = nrm((O, LRU_WIDTH), 0.02)
    lru_w_a = nrm((O, LRU_BLOCKS, LRU_BLOCK_DIM, LRU_BLOCK_DIM), LRU_BLOCK_DIM ** -0.5)
    lru_b_a = nrm((O, LRU_WIDTH), 0.02)
    lru_w_x = nrm((O, LRU_BLOCKS, LRU_BLOCK_DIM, LRU_BLOCK_DIM), LRU_BLOCK_DIM ** -0.5)
    lru_b_x = nrm((O, LRU_WIDTH), 0.02)
    a_pow_c = unif((O, LRU_WIDTH), 0.9, 0.999)
    lru_lambda = -jnp.log(jnp.expm1(-jnp.log(a_pow_c) / LRU_C))
    return {
        "x": x, "mem": mem,
        "ffn1_w_in": ffn1_w_in, "ffn1_w_out": ffn1_w_out,
        "ffn2_w_in": ffn2_w_in, "ffn2_w_out": ffn2_w_out,
        "ln_g": ln_g, "ln_b": ln_b,
        "xattn_w_q": xattn_w_q, "xattn_w_kv": xattn_w_kv, "xattn_w_o": xattn_w_o,
        "even_w_in": even_w_in, "even_w_out": even_w_out,
        "pool_w": pool_w, "pool_scale": pool_scale,
        "sgu_ln_g": sgu_ln_g, "sgu_ln_b": sgu_ln_b, "sgu_w": sgu_w, "sgu_b": sgu_b,
        "odd_w_in": odd_w_in, "odd_w_out": odd_w_out,
        "rwkv_mu": rwkv_mu, "rwkv_w0": rwkv_w0, "rwkv_w_up": rwkv_w_up,
        "rwkv_a0": rwkv_a0, "rwkv_a_up": rwkv_a_up, "rwkv_g_up": rwkv_g_up,
        "rwkv_k_k": rwkv_k_k, "rwkv_k_a": rwkv_k_a, "rwkv_r_k": rwkv_r_k,
        "rwkv_gn_g": rwkv_gn_g, "rwkv_gn_b": rwkv_gn_b,
        "lru_conv_w": lru_conv_w, "lru_conv_b": lru_conv_b,
        "lru_w_a": lru_w_a, "lru_b_a": lru_b_a, "lru_w_x": lru_w_x, "lru_b_x": lru_b_x,
        "lru_lambda": lru_lambda,
    }


def reference(x, mem, ffn1_w_in, ffn1_w_out, ffn2_w_in, ffn2_w_out, ln_g, ln_b,
              xattn_w_q, xattn_w_kv, xattn_w_o, even_w_in, even_w_out, pool_w, pool_scale,
              sgu_ln_g, sgu_ln_b, sgu_w, sgu_b, odd_w_in, odd_w_out, rwkv_mu, rwkv_w0,
              rwkv_w_up, rwkv_a0, rwkv_a_up, rwkv_g_up, rwkv_k_k, rwkv_k_a, rwkv_r_k,
              rwkv_gn_g, rwkv_gn_b, lru_conv_w, lru_conv_b, lru_w_a, lru_b_a, lru_w_x,
              lru_b_x, lru_lambda):
    def post_norm(h, sub, l, j):
        return layer_norm(DEEPNORM_ALPHA * h + sub, ln_g[l, j], ln_b[l, j])

    for l in range(DEPTH):
        x = post_norm(x, MACARON_WEIGHT * swiglu_ffn(x, ffn1_w_in[l], ffn1_w_out[l]), l, 0)
        e = l // 2
        if l % 2 == 0:
            mix = even_mixer(x, even_w_in[e], even_w_out[e], pool_w[e], pool_scale[e],
                             sgu_ln_g[e], sgu_ln_b[e], sgu_w[e], sgu_b[e])
        else:
            mix = odd_mixer(x, odd_w_in[e], odd_w_out[e], rwkv_mu[e], rwkv_w0[e], rwkv_w_up[e],
                            rwkv_a0[e], rwkv_a_up[e], rwkv_g_up[e], rwkv_k_k[e], rwkv_k_a[e],
                            rwkv_r_k[e], rwkv_gn_g[e], rwkv_gn_b[e], lru_conv_w[e], lru_conv_b[e],
                            lru_w_a[e], lru_b_a[e], lru_w_x[e], lru_b_x[e], lru_lambda[e])
        x = post_norm(x, mix, l, 1)
        x = post_norm(x, memory_cross_attention(x, mem, xattn_w_q[l], xattn_w_kv[l], xattn_w_o[l]), l, 2)
        x = post_norm(x, MACARON_WEIGHT * swiglu_ffn(x, ffn2_w_in[l], ffn2_w_out[l]), l, 3)
    return x
```

```cpp
#include <hip/hip_runtime.h>
#include <hip/hip_cooperative_groups.h>
#include <cstdio>
namespace cg = cooperative_groups;
namespace pg8 {
#define PG8_LAS __attribute__((address_space(3)))
typedef unsigned short bf16_t;
typedef short bf16x8 __attribute__((ext_vector_type(8)));
typedef float f32x4 __attribute__((ext_vector_type(4)));
typedef unsigned u32x4 __attribute__((ext_vector_type(4)));
typedef unsigned u32x2 __attribute__((ext_vector_type(2)));
constexpr int BM = 256, BK = 64, HALF = 128, HTB = HALF * BK * 2  , STAGE_BYTES = 8 * HTB, NXCD = 8, WGM = 8;

__host__ __device__ __forceinline__ int lds_byte(int r, int c) { const int st = (r >> 4) * 2 + (c >> 5), rr = r & 15, cc = c & 31, ob = rr * 64 + cc * 2; return st * 1024 + (ob ^ (((ob >> 9) & 1) << 5)); }
__host__ __device__ __forceinline__ void stage_rc(int b, int& R, int& C) { const int st = b / 1024, sb = b % 1024, swz = sb ^ (((sb >> 9) & 1) << 5); R = (st >> 1) * 16 + swz / 64; C = (st & 1) * 32 + (swz % 64) / 2; }
__host__ __device__ __forceinline__ int perm32(int rho) { const int n = rho >> 4, i = rho & 15; return 8 * (i >> 2) + 4 * n + (i & 3); }

struct Unit { int pm, pn; };
struct Gemm { const bf16_t* A; const bf16_t* Bt; int M, N, K; };

struct StaticOrder {
    int nM, nN, nwg, G, c;
    __host__ __device__ void init(int M, int N, int G_, int c_) { nM = M / BM; nN = N / BM; nwg = nM * nN; G = G_; c = c_; }
    __host__ __device__ bool next(int i, Unit& u) const {
        const long L = (long)i * G + c; if (L >= nwg) return false;
        int wgid = (int)L; { const int q = nwg / NXCD, r = nwg % NXCD, xcd = wgid % NXCD, off = wgid / NXCD; wgid = (xcd < r ? xcd * (q + 1) : r * (q + 1) + (xcd - r) * q) + off; }
        const int nig = WGM * nN, gid = wgid / nig, fm = gid * WGM, gsz = (nM - fm) < WGM ? (nM - fm) : WGM;
        u.pm = fm + ((wgid % nig) % gsz); u.pn = (wgid % nig) / gsz; return true;
    }
    __device__ __forceinline__ void a_ready(const Unit&) const {}
    __device__ __forceinline__ void done(const Unit&) const {}
};
__device__ __forceinline__ unsigned cvt_pk_bf16(float lo, float hi) { unsigned r; asm volatile("v_cvt_pk_bf16_f32 %0, %1, %2" : "=v"(r) : "v"(lo), "v"(hi)); return r; }

template <class Epi, class Sched>
__device__ __forceinline__ void gemm_phase(PG8_LAS unsigned char* lds, const Gemm g, const Sched& S, const Epi& E) {
    int tid_ = threadIdx.x; asm volatile("" : "+v"(tid_));
    const int tid = tid_, wid = __builtin_amdgcn_readfirstlane(tid >> 6), lane = tid & 63, wr = wid >> 2, wc = wid & 3, fr = lane & 15, fq = lane >> 4;
    const int K = g.K, nt = K / BK;
    unsigned voffA[2], voffB[2];
#pragma unroll
    for (int i = 0; i < 2; ++i) { int R, C; stage_rc(tid * 16 + i * 8192, R, C); const int Rb = Epi::PERM ? ((R & ~31) + perm32(R & 31)) : R;
        voffA[i] = (unsigned)(R * K + C) * 2u; voffB[i] = (unsigned)(Rb * K + C) * 2u; }
    const size_t kstep = (size_t)(BK * 2);
    const size_t hstep = (size_t)HALF * K * 2;
    const size_t tstep = 2 * hstep;
    const unsigned ldsw = (unsigned)wid * 1024u;
    const int aoff = lds_byte(wr * 64 + fr, fq * 8), boff = lds_byte(wc * 32 + fr, fq * 8);
#define PG8_SA(b, h) (((b) * 2 + (h)) * HTB)
#define PG8_SB(b, h) ((4 + (b) * 2 + (h)) * HTB)
#define PG8_STAGE(bufoff, gbase, voff) do { _Pragma("unroll") for (int _i = 0; _i < 2; ++_i) \
        __builtin_amdgcn_global_load_lds((const unsigned*)((const char*)(gbase) + (voff)[_i]), (PG8_LAS unsigned*)(lds + (bufoff) + ldsw + _i * 8192), 16, 0, 0); } while (0)
#define PG8_LDA(dst, b, h) do { _Pragma("unroll") for (int m = 0; m < 4; ++m) _Pragma("unroll") for (int k = 0; k < 2; ++k) dst[m][k] = *(const PG8_LAS bf16x8*)(lds + PG8_SA(b, h) + aoff + m * 2048 + k * 1024); } while (0)
#define PG8_LDB(dst, b, h) do { _Pragma("unroll") for (int n = 0; n < 2; ++n) _Pragma("unroll") for (int k = 0; k < 2; ++k) dst[n][k] = *(const PG8_LAS bf16x8*)(lds + PG8_SB(b, h) + boff + n * 2048 + k * 1024); } while (0)
#define PG8_MMA(ai, bj, At, Bt) do { __builtin_amdgcn_s_setprio(1); _Pragma("unroll") for (int m = 0; m < 4; ++m) _Pragma("unroll") for (int n = 0; n < 2; ++n) _Pragma("unroll") for (int k = 0; k < 2; ++k) \
        acc[ai][bj][m][n] = __builtin_amdgcn_mfma_f32_16x16x32_bf16(Bt[n][k], At[m][k], acc[ai][bj][m][n], 0, 0, 0); __builtin_amdgcn_s_setprio(0); } while (0)
#define PG8_WAIT_V(n) asm volatile("s_waitcnt vmcnt(" #n ")" ::: "memory")
#define PG8_WAIT_L(n) asm volatile("s_waitcnt lgkmcnt(" #n ")" ::: "memory")
#define PG8_BAR __builtin_amdgcn_s_barrier()
#define PG8_SCHED __builtin_amdgcn_sched_barrier(0)
    Unit cur, nxt; int ui = 0;
    if (!S.next(0, cur)) return;
    f32x4 acc[2][2][4][2];
#pragma unroll
    for (int a = 0; a < 2; ++a)
#pragma unroll
        for (int b = 0; b < 2; ++b)
#pragma unroll
            for (int m = 0; m < 4; ++m)
#pragma unroll
                for (int n = 0; n < 2; ++n) acc[a][b][m][n] = (f32x4){0.f, 0.f, 0.f, 0.f};
    bf16x8 At[4][2], B0[2][2], B1[2][2];
    const char* cA = (const char*)g.A + (size_t)cur.pm * tstep; const char* cB = (const char*)g.Bt + (size_t)cur.pn * tstep;
    S.a_ready(cur);
    PG8_STAGE(PG8_SB(0, 0), cB, voffB); PG8_STAGE(PG8_SA(0, 0), cA, voffA); PG8_STAGE(PG8_SB(0, 1), cB + hstep, voffB); PG8_STAGE(PG8_SA(0, 1), cA + hstep, voffA);
    if (wr == 1) PG8_BAR;
    PG8_WAIT_V(4); PG8_BAR;
    PG8_STAGE(PG8_SB(1, 0), cB + kstep, voffB); PG8_STAGE(PG8_SA(1, 0), cA + kstep, voffA); PG8_STAGE(PG8_SB(1, 1), cB + hstep + kstep, voffB);
    PG8_WAIT_V(6); PG8_BAR;
    for (;;) {
        const bool has_next = S.next(ui + 1, nxt);
        const char* nA = has_next ? (const char*)g.A + (size_t)nxt.pm * tstep : cA; const char* nB = has_next ? (const char*)g.Bt + (size_t)nxt.pn * tstep : cB;
        for (int t = 0; t < nt; t += 2) {
            const bool last = (t == nt - 2);
            const char* a1 = cA + (size_t)(t + 1) * kstep;
            const char* a2 = last ? nA : cA + (size_t)(t + 2) * kstep; const char* b2 = last ? nB : cB + (size_t)(t + 2) * kstep;
            const char* a3 = a2 + kstep; const char* b3 = b2 + kstep;
            if (last && has_next) S.a_ready(nxt);
            PG8_LDB(B0, 0, 0); PG8_SCHED; PG8_LDA(At, 0, 0); PG8_STAGE(PG8_SA(1, 1), a1 + hstep, voffA);
            PG8_WAIT_L(8); PG8_BAR; PG8_WAIT_L(0); PG8_MMA(0, 0, At, B0); PG8_BAR; PG8_SCHED;
            PG8_LDB(B1, 0, 1); PG8_STAGE(PG8_SB(0, 0), b2, voffB);
            PG8_BAR; PG8_WAIT_L(0); PG8_MMA(0, 1, At, B1); PG8_BAR;
            PG8_LDA(At, 0, 1); PG8_STAGE(PG8_SA(0, 0), a2, voffA);
            PG8_BAR; PG8_WAIT_L(0); PG8_MMA(1, 0, At, B0); PG8_BAR; PG8_SCHED;
            PG8_STAGE(PG8_SB(0, 1), b2 + hstep, voffB);
            PG8_WAIT_V(6); PG8_BAR; PG8_MMA(1, 1, At, B1); PG8_BAR;
            PG8_LDB(B0, 1, 0); PG8_SCHED; PG8_LDA(At, 1, 0); PG8_STAGE(PG8_SA(0, 1), a2 + hstep, voffA);
            PG8_WAIT_L(8); PG8_BAR; PG8_WAIT_L(0); PG8_MMA(0, 0, At, B0); PG8_BAR; PG8_SCHED;
            PG8_LDB(B1, 1, 1); PG8_STAGE(PG8_SB(1, 0), b3, voffB);
            PG8_BAR; PG8_WAIT_L(0); PG8_MMA(0, 1, At, B1); PG8_BAR;
            PG8_LDA(At, 1, 1); PG8_STAGE(PG8_SA(1, 0), a3, voffA);
            PG8_BAR; PG8_WAIT_L(0); PG8_MMA(1, 0, At, B0); PG8_BAR; PG8_SCHED;
            PG8_STAGE(PG8_SB(1, 1), b3 + hstep, voffB);
            PG8_WAIT_V(6); PG8_BAR; PG8_MMA(1, 1, At, B1); PG8_BAR;
        }
        if constexpr (!Epi::AFTER_DRAIN) { E(acc, cur, wr, wc, fr, fq); S.done(cur); }
        if (!has_next) break;
#pragma unroll
        for (int a = 0; a < 2; ++a)
#pragma unroll
            for (int b = 0; b < 2; ++b)
#pragma unroll
                for (int m = 0; m < 4; ++m)
#pragma unroll
                    for (int n = 0; n < 2; ++n) acc[a][b][m][n] = (f32x4){0.f, 0.f, 0.f, 0.f};
        cur = nxt; cA = nA; cB = nB; ++ui;
    }
    PG8_WAIT_V(0);
    if (wr == 0) PG8_BAR;
    PG8_BAR;
    if constexpr (Epi::AFTER_DRAIN) { E.fused(acc, cur, wr, wc, fr, fq, lds, wid, lane); S.done(cur); }
#undef PG8_SA
#undef PG8_SB
#undef PG8_STAGE
#undef PG8_LDA
#undef PG8_LDB
#undef PG8_MMA
#undef PG8_WAIT_V
#undef PG8_WAIT_L
#undef PG8_BAR
#undef PG8_SCHED
}
}

using pg8::bf16_t; using pg8::bf16x8; using pg8::f32x4; using pg8::u32x4; using pg8::u32x2;
#define LAS __attribute__((address_space(3)))
constexpr int NTOK = 32768, SEQ = 16384, DM = 1024, FF = 2816;
constexpr int NCH = 64;
constexpr int TCH = SEQ / NCH;
constexpr int LCH = 128;
constexpr int NLCH = SEQ / LCH;
constexpr float ALPHA = 1.681792830507429f;
constexpr int LDS_BYTES = 136 * 1024;

constexpr size_t MiB = 1024 * 1024;
constexpr size_t E_FFIN = (size_t)5632 * 1024, E_FFOUT = (size_t)1024 * 2816, E_SQ = (size_t)1024 * 1024, E_KV = (size_t)2048 * 1024, E_MIXIN = (size_t)2816 * 1024;
constexpr size_t W_FF1IN = 0, W_FF1OUT = W_FF1IN + E_FFIN, W_FF2IN = W_FF1OUT + E_FFOUT, W_FF2OUT = W_FF2IN + E_FFIN, W_Q = W_FF2OUT + E_FFOUT, W_KV = W_Q + E_SQ, W_O = W_KV + E_KV,
                 W_MIXIN = W_O + E_SQ, W_MIXOUT = W_MIXIN + E_MIXIN, W_AUX1 = W_MIXOUT + E_SQ, W_AUX2 = W_AUX1 + (size_t)1536 * 256, W_END = W_AUX2 + (size_t)1024 * 512;
constexpr size_t WS_W = 0;
constexpr size_t WS_XB = 52 * MiB;
constexpr size_t WS_H = WS_XB + 64 * MiB;
constexpr size_t WS_LO = WS_H + 176 * MiB;
constexpr size_t WS_AP = WS_LO + 96 * MiB;
constexpr size_t WS_XC = WS_AP + 16 * MiB;
constexpr size_t WS_LA = WS_XC + 32 * MiB;
constexpr size_t WS_MISC = WS_LA + 64 * MiB;
constexpr size_t WS_BAR = WS_MISC + 4 * MiB;
constexpr size_t WS_MR = WS_BAR + 1 * MiB;
constexpr size_t WS_END = WS_MR + 1 * MiB;
static_assert(W_END * 2 <= 52 * MiB, "weights");
static_assert(WS_END <= 512 * MiB, "workspace");

struct Args { const float* in[39]; float* out; unsigned char* ws; };
typedef const __attribute__((address_space(4))) Args* CArgsP;
__device__ __forceinline__ CArgsP argp() { CArgsP p = (CArgsP)__builtin_amdgcn_kernarg_segment_ptr(); asm volatile("" : "+s"(p)); return p; }

__device__ __forceinline__ float bf2f(unsigned short b) { return __uint_as_float(((unsigned)b) << 16); }
__device__ __forceinline__ float bfs2f(short b) { return __uint_as_float(((unsigned)(unsigned short)b) << 16); }
__device__ __forceinline__ unsigned short f2bf(float f) { unsigned u = __float_as_uint(f); u += 0x7FFFu + ((u >> 16) & 1u); return (unsigned short)(u >> 16); }
__device__ __forceinline__ unsigned pk2(float lo, float hi) { return pg8::cvt_pk_bf16(lo, hi); }
__device__ __forceinline__ float sigmoidf_(float x) { return __builtin_amdgcn_rcpf(1.0f + __expf(-x)); }
__device__ __forceinline__ float siluf_(float x) { return x * sigmoidf_(x); }
__device__ __forceinline__ float tanhf_(float y) { return 1.0f - 2.0f * __builtin_amdgcn_rcpf(1.0f + __expf(2.0f * y)); }
__device__ __forceinline__ float geluf_(float x) { return 0.5f * x * (1.0f + tanhf_(0.7978845608028654f * (x + 0.044715f * x * x * x))); }
__device__ __forceinline__ float softplusf_(float x) { return fmaxf(x, 0.0f) + __logf(1.0f + __expf(-fabsf(x))); }
__device__ __forceinline__ float wave_sum(float v) {
#pragma unroll
    for (int o = 1; o < 64; o <<= 1) v += __shfl_xor(v, o);
    return v;
}
__device__ __forceinline__ int otid() { int t = threadIdx.x; asm volatile("" : "+v"(t)); return t; }
#define LDS_SYNC_WAVE() asm volatile("s_waitcnt lgkmcnt(0)" ::: "memory")

typedef const f32x4 (&AccRef)[2][2][4][2];
struct EpiSwiGLU { static constexpr bool PERM = true, AFTER_DRAIN = false; bf16_t* O;
    __device__ __forceinline__ void operator()(AccRef acc, const pg8::Unit& u, int wr, int wc, int fr, int fq) const {
        const int row0 = u.pm * 256 + wr * 64 + fr, col0 = u.pn * 128 + wc * 32 + 8 * fq;
#pragma unroll
        for (int ai = 0; ai < 2; ++ai)
#pragma unroll
            for (int m = 0; m < 4; ++m) { bf16_t* rowp = O + (size_t)(row0 + ai * 128 + m * 16) * FF + col0;
                const f32x4 g0 = acc[ai][0][m][0], g1 = acc[ai][0][m][1], u0 = acc[ai][1][m][0], u1 = acc[ai][1][m][1];
                u32x4 o; o.x = pk2(siluf_(g0[0]) * u0[0], siluf_(g0[1]) * u0[1]); o.y = pk2(siluf_(g0[2]) * u0[2], siluf_(g0[3]) * u0[3]);
                o.z = pk2(siluf_(g1[0]) * u1[0], siluf_(g1[1]) * u1[1]); o.w = pk2(siluf_(g1[2]) * u1[2], siluf_(g1[3]) * u1[3]);
                *(u32x4*)rowp = o; }
    } };
struct EpiResid { static constexpr bool PERM = false, AFTER_DRAIN = false; const float* res; float* out; const float* MR; const float* g; const float* b; float scale; int first;
    __device__ __forceinline__ void operator()(AccRef acc, const pg8::Unit& u, int wr, int wc, int fr, int fq) const {
        const int row0 = u.pm * 256 + wr * 64 + fr, col0 = u.pn * 256 + wc * 32 + 4 * fq;
        f32x4 g4[2][2], b4[2][2];
#pragma unroll
        for (int bj = 0; bj < 2; ++bj)
#pragma unroll
            for (int n = 0; n < 2; ++n) { if (first) { g4[bj][n] = (f32x4){1.f, 1.f, 1.f, 1.f}; b4[bj][n] = (f32x4){0.f, 0.f, 0.f, 0.f}; } else { g4[bj][n] = *(const f32x4*)(g + col0 + bj * 128 + n * 16); b4[bj][n] = *(const f32x4*)(b + col0 + bj * 128 + n * 16); } }
#pragma unroll
        for (int ai = 0; ai < 2; ++ai)
#pragma unroll
            for (int m = 0; m < 4; ++m) { const int row = row0 + ai * 128 + m * 16; const size_t off = (size_t)row * DM + col0;
                const float mean = MR[2 * row], rstd = MR[2 * row + 1];
#pragma unroll
                for (int bj = 0; bj < 2; ++bj)
#pragma unroll
                    for (int n = 0; n < 2; ++n) { const size_t o = off + bj * 128 + n * 16; const f32x4 r = *(const f32x4*)(res + o);
                        const f32x4 x = (r - mean) * rstd * g4[bj][n] + b4[bj][n]; *(f32x4*)(out + o) = x * ALPHA + acc[ai][bj][m][n] * scale; } }
    } };
struct EpiBf16g { static constexpr bool PERM = true, AFTER_DRAIN = false; bf16_t* O; int ldc; int gelu_from; float scale;
    __device__ __forceinline__ void operator()(AccRef acc, const pg8::Unit& u, int wr, int wc, int fr, int fq) const {
        const int row0 = u.pm * 256 + wr * 64 + fr, col0 = u.pn * 256 + wc * 32 + 8 * fq; const bool dog = u.pn >= gelu_from;
#pragma unroll
        for (int ai = 0; ai < 2; ++ai)
#pragma unroll
            for (int m = 0; m < 4; ++m) { bf16_t* rowp = O + (size_t)(row0 + ai * 128 + m * 16) * ldc + col0;
#pragma unroll
                for (int bj = 0; bj < 2; ++bj) { f32x4 v0 = acc[ai][bj][m][0] * scale, v1 = acc[ai][bj][m][1] * scale;
                    if (dog) {
#pragma unroll
                        for (int e = 0; e < 4; ++e) { v0[e] = geluf_(v0[e]); v1[e] = geluf_(v1[e]); } }
                    u32x4 o; o.x = pk2(v0[0], v0[1]); o.y = pk2(v0[2], v0[3]); o.z = pk2(v1[0], v1[1]); o.w = pk2(v1[2], v1[3]);
                    *(u32x4*)(rowp + bj * 128) = o; } }
    } };
struct EpiKV { static constexpr bool PERM = false, AFTER_DRAIN = false; bf16_t* Kb; bf16_t* VT;
    __device__ __forceinline__ void operator()(AccRef acc, const pg8::Unit& u, int wr, int wc, int fr, int fq) const {
        const int row0 = u.pm * 256 + wr * 64 + fr, col0 = u.pn * 256 + wc * 32 + 4 * fq;
#pragma unroll
        for (int ai = 0; ai < 2; ++ai)
#pragma unroll
            for (int m = 0; m < 4; ++m) { const int row = row0 + ai * 128 + m * 16;
#pragma unroll
                for (int bj = 0; bj < 2; ++bj)
#pragma unroll
                    for (int n = 0; n < 2; ++n) { const int col = col0 + bj * 128 + n * 16; const f32x4 v = acc[ai][bj][m][n];
                        if (u.pn < 4) { u32x2 o; o.x = pk2(v[0], v[1]); o.y = pk2(v[2], v[3]); *(u32x2*)(Kb + (size_t)row * 1024 + col) = o; }
                        else { const int cc = col - 1024, hh = cc >> 8, d = cc & 255, b = row >> 8, mm = row & 255;
#pragma unroll
                            for (int e = 0; e < 4; ++e) VT[(size_t)((b * 4 + hh) * 256 + d + e) * 256 + mm] = f2bf(v[e]); } } }
    } };
struct EpiLru { static constexpr bool PERM = true, AFTER_DRAIN = false; const bf16_t* XC; const float* b_a; const float* b_x; const float* lam; bf16_t* LGA; bf16_t* BX;
    __device__ __forceinline__ void operator()(AccRef acc, const pg8::Unit& u, int wr, int wc, int fr, int fq) const {
        const int row0 = u.pm * 256 + wr * 64 + fr, ch0 = u.pn * 128 + wc * 32 + 8 * fq;
#pragma unroll
        for (int n = 0; n < 2; ++n) { float sp[4]; const f32x4 lm = *(const f32x4*)(lam + ch0 + 4 * n), ba = *(const f32x4*)(b_a + ch0 + 4 * n), bx_ = *(const f32x4*)(b_x + ch0 + 4 * n);
#pragma unroll
            for (int e = 0; e < 4; ++e) sp[e] = -8.0f * softplusf_(-lm[e]);
#pragma unroll
            for (int ai = 0; ai < 2; ++ai)
#pragma unroll
                for (int m = 0; m < 4; ++m) { const size_t off = (size_t)(row0 + ai * 128 + m * 16) * 512 + ch0 + 4 * n;
                    const u32x2 xr = *(const u32x2*)(XC + off); float xc[4] = {__uint_as_float(xr.x << 16), __uint_as_float(xr.x & 0xffff0000u), __uint_as_float(xr.y << 16), __uint_as_float(xr.y & 0xffff0000u)};
                    float la[4], bb[4];
#pragma unroll
                    for (int e = 0; e < 4; ++e) { const float rec = sigmoidf_(acc[ai][0][m][n][e] + ba[e]), inp = sigmoidf_(acc[ai][1][m][n][e] + bx_[e]);
                        const float lg = sp[e] * rec; la[e] = lg; bb[e] = sqrtf(fmaxf(1.0f - __expf(2.0f * lg), 0.0f)) * (inp * xc[e]); }
                    u32x2 o; o.x = pk2(la[0], la[1]); o.y = pk2(la[2], la[3]); *(u32x2*)(LGA + off) = o;
                    o.x = pk2(bb[0], bb[1]); o.y = pk2(bb[2], bb[3]); *(u32x2*)(BX + off) = o; } }
    } };
struct EpiPool { static constexpr bool PERM = true, AFTER_DRAIN = false; bf16_t* O; const float* scl;
    __device__ __forceinline__ void operator()(AccRef acc, const pg8::Unit& u, int wr, int wc, int fr, int fq) const {
        const int row0 = u.pm * 256 + wr * 64 + fr, col0 = u.pn * 256 + wc * 32 + 8 * fq;
#pragma unroll
        for (int ai = 0; ai < 2; ++ai)
#pragma unroll
            for (int m = 0; m < 4; ++m) { bf16_t* rowp = O + (size_t)(row0 + ai * 128 + m * 16) * 1024 + col0;
#pragma unroll
                for (int bj = 0; bj < 2; ++bj) { float v[8];
#pragma unroll
                    for (int e = 0; e < 8; ++e) v[e] = acc[ai][bj][m][e >> 2][e & 3] * scl[col0 + bj * 128 + e];
                    u32x4 o; o.x = pk2(v[0], v[1]); o.y = pk2(v[2], v[3]); o.z = pk2(v[4], v[5]); o.w = pk2(v[6], v[7]);
                    *(u32x4*)(rowp + bj * 128) = o; } }
    } };

template <class Epi> __device__ __forceinline__ void run_gemm(unsigned char* shm, const bf16_t* A, const bf16_t* Bt, int M, int N, int K, const Epi& E, int G = 0, int c = -1) {
    pg8::Gemm g; g.A = A; g.Bt = Bt; g.M = M; g.N = N; g.K = K;
    pg8::StaticOrder S; S.init(M, N, G > 0 ? G : (int)gridDim.x, c >= 0 ? c : (int)blockIdx.x);
    pg8::gemm_phase<Epi, pg8::StaticOrder>((PG8_LAS unsigned char*)shm, g, S, E);
}

template <int MODE> __device__ __forceinline__ int rowmap(int n) {
    if (MODE == 0) return n;
    const int up = n >= FF, i = up ? n - FF : n; return (i >> 7) * 256 + up * 128 + (i & 127);
}
template <int MODE> __device__ __forceinline__ void conv_tile(const float* src, int K, int N, bf16_t* dst, int tile, float* tb) {
    const int tid = otid(), ntn = N >> 6, k0 = (tile / ntn) << 6, n0 = (tile % ntn) << 6;
#pragma unroll
    for (int i = 0; i < 8; ++i) { const int kk = i * 8 + (tid >> 6), nn = tid & 63; tb[kk * 65 + nn] = src[(size_t)(k0 + kk) * N + n0 + nn]; }
    __syncthreads();
#pragma unroll
    for (int i = 0; i < 4; ++i) { const int nn = i * 16 + (tid >> 5), kk = 2 * (tid & 31);
        *(unsigned*)(dst + (size_t)rowmap<MODE>(n0 + nn) * K + k0 + kk) = pk2(tb[kk * 65 + nn], tb[(kk + 1) * 65 + nn]); }
    __syncthreads();
}

#define XB_TMO      128
#define XB_XCNT(j)  (256  + 64 * (j))
#define XB_XSUB(j)  (1280 + 64 * (j))
#define XB_XGEN(j)  (2304 + 64 * (j))
#define XB_TOP      3328
#define XB_TOPGEN   3392
#define XCD_BAR_WORDS 3456
#define XB_SPIN_CAP (1u << 18)

__device__ __forceinline__ unsigned xb_ld(unsigned* p)              { return __hip_atomic_load(p, __ATOMIC_RELAXED, __HIP_MEMORY_SCOPE_AGENT); }
__device__ __forceinline__ unsigned xb_add(unsigned* p, unsigned v) { return __hip_atomic_fetch_add(p, v, __ATOMIC_RELAXED, __HIP_MEMORY_SCOPE_AGENT); }
__device__ __forceinline__ unsigned xb_xcc_id() { return (unsigned)__builtin_amdgcn_s_getreg((3 << 11) | 20) & 0xFu; }
#define XB_SPIN(cond, bar) do { unsigned _sp = 0; while (cond) { __builtin_amdgcn_s_sleep(1); \
    if ((++_sp & 255u) == 0u) { if (xb_ld(&(bar)[XB_TMO])) break; if (_sp > XB_SPIN_CAP) { atomicAdd(&(bar)[XB_TMO], 1u); break; } } } } while (0)

struct XcdBarrier {
    unsigned* bar; unsigned x;
    volatile LAS unsigned* st;
};

__device__ __forceinline__ XcdBarrier xcd_barrier_post(unsigned* bar, volatile LAS unsigned* st) {
    XcdBarrier b; b.bar = bar; b.x = xb_xcc_id(); b.st = st;
    if (otid() == 0) (void)xb_add(&bar[XB_XCNT(b.x)], 1u);
    return b;
}
__device__ __forceinline__ void xcd_barrier_complete(unsigned* bar, unsigned x, unsigned& nloc, unsigned& nx) {
    const unsigned G = gridDim.x * gridDim.y * gridDim.z;
    unsigned sum, cnt, mine, sp = 0u;
    for (;;) {
        sum = 0u; cnt = 0u; mine = 0u;
#pragma unroll
        for (unsigned j = 0; j < 16; ++j) { const unsigned c = xb_ld(&bar[XB_XCNT(j)]); sum += c; cnt += (c > 0u) ? 1u : 0u; mine = (j == x) ? c : mine; }
        if (sum == G) break;
        __builtin_amdgcn_s_sleep(1);
        if ((++sp & 255u) == 0u) { if (xb_ld(&bar[XB_TMO])) break; if (sp > XB_SPIN_CAP) { atomicAdd(&bar[XB_TMO], 1u); break; } }
    }
    nloc = mine > 0u ? mine : 1u; nx = cnt > 0u ? cnt : 1u;
}

__device__ __forceinline__ void xcd_barrier(const XcdBarrier& b) {
    asm volatile("s_waitcnt vmcnt(0)" ::: "memory");
    __syncthreads();
    if (otid() == 0) {
        unsigned* bar = b.bar;
        __builtin_amdgcn_s_waitcnt(0);
        unsigned nloc = b.st[0], nx = b.st[1];
        if (nloc == 0u) { xcd_barrier_complete(bar, b.x, nloc, nx); b.st[0] = nloc; b.st[1] = nx; }
        const unsigned old = xb_add(&bar[XB_XSUB(b.x)], 1u);
        const unsigned gen = old / nloc;
        if (old + 1u == (gen + 1u) * nloc) {
            __builtin_amdgcn_fence(__ATOMIC_RELEASE, "agent");
            asm volatile("s_waitcnt vmcnt(0)" ::: "memory");
            const unsigned og = xb_add(&bar[XB_TOP], 1u);
            const unsigned tg = og / nx;
            if (og + 1u == (tg + 1u) * nx) xb_add(&bar[XB_TOPGEN], 1u);
            else XB_SPIN(xb_ld(&bar[XB_TOPGEN]) == tg, bar);
            __builtin_amdgcn_fence(__ATOMIC_ACQUIRE, "agent");
            xb_add(&bar[XB_XGEN(b.x)], 1u);
            asm volatile("s_waitcnt vmcnt(0)" ::: "memory");
        } else {
            XB_SPIN(xb_ld(&bar[XB_XGEN(b.x)]) == gen, bar);
            __builtin_amdgcn_fence(__ATOMIC_ACQUIRE, "agent");
            asm volatile("s_waitcnt vmcnt(0)" ::: "memory");
        }
    }
    __syncthreads();
}

struct CvDesc { const float* src; bf16_t* dst; int K, N, mode, tile; };
__device__ __forceinline__ bool cv_decode(CArgsP a, int l, int it, CvDesc& d) {
    bf16_t* W = (bf16_t*)(a->ws + WS_W); const int e = l >> 1, odd = l & 1;
    constexpr int T_FFIN = 8 * 88, T_FFOUT = 22 * 16, T_SQ = 128, T_KV = 8 * 32;
    const int T_MIXIN = odd ? 8 * 44 : 8 * 24;
    int r = it; d.mode = 0;
    if (r < T_FFIN) { d.src = a->in[2] + (size_t)l * 1024 * 5632; d.K = 1024; d.N = 5632; d.dst = W + W_FF1IN; d.mode = 1; d.tile = r; return true; } r -= T_FFIN;
    if (r < T_FFIN) { d.src = a->in[4] + (size_t)l * 1024 * 5632; d.K = 1024; d.N = 5632; d.dst = W + W_FF2IN; d.mode = 1; d.tile = r; return true; } r -= T_FFIN;
    if (r < T_FFOUT) { d.src = a->in[3] + (size_t)l * 2816 * 1024; d.K = 2816; d.N = 1024; d.dst = W + W_FF1OUT; d.tile = r; return true; } r -= T_FFOUT;
    if (r < T_FFOUT) { d.src = a->in[5] + (size_t)l * 2816 * 1024; d.K = 2816; d.N = 1024; d.dst = W + W_FF2OUT; d.tile = r; return true; } r -= T_FFOUT;
    if (r < T_SQ) { d.src = a->in[8] + (size_t)l * 1024 * 1024; d.K = 1024; d.N = 1024; d.dst = W + W_Q; d.tile = r; return true; } r -= T_SQ;
    if (r < T_KV) { d.src = a->in[9] + (size_t)l * 1024 * 2048; d.K = 1024; d.N = 2048; d.dst = W + W_KV; d.tile = r; return true; } r -= T_KV;
    if (r < T_SQ) { d.src = a->in[10] + (size_t)l * 1024 * 1024; d.K = 1024; d.N = 1024; d.dst = W + W_O; d.tile = r; return true; } r -= T_SQ;
    if (r < T_SQ) { d.src = (odd ? a->in[20] : a->in[12]) + (size_t)e * 1024 * 1024; d.K = 1024; d.N = 1024; d.dst = W + W_MIXOUT; d.tile = r; return true; } r -= T_SQ;
    if (r < T_MIXIN) { d.K = 1024; d.dst = W + W_MIXIN; d.tile = r; if (odd) { d.src = a->in[19] + (size_t)e * 1024 * 2816; d.N = 2816; } else { d.src = a->in[11] + (size_t)e * 1024 * 1536; d.N = 1536; } return true; }
    return false;
}
__device__ __forceinline__ void cv_load(const CvDesc& d, int tid, float (&v)[16]) {
    const int ntn = d.N >> 6, k0 = (d.tile / ntn) << 7, n0 = (d.tile % ntn) << 6;
#pragma unroll
    for (int i = 0; i < 16; ++i) v[i] = d.src[(size_t)(k0 + i * 8 + (tid >> 6)) * d.N + n0 + (tid & 63)];
}
__device__ __forceinline__ void convert_layer(CArgsP a, int l, unsigned char* shm) {
    float* tb = (float*)shm; bf16_t* W = (bf16_t*)(a->ws + WS_W);
    const int e = l >> 1, odd = l & 1, tid = otid();
    {
        CvDesc d, nx; float v[16]; int it = blockIdx.x; bool have = cv_decode(a, l, it, d);
        if (have) cv_load(d, tid, v);
        while (have) {
#pragma unroll
            for (int i = 0; i < 16; ++i) tb[(i * 8 + (tid >> 6)) * 65 + (tid & 63)] = v[i];
            __syncthreads();
            it += gridDim.x; const bool hn = cv_decode(a, l, it, nx);
            if (hn) cv_load(nx, tid, v);
            const int ntn = d.N >> 6, k0 = (d.tile / ntn) << 7, n0 = (d.tile % ntn) << 6;
#pragma unroll
            for (int i = 0; i < 8; ++i) { const int nn = i * 8 + (tid >> 6), kk = 2 * (tid & 63), n = n0 + nn; const int row = d.mode ? rowmap<1>(n) : n;
                *(unsigned*)(d.dst + (size_t)row * d.K + k0 + kk) = pk2(tb[kk * 65 + nn], tb[(kk + 1) * 65 + nn]); }
            __syncthreads();
            d = nx; have = hn;
        }
    }
    const int gtid = blockIdx.x * 512 + otid(), nth = gridDim.x * 512;
    if (!odd) {
        const float* pw = a->in[13] + (size_t)e * 4 * 128 * 128;
        for (int idx = gtid; idx < 512 * 512; idx += nth) { const int n = idx >> 9, k = idx & 511, g = n >> 7, d = n & 127, g2 = k >> 7, c = k & 127;
            W[W_AUX1 + idx] = (g == g2) ? f2bf(pw[(g * 128 + c) * 128 + d]) : (bf16_t)0; }
    } else {
        const float* wup = a->in[23] + (size_t)e * 64 * 512; const float* aup = a->in[25] + (size_t)e * 64 * 512; const float* gup = a->in[26] + (size_t)e * 128 * 512;
        for (int idx = gtid; idx < 1536 * 256; idx += nth) { const int n = idx >> 8, k = idx & 255, kind = n >> 9, j = n & 511; float v = 0.f;
            if (kind == 0) { if (k < 64) v = wup[k * 512 + j]; } else if (kind == 1) { if (k >= 64 && k < 128) v = aup[(k - 64) * 512 + j]; } else { if (k >= 128) v = gup[(k - 128) * 512 + j]; }
            W[W_AUX1 + idx] = f2bf(v); }
        const float* wa = a->in[34] + (size_t)e * 8 * 64 * 64; const float* wx = a->in[36] + (size_t)e * 8 * 64 * 64;
        for (int idx = gtid; idx < 1024 * 512; idx += nth) { const int n = idx >> 9, k = idx & 511, pn = n >> 8, bj = (n >> 7) & 1, cc = n & 127, ch = pn * 128 + cc, hb = ch >> 6, jj = ch & 63; float v = 0.f;
            if ((k >> 6) == hb) v = (bj ? wx : wa)[(hb * 64 + (k & 63)) * 64 + jj];
            W[W_AUX2 + idx] = f2bf(v); }
    }
}
__device__ __forceinline__ void prologue_cast(CArgsP a) {
    const int gtid = blockIdx.x * 512 + otid(), nth = gridDim.x * 512;
    const f32x4* x4 = (const f32x4*)a->in[0]; u32x2* xb = (u32x2*)(a->ws + WS_XB);
    for (int i0 = gtid; i0 < NTOK * DM / 4; i0 += nth * 8) { f32x4 v[8];
#pragma unroll
        for (int u = 0; u < 8; ++u) { const int i = i0 + u * nth; v[u] = (i < NTOK * DM / 4) ? x4[i] : (f32x4){0.f, 0.f, 0.f, 0.f}; }
#pragma unroll
        for (int u = 0; u < 8; ++u) { const int i = i0 + u * nth; if (i < NTOK * DM / 4) { u32x2 o; o.x = pk2(v[u][0], v[u][1]); o.y = pk2(v[u][2], v[u][3]); xb[i] = o; } } }
    { float* MR = (float*)(a->ws + WS_MR); for (int i = gtid; i < NTOK; i += nth) { MR[2 * i] = 0.f; MR[2 * i + 1] = 1.f; } }
    const f32x4* m4 = (const f32x4*)a->in[1]; u32x2* mb = (u32x2*)(a->ws + WS_MISC + 2 * MiB);
    for (int i = gtid; i < 512 * DM / 4; i += nth) { const f32x4 v = m4[i]; u32x2 o; o.x = pk2(v[0], v[1]); o.y = pk2(v[2], v[3]); mb[i] = o; }
}
#define DPP_F(v, ctrl) __builtin_bit_cast(float, __builtin_amdgcn_update_dpp(0, __builtin_bit_cast(int, (v)), (ctrl), 0xF, 0xF, false))
__device__ __forceinline__ float wsum_fast(float v) {
    v += DPP_F(v, 0xB1); v += DPP_F(v, 0x4E); v += DPP_F(v, 0x141); v += DPP_F(v, 0x140);
    const int iv = __builtin_bit_cast(int, v);
    const float s0 = __builtin_bit_cast(float, __builtin_amdgcn_readlane(iv, 0)), s1 = __builtin_bit_cast(float, __builtin_amdgcn_readlane(iv, 16));
    const float s2 = __builtin_bit_cast(float, __builtin_amdgcn_readlane(iv, 32)), s3 = __builtin_bit_cast(float, __builtin_amdgcn_readlane(iv, 48));
    return (s0 + s1) + (s2 + s3);
}
template <bool FINAL> __device__ __forceinline__ void ln_phase(float* xo, bf16_t* XB, float* MR, const float* g, const float* b, int bofs, int nblk) {
    const int lane = otid() & 63, wave = otid() >> 6;
    f32x4 g4[4], b4[4];
#pragma unroll
    for (int j = 0; j < 4; ++j) { g4[j] = ((const f32x4*)g)[lane + 64 * j]; b4[j] = ((const f32x4*)b)[lane + 64 * j]; }
    int row = ((int)blockIdx.x - bofs) * 8 + wave; const int rstep = nblk * 8;
    f32x4 nx[4];
    if (row < NTOK) {
#pragma unroll
        for (int j = 0; j < 4; ++j) nx[j] = ((const f32x4*)(xo + (size_t)row * DM) + lane)[64 * j];
    }
    for (; row < NTOK; row += rstep) {
        f32x4* xr = (f32x4*)(xo + (size_t)row * DM) + lane; f32x4 v[4]; float s = 0.f;
#pragma unroll
        for (int j = 0; j < 4; ++j) { v[j] = nx[j]; s += (v[j][0] + v[j][1]) + (v[j][2] + v[j][3]); }
        if (row + rstep < NTOK) {
#pragma unroll
            for (int j = 0; j < 4; ++j) nx[j] = ((const f32x4*)(xo + (size_t)(row + rstep) * DM) + lane)[64 * j];
        }
        const float mean = wsum_fast(s) * (1.f / DM); float s2 = 0.f;
#pragma unroll
        for (int j = 0; j < 4; ++j) { v[j] = v[j] - mean; s2 += (v[j][0] * v[j][0] + v[j][1] * v[j][1]) + (v[j][2] * v[j][2] + v[j][3] * v[j][3]); }
        const float rstd = rsqrtf(wsum_fast(s2) * (1.f / DM) + 1e-5f);
        if (!FINAL && lane == 0) { MR[2 * row] = mean; MR[2 * row + 1] = rstd; }
        u32x2* o8 = (u32x2*)(XB + (size_t)row * DM) + lane;
#pragma unroll
        for (int j = 0; j < 4; ++j) { const f32x4 y = v[j] * rstd * g4[j] + b4[j]; if (FINAL) xr[64 * j] = y; else { u32x2 o; o.x = pk2(y[0], y[1]); o.y = pk2(y[2], y[3]); o8[64 * j] = o; } }
    }
}
constexpr int AT_LD = 528;
__device__ __forceinline__ void attn_fill(LAS unsigned char* lds, const bf16_t* src, int ld_src, int tid) {
#pragma unroll 1
    for (int hb = 0; hb < 16; hb += 8) { u32x4 t[8];
#pragma unroll
        for (int i = 0; i < 8; ++i) { const int id = (hb + i) * 512 + tid, row = id >> 5, c = id & 31; t[i] = *(const u32x4*)(src + (size_t)row * ld_src + c * 8); }
#pragma unroll
        for (int i = 0; i < 8; ++i) { const int id = (hb + i) * 512 + tid, row = id >> 5, c = id & 31; *(LAS u32x4*)(lds + row * AT_LD + c * 16) = t[i]; } }
}
__device__ __forceinline__ void attn_phase(const bf16_t* Q, const bf16_t* Kb, const bf16_t* VT, bf16_t* O, unsigned char* shm) {
    const int tid = otid(), lane = tid & 63, wave = tid >> 6, fr = lane & 15, fq = lane >> 4;
    LAS unsigned char* lds = (LAS unsigned char*)shm;
    for (int item = blockIdx.x; item < 512; item += gridDim.x) {
        const int bh = item & 7, b = bh >> 2, h = bh & 3, row0 = b * SEQ + (item >> 3) * 256 + wave * 32;
        bf16x8 qf[2][8];
#pragma unroll
        for (int t = 0; t < 2; ++t)
#pragma unroll
            for (int ks = 0; ks < 8; ++ks) qf[t][ks] = *(const bf16x8*)(Q + (size_t)(row0 + t * 16 + fr) * DM + h * 256 + ks * 32 + fq * 8);
        attn_fill(lds, Kb + (size_t)(b * 256) * DM + h * 256, DM, tid);
        __syncthreads();
        f32x4 s[2][16];
        {
            bf16x8 kf[3][2]; f32x4 a0 = {0.f, 0.f, 0.f, 0.f}, a1 = {0.f, 0.f, 0.f, 0.f};
            const LAS unsigned char* kb = lds + fr * AT_LD + fq * 16;
#pragma unroll
            for (int pg = 0; pg < 2; ++pg)
#pragma unroll
                for (int ks = 0; ks < 2; ++ks) kf[pg][ks] = *(const LAS bf16x8*)(kb + pg * 128 + ks * 64);
#pragma unroll
            for (int g = 0; g < 64; ++g) { const int mt = g >> 2, qd = g & 3;
                if (g + 2 < 64) { const int ng = g + 2; const LAS unsigned char* np = kb + (ng >> 2) * 16 * AT_LD + (ng & 3) * 128;
#pragma unroll
                    for (int ks = 0; ks < 2; ++ks) kf[ng % 3][ks] = *(const LAS bf16x8*)(np + ks * 64); }
                __builtin_amdgcn_sched_barrier(0);
#pragma unroll
                for (int ks = 0; ks < 2; ++ks) { const bf16x8 kv = kf[g % 3][ks];
                    a0 = __builtin_amdgcn_mfma_f32_16x16x32_bf16(kv, qf[0][qd * 2 + ks], a0, 0, 0, 0); a1 = __builtin_amdgcn_mfma_f32_16x16x32_bf16(kv, qf[1][qd * 2 + ks], a1, 0, 0, 0); }
                if (qd == 3) { s[0][mt] = a0; s[1][mt] = a1; a0 = (f32x4){0.f, 0.f, 0.f, 0.f}; a1 = (f32x4){0.f, 0.f, 0.f, 0.f}; }
                __builtin_amdgcn_sched_barrier(0); }
        }
        bf16x8 pb[2][8]; float inv[2];
#pragma unroll
        for (int t = 0; t < 2; ++t) { float mx = -3.0e38f;
#pragma unroll
            for (int mt = 0; mt < 16; ++mt)
#pragma unroll
                for (int q = 0; q < 4; ++q) mx = fmaxf(mx, s[t][mt][q]);
            mx = fmaxf(mx, __shfl_xor(mx, 16)); mx = fmaxf(mx, __shfl_xor(mx, 32));
            float sum = 0.f;
#pragma unroll
            for (int mt = 0; mt < 16; ++mt)
#pragma unroll
                for (int q = 0; q < 4; ++q) { const float pv = __expf(s[t][mt][q] - mx); s[t][mt][q] = pv; sum += pv; }
            sum += __shfl_xor(sum, 16); sum += __shfl_xor(sum, 32); inv[t] = 1.0f / sum;
#pragma unroll
            for (int kp = 0; kp < 8; ++kp) { u32x4 tt; tt.x = pk2(s[t][2 * kp][0], s[t][2 * kp][1]); tt.y = pk2(s[t][2 * kp][2], s[t][2 * kp][3]); tt.z = pk2(s[t][2 * kp + 1][0], s[t][2 * kp + 1][1]); tt.w = pk2(s[t][2 * kp + 1][2], s[t][2 * kp + 1][3]);
                pb[t][kp] = __builtin_bit_cast(bf16x8, tt); } }
        __syncthreads();
        attn_fill(lds, VT + (size_t)((b * 4 + h) * 256) * 256, 256, tid);
        __syncthreads();
        {
            u32x2 vA[8], vB[8]; f32x4 a0 = {0.f, 0.f, 0.f, 0.f}, a1 = {0.f, 0.f, 0.f, 0.f};
            const LAS unsigned char* vb = lds + fr * AT_LD + fq * 8;
#pragma unroll
            for (int q = 0; q < 8; ++q) vA[q] = *(const LAS u32x2*)(vb + q * 32);
#pragma unroll
            for (int g = 0; g < 32; ++g) { const int dt = g >> 1, hf = g & 1;
                if (g + 1 < 32) { const int ndt = (g + 1) >> 1, nhf = (g + 1) & 1; const LAS unsigned char* np = vb + ndt * 16 * AT_LD + nhf * 256;
#pragma unroll
                    for (int q = 0; q < 8; ++q) { if (g & 1) vA[q] = *(const LAS u32x2*)(np + q * 32); else vB[q] = *(const LAS u32x2*)(np + q * 32); } }
                __builtin_amdgcn_sched_barrier(0);
#pragma unroll
                for (int kq = 0; kq < 4; ++kq) { const u32x2 lo = (g & 1) ? vB[2 * kq] : vA[2 * kq], hi = (g & 1) ? vB[2 * kq + 1] : vA[2 * kq + 1]; u32x4 tt; tt.x = lo.x; tt.y = lo.y; tt.z = hi.x; tt.w = hi.y;
                    const bf16x8 vf = __builtin_bit_cast(bf16x8, tt);
                    a0 = __builtin_amdgcn_mfma_f32_16x16x32_bf16(vf, pb[0][hf * 4 + kq], a0, 0, 0, 0); a1 = __builtin_amdgcn_mfma_f32_16x16x32_bf16(vf, pb[1][hf * 4 + kq], a1, 0, 0, 0); }
                if (hf) { u32x2 o; o.x = pk2(a0[0] * inv[0], a0[1] * inv[0]); o.y = pk2(a0[2] * inv[0], a0[3] * inv[0]);
                    *(u32x2*)(O + (size_t)(row0 + fr) * DM + h * 256 + dt * 16 + fq * 4) = o;
                    o.x = pk2(a1[0] * inv[1], a1[1] * inv[1]); o.y = pk2(a1[2] * inv[1], a1[3] * inv[1]);
                    *(u32x2*)(O + (size_t)(row0 + 16 + fr) * DM + h * 256 + dt * 16 + fq * 4) = o;
                    a0 = (f32x4){0.f, 0.f, 0.f, 0.f}; a1 = (f32x4){0.f, 0.f, 0.f, 0.f}; }
                __builtin_amdgcn_sched_barrier(0); }
        }
        __syncthreads();
    }
}
__device__ __forceinline__ void even_core(CArgsP a, int e, unsigned char* shm) {
    const bf16_t* H = (const bf16_t*)(a->ws + WS_H); bf16_t* POOLED = (bf16_t*)(a->ws + WS_LO); bf16_t* CONCAT = (bf16_t*)(a->ws + WS_XB);
    const int tid = otid(), lane = tid & 63, wave = tid >> 6;
    LAS float* Wl = (LAS float*)shm; LAS float* Vl = Wl + 128 * 129; LAS float* st = Vl + 128 * 128;
    const float* sgw = a->in[17] + (size_t)e * 4 * 128 * 128; const float* sgb = a->in[18] + (size_t)e * 4 * 128;
    const float* lng = a->in[15] + (size_t)e * 512; const float* lnb = a->in[16] + (size_t)e * 512;
    for (int chunk = blockIdx.x; chunk < NTOK / 128; chunk += gridDim.x) {
        const int tok0 = chunk * 128, tseq0 = tok0 & (SEQ - 1);
        {
            const int c = tid, grp = c >> 7; float hist[16]; hist[0] = 0.f;
#pragma unroll
            for (int u = 1; u < 16; ++u) { const int p = u - 16; hist[u] = (tseq0 + p >= 0) ? bf2f(H[(size_t)(tok0 + p) * 1536 + c]) : 0.f; }
            for (int tb = 0; tb < 128; tb += 16) {
#pragma unroll
                for (int u = 0; u < 16; ++u) { const int t = tb + u; const float x = bf2f(H[(size_t)(tok0 + t) * 1536 + c]); hist[u] = x;
                    const float s2 = x + hist[(u + 15) & 15];
                    const float s4 = s2 + hist[(u + 14) & 15] + hist[(u + 13) & 15];
                    const float s8 = s4 + (hist[(u + 12) & 15] + hist[(u + 11) & 15]) + (hist[(u + 10) & 15] + hist[(u + 9) & 15]);
                    const float s16 = s8 + ((hist[(u + 8) & 15] + hist[(u + 7) & 15]) + (hist[(u + 6) & 15] + hist[(u + 5) & 15])) + ((hist[(u + 4) & 15] + hist[(u + 3) & 15]) + (hist[(u + 2) & 15] + hist[(u + 1) & 15]));
                    const float sum = grp == 0 ? s2 : grp == 1 ? s4 : grp == 2 ? s8 : s16; const int win = 2 << grp, pos = tseq0 + t + 1;
                    const float dv = (float)(pos < win ? pos : win);
                    POOLED[(size_t)(tok0 + t) * 512 + c] = f2bf(sum / dv - x); }
            }
        }
#pragma unroll 4
        for (int i = 0; i < 16; ++i) { const int t = wave + 8 * i; const bf16x8 v8 = *(const bf16x8*)(H + (size_t)(tok0 + t) * 1536 + 1024 + lane * 8); float f[8], s = 0.f;
#pragma unroll
            for (int q = 0; q < 8; ++q) { f[q] = bfs2f(v8[q]); s += f[q]; }
            const float mean = wsum_fast(s) * (1.f / 512.f); float s2 = 0.f;
#pragma unroll
            for (int q = 0; q < 8; ++q) { const float d = f[q] - mean; s2 += d * d; }
            const float var = wsum_fast(s2) * (1.f / 512.f);
            if (lane == 0) { st[2 * t] = mean; st[2 * t + 1] = rsqrtf(var + 1e-5f); } }
        __syncthreads();
        for (int h = 0; h < 4; ++h) {
#pragma unroll
            for (int it = 0; it < 8; ++it) { const int idx = it * 512 + tid, t = idx >> 5, s0 = (idx & 31) * 4; const f32x4 w4 = *(const f32x4*)(sgw + (size_t)(h * 128 + t) * 128 + s0);
#pragma unroll
                for (int q = 0; q < 4; ++q) Wl[t * 129 + s0 + q] = (s0 + q <= t) ? w4[q] : 0.f; }
#pragma unroll
            for (int it = 0; it < 4; ++it) { const int idx = it * 512 + tid, s = idx >> 4, d0 = (idx & 15) * 8; const bf16x8 v8 = *(const bf16x8*)(H + (size_t)(tok0 + s) * 1536 + 1024 + h * 128 + d0);
                const float mean = st[2 * s], rstd = st[2 * s + 1];
#pragma unroll
                for (int q = 0; q < 8; ++q) Vl[s * 128 + d0 + q] = (bfs2f(v8[q]) - mean) * rstd * lng[h * 128 + d0 + q] + lnb[h * 128 + d0 + q]; }
            __syncthreads();
            const int d0 = (tid & 15) * 8, t0 = (tid >> 4) * 4;
            float acc[4][8];
#pragma unroll
            for (int i = 0; i < 4; ++i)
#pragma unroll
                for (int q = 0; q < 8; ++q) acc[i][q] = 0.f;
            for (int s = 0; s <= t0 + 3; ++s) { const f32x4 va = *(const LAS f32x4*)(Vl + s * 128 + d0), vb = *(const LAS f32x4*)(Vl + s * 128 + d0 + 4);
#pragma unroll
                for (int i = 0; i < 4; ++i) { const float w = Wl[(t0 + i) * 129 + s];
#pragma unroll
                    for (int q = 0; q < 4; ++q) { acc[i][q] += w * va[q]; acc[i][4 + q] += w * vb[q]; } } }
#pragma unroll
            for (int i = 0; i < 4; ++i) { const int t = t0 + i; const float bias = sgb[h * 128 + t]; const bf16x8 u8 = *(const bf16x8*)(H + (size_t)(tok0 + t) * 1536 + 512 + h * 128 + d0);
                float o[8];
#pragma unroll
                for (int q = 0; q < 8; ++q) o[q] = bfs2f(u8[q]) * (acc[i][q] + bias);
                u32x4 ov; ov.x = pk2(o[0], o[1]); ov.y = pk2(o[2], o[3]); ov.z = pk2(o[4], o[5]); ov.w = pk2(o[6], o[7]);
                *(u32x4*)(CONCAT + (size_t)(tok0 + t) * 1024 + 512 + h * 128 + d0) = ov; }
            __syncthreads();
        }
    }
}
__device__ __forceinline__ void odd_prep(CArgsP a, int e) {
    const bf16_t* H = (const bf16_t*)(a->ws + WS_H); bf16_t* AP = (bf16_t*)(a->ws + WS_AP); bf16_t* XC = (bf16_t*)(a->ws + WS_XC);
    const float* mu = a->in[21] + (size_t)e * 1792; const float* cw = a->in[32] + (size_t)e * 4 * 512; const float* cb = a->in[33] + (size_t)e * 512;
    const int gtid = blockIdx.x * 512 + otid(), nth = gridDim.x * 512;
    const bf16x8 z8 = {0, 0, 0, 0, 0, 0, 0, 0};
    for (int it0 = gtid; it0 < NTOK * 32; it0 += nth * 4) { bf16x8 cur[4], prv[4];
#pragma unroll
        for (int u = 0; u < 4; ++u) { const int it = it0 + u * nth, tok = it >> 5, c0 = (it & 31) * 8; const bool ok = it < NTOK * 32;
            cur[u] = ok ? *(const bf16x8*)(H + (size_t)tok * 2816 + 1536 + c0) : z8;
            prv[u] = (ok && (tok & (SEQ - 1))) ? *(const bf16x8*)(H + (size_t)(tok - 1) * 2816 + 1536 + c0) : z8; }
#pragma unroll
        for (int u = 0; u < 4; ++u) { const int it = it0 + u * nth, tok = it >> 5, c0 = (it & 31) * 8; if (it < NTOK * 32) { float v[8];
#pragma unroll
            for (int q = 0; q < 8; ++q) { const float c = bfs2f(cur[u][q]), z = c + mu[1536 + c0 + q] * (bfs2f(prv[u][q]) - c); v[q] = c0 < 64 ? tanhf_(z) : (c0 < 128 ? z : sigmoidf_(z)); }
            u32x4 o; o.x = pk2(v[0], v[1]); o.y = pk2(v[2], v[3]); o.z = pk2(v[4], v[5]); o.w = pk2(v[6], v[7]); *(u32x4*)(AP + (size_t)tok * 256 + c0) = o; } } }
    for (int it0 = gtid; it0 < NTOK * 64; it0 += nth * 4) { bf16x8 x8[4][4];
#pragma unroll
        for (int u = 0; u < 4; ++u) { const int it = it0 + u * nth, tok = it >> 6, c0 = (it & 63) * 8, tseq = tok & (SEQ - 1); const bool ok = it < NTOK * 64;
#pragma unroll
            for (int i = 0; i < 4; ++i) x8[u][i] = (ok && tseq - 3 + i >= 0) ? *(const bf16x8*)(H + (size_t)(tok - 3 + i) * 2816 + 2304 + c0) : z8; }
#pragma unroll
        for (int u = 0; u < 4; ++u) { const int it = it0 + u * nth, tok = it >> 6, c0 = (it & 63) * 8; if (it < NTOK * 64) { float v[8];
#pragma unroll
            for (int q = 0; q < 8; ++q) v[q] = cb[c0 + q];
#pragma unroll
            for (int i = 0; i < 4; ++i)
#pragma unroll
                for (int q = 0; q < 8; ++q) v[q] += cw[i * 512 + c0 + q] * bfs2f(x8[u][i][q]);
            u32x4 o; o.x = pk2(v[0], v[1]); o.y = pk2(v[2], v[3]); o.z = pk2(v[4], v[5]); o.w = pk2(v[6], v[7]); *(u32x4*)(XC + (size_t)tok * 512 + c0) = o; } } }
}
constexpr int RW_STEP = 448, RW_WAVE = 8 * RW_STEP + 8;
typedef float f32x2 __attribute__((ext_vector_type(2)));
__device__ __forceinline__ float red8(float v) {
    v += __builtin_bit_cast(float, __builtin_amdgcn_update_dpp(0, __builtin_bit_cast(int, v), 0xB1, 0xF, 0xF, false));
    v += __builtin_bit_cast(float, __builtin_amdgcn_update_dpp(0, __builtin_bit_cast(int, v), 0x4E, 0xF, 0xF, false));
    v += __builtin_bit_cast(float, __builtin_amdgcn_update_dpp(0, __builtin_bit_cast(int, v), 0x141, 0xF, 0xF, false));
    return v;
}
__device__ __forceinline__ float red4(float v) { v += DPP_F(v, 0xB1); v += DPP_F(v, 0x4E); return v; }
#define LD8P(dst, ptr) do { _Pragma("unroll") for (int _q = 0; _q < 4; ++_q) { const f32x4 _t = *(const LAS f32x4*)((ptr) + 4 * _q); dst[2 * _q] = (f32x2){_t[0], _t[1]}; dst[2 * _q + 1] = (f32x2){_t[2], _t[3]}; } } while (0)
template <int MODE> __device__ __forceinline__ void rwkv_scan(CArgsP a, int e, int bh, int c, LAS float* wl) {
    const int lane = otid() & 63, b = bh >> 3, h = bh & 7, cj = h * 64 + lane, ib = lane >> 2, jb = lane & 3;
    const bf16_t* H = (const bf16_t*)(a->ws + WS_H); const bf16_t* LO = (const bf16_t*)(a->ws + WS_LO); bf16_t* CONCAT = (bf16_t*)(a->ws + WS_XB);
    float* Lc = (float*)(a->ws + WS_AP); float* Mc = Lc + (size_t)16 * NCH * 4096; float* Ss = Mc + (size_t)16 * NCH * 4096;
    const size_t sidx = ((size_t)bh * NCH + c) * 4096 + (size_t)(ib * 4) * 64 + jb * 16;
    const int tok0 = b * SEQ + c * TCH;
    const float* mu = a->in[21] + (size_t)e * 1792;
    const float mu_r = mu[cj], mu_k = mu[512 + cj], mu_v = mu[1024 + cj], kkc = a->in[27][e * 512 + cj], kac = a->in[28][e * 512 + cj], rkc = a->in[29][e * 512 + cj];
    const float gng = a->in[30][e * 512 + cj], gnb = a->in[31][e * 512 + cj];
    const float w0c = a->in[22][e * 512 + cj], a0c = a->in[24][e * 512 + cj];
    f32x2 S[4][8];
    if (MODE == 2) {
#pragma unroll
        for (int r = 0; r < 4; ++r)
#pragma unroll
            for (int q = 0; q < 4; ++q) { const f32x4 t = *(const f32x4*)(Ss + sidx + r * 64 + 4 * q); S[r][2 * q] = (f32x2){t[0], t[1]}; S[r][2 * q + 1] = (f32x2){t[2], t[3]}; }
    } else {
#pragma unroll
        for (int r = 0; r < 4; ++r)
#pragma unroll
            for (int q = 0; q < 8; ++q) { const int row = ib * 4 + r, col = jb * 16 + 2 * q; S[r][q][0] = (MODE == 1 && row == col) ? 1.f : 0.f; S[r][q][1] = (MODE == 1 && row == col + 1) ? 1.f : 0.f; }
    }
    float pr = 0.f, pk = 0.f, pv = 0.f;
    if (c > 0) { const bf16_t* hp = H + (size_t)(tok0 - 1) * 2816 + cj; pr = bf2f(hp[0]); pk = bf2f(hp[512]); pv = bf2f(hp[1024]); }
    unsigned short rw[8][6];
#define RW_LOAD(T0) do { _Pragma("unroll") for (int s = 0; s < 8; ++s) { const size_t tok = (size_t)(tok0 + (T0) + s); const bf16_t* hp = H + tok * 2816 + cj; const bf16_t* lp = LO + tok * 1536 + cj; \
        rw[s][0] = hp[0]; rw[s][1] = hp[512]; rw[s][2] = hp[1024]; rw[s][3] = lp[0]; rw[s][4] = lp[512]; if (MODE == 2) rw[s][5] = lp[1024]; } } while (0)
    RW_LOAD(0);
    for (int t0 = 0; t0 < TCH; t0 += 8) {
#pragma unroll
        for (int s = 0; s < 8; ++s) {
            const float rr = bf2f(rw[s][0]), kr = bf2f(rw[s][1]), vr = bf2f(rw[s][2]), ee = __expf(-softplusf_(-(w0c + bf2f(rw[s][3]))) - 0.5f), aa = sigmoidf_(a0c + bf2f(rw[s][4]));
            const float rl = rr + mu_r * (pr - rr), kl = kr + mu_k * (pk - kr), vl = vr + mu_v * (pv - vr); pr = rr; pk = kr; pv = vr;
            const float kkj = kl * kkc, ss = wsum_fast(kkj * kkj), kn = kkj * rsqrtf(fmaxf(ss, 1e-24f));
            const float kp = kl * (1.0f + (aa - 1.0f) * kac), dec = __expf(-ee);
            LAS float* base = wl + s * RW_STEP;
            base[lane] = -kn; base[64 + lane] = dec; base[128 + lane] = kn * aa; base[192 + lane] = kp; base[320 + lane] = vl;
            if (MODE == 2) { base[256 + lane] = rl; base[384 + lane] = bf2f(rw[s][5]); const float bd = wsum_fast(rl * kp * rkc); if (lane == 0) wl[8 * RW_STEP + s] = bd; } }
        if (t0 + 8 < TCH) RW_LOAD(t0 + 8);
        LDS_SYNC_WAVE();
#pragma unroll 2
        for (int s = 0; s < 8; ++s) { const LAS float* base = wl + s * RW_STEP;
            f32x2 av[8], dc[8], bv[8], kp[8]; f32x4 vr4 = {0.f, 0.f, 0.f, 0.f};
            LD8P(av, base + jb * 16); LD8P(dc, base + 64 + jb * 16); LD8P(bv, base + 128 + jb * 16);
            if (MODE != 1) { LD8P(kp, base + 192 + jb * 16); vr4 = *(const LAS f32x4*)(base + 320 + ib * 4); }
            float sa[4];
#pragma unroll
            for (int r = 0; r < 4; ++r) { f32x2 p = S[r][0] * av[0];
#pragma unroll
                for (int q = 1; q < 8; ++q) p += S[r][q] * av[q];
                sa[r] = red4(p[0] + p[1]); }
#pragma unroll
            for (int r = 0; r < 4; ++r) { const f32x2 sa2 = (f32x2){sa[r], sa[r]};
                if (MODE == 1) {
#pragma unroll
                    for (int q = 0; q < 8; ++q) S[r][q] = S[r][q] * dc[q] + sa2 * bv[q];
                } else { const f32x2 v2 = (f32x2){vr4[r], vr4[r]};
#pragma unroll
                    for (int q = 0; q < 8; ++q) S[r][q] = S[r][q] * dc[q] + (sa2 * bv[q] + v2 * kp[q]); } }
            if (MODE == 2) { f32x2 rv[8]; LD8P(rv, base + 256 + jb * 16);
                float y = 0.f;
#pragma unroll
                for (int r = 0; r < 4; ++r) { f32x2 p = S[r][0] * rv[0];
#pragma unroll
                    for (int q = 1; q < 8; ++q) p += S[r][q] * rv[q];
                    const float yr = red4(p[0] + p[1]); y = (jb == r) ? yr : y; }
                const float vi = base[320 + lane];
                const float mean = wsum_fast(y) * (1.f / 64.f), ey2 = wsum_fast(y * y) * (1.f / 64.f), dl = y - mean, var = fmaxf(ey2 - mean * mean, 0.f);
                const float yn = dl * rsqrtf(var + 64e-5f) * gng + gnb;
                const float o = (yn + wl[8 * RW_STEP + s] * vi) * base[384 + lane];
                CONCAT[(size_t)(tok0 + t0 + s) * 1024 + cj] = f2bf(o); } }
        LDS_SYNC_WAVE();
    }
#undef RW_LOAD
    if (MODE != 2) { float* dst = (MODE == 0 ? Lc : Mc) + sidx;
#pragma unroll
        for (int r = 0; r < 4; ++r)
#pragma unroll
            for (int q = 0; q < 4; ++q) { f32x4 t; t[0] = S[r][2 * q][0]; t[1] = S[r][2 * q][1]; t[2] = S[r][2 * q + 1][0]; t[3] = S[r][2 * q + 1][1]; *(f32x4*)(dst + r * 64 + 4 * q) = t; } }
}
template <int MODE> __device__ __forceinline__ void rwkv_pass1_pair(CArgsP a, int e, int bh, int c, LAS float* pl) {
    const int lane = otid() & 63, b = bh >> 3, h = bh & 7, cj = h * 64 + lane, ib = lane >> 2, jb = lane & 3;
    const bf16_t* H = (const bf16_t*)(a->ws + WS_H); const bf16_t* LO = (const bf16_t*)(a->ws + WS_LO);
    float* Lc = (float*)(a->ws + WS_AP); float* Mc = Lc + (size_t)16 * NCH * 4096;
    const size_t sidx = ((size_t)bh * NCH + c) * 4096 + (size_t)(ib * 4) * 64 + jb * 16;
    const int tok0 = b * SEQ + c * TCH;
    const float* mu = a->in[21] + (size_t)e * 1792;
    const float mu_k = mu[512 + cj], mu_v = mu[1024 + cj], kkc = a->in[27][e * 512 + cj], kac = a->in[28][e * 512 + cj];
    const float w0c = a->in[22][e * 512 + cj], a0c = a->in[24][e * 512 + cj];
    f32x2 S[4][8];
#pragma unroll
    for (int r = 0; r < 4; ++r)
#pragma unroll
        for (int q = 0; q < 8; ++q) { const int row = ib * 4 + r, col = jb * 16 + 2 * q; S[r][q][0] = (MODE == 1 && row == col) ? 1.f : 0.f; S[r][q][1] = (MODE == 1 && row == col + 1) ? 1.f : 0.f; }
    unsigned short rw[5][4];
#define RW1_LOAD(T0) do { _Pragma("unroll") for (int s = 0; s < 5; ++s) { const int tk = tok0 + (T0) + MODE * 4 + s - 1; const bf16_t* hp = H + (size_t)tk * 2816 + cj; const bf16_t* lp = LO + (size_t)tk * 1536 + cj; \
        if (s == 0) { const bool have = (c > 0) || ((T0) + MODE * 4 > 0); rw[0][0] = have ? hp[512] : (unsigned short)0; rw[0][1] = have ? hp[1024] : (unsigned short)0; } \
        else { rw[s][0] = hp[512]; rw[s][1] = hp[1024]; rw[s][2] = lp[0]; rw[s][3] = lp[512]; } } } while (0)
    RW1_LOAD(0);
    for (int t0 = 0; t0 < TCH; t0 += 8) {
        float pk = bf2f(rw[0][0]), pv = bf2f(rw[0][1]);
#pragma unroll
        for (int u = 0; u < 4; ++u) { const int s = MODE * 4 + u;
            const float kr = bf2f(rw[u + 1][0]), vr = bf2f(rw[u + 1][1]), ee = __expf(-softplusf_(-(w0c + bf2f(rw[u + 1][2]))) - 0.5f), aa = sigmoidf_(a0c + bf2f(rw[u + 1][3]));
            const float kl = kr + mu_k * (pk - kr), vl = vr + mu_v * (pv - vr); pk = kr; pv = vr;
            const float kkj = kl * kkc, ss = wsum_fast(kkj * kkj), kn = kkj * rsqrtf(fmaxf(ss, 1e-24f));
            const float kp = kl * (1.0f + (aa - 1.0f) * kac), dec = __expf(-ee);
            LAS float* base = pl + s * RW_STEP;
            base[lane] = -kn; base[64 + lane] = dec; base[128 + lane] = kn * aa; base[192 + lane] = kp; base[320 + lane] = vl; }
        if (t0 + 8 < TCH) RW1_LOAD(t0 + 8);
        __syncthreads();
#pragma unroll 2
        for (int s = 0; s < 8; ++s) { const LAS float* base = pl + s * RW_STEP;
            f32x2 av[8], dc[8], bv[8], kp[8]; f32x4 vr4 = {0.f, 0.f, 0.f, 0.f};
            LD8P(av, base + jb * 16); LD8P(dc, base + 64 + jb * 16); LD8P(bv, base + 128 + jb * 16);
            if (MODE == 0) { LD8P(kp, base + 192 + jb * 16); vr4 = *(const LAS f32x4*)(base + 320 + ib * 4); }
            float sa[4];
#pragma unroll
            for (int r = 0; r < 4; ++r) { f32x2 pp = S[r][0] * av[0];
#pragma unroll
                for (int q = 1; q < 8; ++q) pp += S[r][q] * av[q];
                sa[r] = red4(pp[0] + pp[1]); }
#pragma unroll
            for (int r = 0; r < 4; ++r) { const f32x2 sa2 = (f32x2){sa[r], sa[r]};
                if (MODE == 1) {
#pragma unroll
                    for (int q = 0; q < 8; ++q) S[r][q] = S[r][q] * dc[q] + sa2 * bv[q];
                } else { const f32x2 v2 = (f32x2){vr4[r], vr4[r]};
#pragma unroll
                    for (int q = 0; q < 8; ++q) S[r][q] = S[r][q] * dc[q] + (sa2 * bv[q] + v2 * kp[q]); } } }
        __syncthreads();
    }
#undef RW1_LOAD
    float* dst = (MODE == 0 ? Lc : Mc) + sidx;
#pragma unroll
    for (int r = 0; r < 4; ++r)
#pragma unroll
        for (int q = 0; q < 4; ++q) { f32x4 t; t[0] = S[r][2 * q][0]; t[1] = S[r][2 * q][1]; t[2] = S[r][2 * q + 1][0]; t[3] = S[r][2 * q + 1][1]; *(f32x4*)(dst + r * 64 + 4 * q) = t; }
}
#define LD4P(dst, ptr) do { const f32x4 _t0 = *(const LAS f32x4*)(ptr), _t1 = *(const LAS f32x4*)((ptr) + 4); dst[0] = (f32x2){_t0[0], _t0[1]}; dst[1] = (f32x2){_t0[2], _t0[3]}; dst[2] = (f32x2){_t1[0], _t1[1]}; dst[3] = (f32x2){_t1[2], _t1[3]}; } while (0)
constexpr int RW_PAIR = RW_WAVE + 1024;
__device__ __forceinline__ void rwkv_pass2_pair(CArgsP a, int e, int bh, int c, int hf, LAS float* pl) {
    const int lane = otid() & 63, b = bh >> 3, h = bh & 7, cj = h * 64 + lane, ib = lane >> 3, jb = lane & 7;
    const bf16_t* H = (const bf16_t*)(a->ws + WS_H); const bf16_t* LO = (const bf16_t*)(a->ws + WS_LO); bf16_t* CONCAT = (bf16_t*)(a->ws + WS_XB);
    const float* Ss = (const float*)(a->ws + WS_AP) + (size_t)2 * 16 * NCH * 4096;
    const size_t sidx = ((size_t)bh * NCH + c) * 4096 + (size_t)(hf * 32 + ib * 4) * 64 + jb * 8;
    const int tok0 = b * SEQ + c * TCH;
    const float* mu = a->in[21] + (size_t)e * 1792;
    const float mu_r = mu[cj], mu_k = mu[512 + cj], mu_v = mu[1024 + cj], kkc = a->in[27][e * 512 + cj], kac = a->in[28][e * 512 + cj], rkc = a->in[29][e * 512 + cj];
    const float gng = a->in[30][e * 512 + cj], gnb = a->in[31][e * 512 + cj];
    const float w0c = a->in[22][e * 512 + cj], a0c = a->in[24][e * 512 + cj];
    LAS float* yb = pl + RW_WAVE;
    f32x2 S[4][4];
#pragma unroll
    for (int r = 0; r < 4; ++r) { const f32x4 t0 = *(const f32x4*)(Ss + sidx + r * 64), t1 = *(const f32x4*)(Ss + sidx + r * 64 + 4);
        S[r][0] = (f32x2){t0[0], t0[1]}; S[r][1] = (f32x2){t0[2], t0[3]}; S[r][2] = (f32x2){t1[0], t1[1]}; S[r][3] = (f32x2){t1[2], t1[3]}; }
    unsigned short rw[5][6];
#define RW2_LOAD(T0) do { _Pragma("unroll") for (int s = 0; s < 5; ++s) { const int tk = tok0 + (T0) + hf * 4 + s - 1; const bool ok = ((tk & (SEQ - 1)) != SEQ - 1) || s > 0 || true; \
        const bf16_t* hp = H + (size_t)tk * 2816 + cj; const bf16_t* lp = LO + (size_t)tk * 1536 + cj; (void)ok; \
        if (s == 0) { const bool have = (c > 0) || ((T0) + hf * 4 > 0); rw[0][0] = have ? hp[0] : (unsigned short)0; rw[0][1] = have ? hp[512] : (unsigned short)0; rw[0][2] = have ? hp[1024] : (unsigned short)0; } \
        else { rw[s][0] = hp[0]; rw[s][1] = hp[512]; rw[s][2] = hp[1024]; rw[s][3] = lp[0]; rw[s][4] = lp[512]; rw[s][5] = lp[1024]; } } } while (0)
    RW2_LOAD(0);
    for (int t0 = 0; t0 < TCH; t0 += 8) {
        float pr = bf2f(rw[0][0]), pk = bf2f(rw[0][1]), pv = bf2f(rw[0][2]);
#pragma unroll
        for (int u = 0; u < 4; ++u) { const int s = hf * 4 + u;
            const float rr = bf2f(rw[u + 1][0]), kr = bf2f(rw[u + 1][1]), vr = bf2f(rw[u + 1][2]), ee = __expf(-softplusf_(-(w0c + bf2f(rw[u + 1][3]))) - 0.5f), aa = sigmoidf_(a0c + bf2f(rw[u + 1][4]));
            const float rl = rr + mu_r * (pr - rr), kl = kr + mu_k * (pk - kr), vl = vr + mu_v * (pv - vr); pr = rr; pk = kr; pv = vr;
            const float kkj = kl * kkc, ss = wsum_fast(kkj * kkj), kn = kkj * rsqrtf(fmaxf(ss, 1e-24f));
            const float kp = kl * (1.0f + (aa - 1.0f) * kac), dec = __expf(-ee);
            LAS float* base = pl + s * RW_STEP;
            base[lane] = -kn; base[64 + lane] = dec; base[128 + lane] = kn * aa; base[192 + lane] = kp; base[256 + lane] = rl; base[320 + lane] = vl; base[384 + lane] = bf2f(rw[u + 1][5]);
            const float bd = wsum_fast(rl * kp * rkc); if (lane == 0) pl[8 * RW_STEP + s] = bd; }
        if (t0 + 8 < TCH) RW2_LOAD(t0 + 8);
        __syncthreads();
#pragma unroll 2
        for (int s = 0; s < 8; ++s) { const LAS float* base = pl + s * RW_STEP;
            f32x2 av[4], dc[4], bv[4], kp[4], rv[4];
            LD4P(av, base + jb * 8); LD4P(dc, base + 64 + jb * 8); LD4P(bv, base + 128 + jb * 8); LD4P(kp, base + 192 + jb * 8); LD4P(rv, base + 256 + jb * 8);
            const f32x4 v4 = *(const LAS f32x4*)(base + 320 + hf * 32 + ib * 4);
            float sa[4];
#pragma unroll
            for (int r = 0; r < 4; ++r) { f32x2 pp = S[r][0] * av[0]; pp += S[r][1] * av[1]; pp += S[r][2] * av[2]; pp += S[r][3] * av[3]; sa[r] = red8(pp[0] + pp[1]); }
            float ysel = 0.f;
#pragma unroll
            for (int r = 0; r < 4; ++r) { const f32x2 sa2 = (f32x2){sa[r], sa[r]}, v2 = (f32x2){v4[r], v4[r]};
#pragma unroll
                for (int q = 0; q < 4; ++q) S[r][q] = S[r][q] * dc[q] + (sa2 * bv[q] + v2 * kp[q]);
                f32x2 pp = S[r][0] * rv[0]; pp += S[r][1] * rv[1]; pp += S[r][2] * rv[2]; pp += S[r][3] * rv[3]; const float yr = red8(pp[0] + pp[1]); ysel = (jb == r) ? yr : ysel; }
            if (jb < 4) yb[s * 64 + hf * 32 + ib * 4 + jb] = ysel; }
        __syncthreads();
#pragma unroll
        for (int u = 0; u < 4; ++u) { const int s = hf * 4 + u; const LAS float* base = pl + s * RW_STEP; const float y = yb[s * 64 + lane], vi = base[320 + lane];
            const float mean = wsum_fast(y) * (1.f / 64.f), ey2 = wsum_fast(y * y) * (1.f / 64.f), dl = y - mean, var = fmaxf(ey2 - mean * mean, 0.f);
            const float yn = dl * rsqrtf(var + 64e-5f) * gng + gnb;
            const float o = (yn + pl[8 * RW_STEP + s] * vi) * base[384 + lane];
            CONCAT[(size_t)(tok0 + t0 + s) * 1024 + cj] = f2bf(o); }
        __syncthreads();
    }
#undef RW2_LOAD
}
__device__ __forceinline__ void rwkv_combine(CArgsP a, int blk, unsigned char* shm) {
    float* Lc = (float*)(a->ws + WS_AP); float* Mc = Lc + (size_t)16 * NCH * 4096; float* Ss = Mc + (size_t)16 * NCH * 4096;
    LAS float* Sc = (LAS float*)shm; LAS float* Mb = Sc + 512;
    const int tid = otid(), bh = blk >> 3, rg = blk & 7, r = tid >> 6, j = tid & 63;
    const size_t mbase = (size_t)bh * NCH * 4096, rowoff = (size_t)(rg * 8 + r) * 64 + j;
    float cur = 0.f;
    f32x4 mn0 = *(const f32x4*)(Mc + mbase + tid * 8), mn1 = *(const f32x4*)(Mc + mbase + tid * 8 + 4); float ln = Lc[mbase + rowoff];
    for (int c = 0; c < NCH; ++c) {
        Ss[mbase + (size_t)c * 4096 + rowoff] = cur;
        Sc[r * 64 + j] = cur; *(LAS f32x4*)(Mb + tid * 8) = mn0; *(LAS f32x4*)(Mb + tid * 8 + 4) = mn1;
        float acc = ln;
        __syncthreads();
        if (c + 1 < NCH) { const size_t nb = mbase + (size_t)(c + 1) * 4096; mn0 = *(const f32x4*)(Mc + nb + tid * 8); mn1 = *(const f32x4*)(Mc + nb + tid * 8 + 4); ln = Lc[nb + rowoff]; }
#pragma unroll
        for (int k = 0; k < 64; k += 4) { const f32x4 s4 = *(const LAS f32x4*)(Sc + r * 64 + k);
            acc += s4[0] * Mb[k * 64 + j]; acc += s4[1] * Mb[(k + 1) * 64 + j]; acc += s4[2] * Mb[(k + 2) * 64 + j]; acc += s4[3] * Mb[(k + 3) * 64 + j]; }
        cur = acc;
        __syncthreads();
    }
}
__device__ __forceinline__ void lru_pass_a(CArgsP a, int gtid, int nth) {
    const bf16_t* LGA = (const bf16_t*)(a->ws + WS_LA); const bf16_t* BX = LGA + (size_t)NTOK * 512; float2* PE = (float2*)(a->ws + WS_MISC + 3 * MiB);
    for (int it = gtid; it < 2 * NLCH * 512; it += nth) { const int ch = it & 511, cc = (it >> 9) & (NLCH - 1), b = it >> 16; const size_t base = ((size_t)b * SEQ + (size_t)cc * LCH) * 512 + ch;
        float P = 1.f, E = 0.f;
#pragma unroll 32
        for (int t = 0; t < LCH; ++t) { const float av = __expf(bf2f(LGA[base + (size_t)t * 512])), bx = bf2f(BX[base + (size_t)t * 512]); P *= av; E = av * E + bx; }
        PE[it] = make_float2(P, E); }
}
__device__ __forceinline__ void lru_pass_c2(CArgsP a, int gtid, int nth) {
    const unsigned* LGA = (const unsigned*)(a->ws + WS_LA); const unsigned* BX = LGA + (size_t)NTOK * 256; const f32x4* PE = (const f32x4*)(a->ws + WS_MISC + 3 * MiB);
    const unsigned* H = (const unsigned*)(a->ws + WS_H); unsigned* CONCAT = (unsigned*)(a->ws + WS_XB);
    for (int it = gtid; it < 2 * NLCH * 256; it += nth) { const int chp = it & 255, cc = (it >> 8) & (NLCH - 1), b = it >> 15; const size_t tokb = (size_t)b * SEQ + (size_t)cc * LCH;
        float h0 = 0.f, h1 = 0.f;
#pragma unroll 8
        for (int c2 = 0; c2 < cc; ++c2) { const f32x4 pe = PE[(b << 15) + (c2 << 8) + chp]; h0 = pe[0] * h0 + pe[1]; h1 = pe[2] * h1 + pe[3]; }
#pragma unroll 8
        for (int t = 0; t < LCH; ++t) { const size_t tok = tokb + t; const unsigned la = LGA[tok * 256 + chp], bx = BX[tok * 256 + chp], gt = H[tok * 1408 + 896 + chp];
            h0 = __expf(__uint_as_float(la << 16)) * h0 + __uint_as_float(bx << 16); h1 = __expf(__uint_as_float(la & 0xffff0000u)) * h1 + __uint_as_float(bx & 0xffff0000u);
            CONCAT[tok * 512 + 256 + chp] = pk2(h0 * geluf_(__uint_as_float(gt << 16)), h1 * geluf_(__uint_as_float(gt & 0xffff0000u))); } }
}
__device__ __forceinline__ void lru_carry(CArgsP a, int gtid) {
    if (gtid >= 1024) return;
    const float2* PE = (const float2*)(a->ws + WS_MISC + 3 * MiB); float* CY = (float*)(a->ws + WS_MR + 512 * 1024);
    const int b = gtid >> 9, ch = gtid & 511; float hsv = 0.f;
#pragma unroll 16
    for (int cc = 0; cc < NLCH; ++cc) { const int idx = (b << 16) + (cc << 9) + ch; const float2 pe = PE[idx]; CY[idx] = hsv; hsv = pe.x * hsv + pe.y; }
}
__device__ __forceinline__ void lru_pass_c(CArgsP a, int gtid, int nth) {
    const bf16_t* LGA = (const bf16_t*)(a->ws + WS_LA); const bf16_t* BX = LGA + (size_t)NTOK * 512; const float2* PE = (const float2*)(a->ws + WS_MISC + 3 * MiB);
    const bf16_t* H = (const bf16_t*)(a->ws + WS_H); bf16_t* CONCAT = (bf16_t*)(a->ws + WS_XB);
    for (int it = gtid; it < 2 * NLCH * 512; it += nth) { const int ch = it & 511, cc = (it >> 9) & (NLCH - 1), b = it >> 16; const size_t tokb = (size_t)b * SEQ + (size_t)cc * LCH;
        float hsv = ((const float*)(a->ws + WS_MR + 512 * 1024))[it];
#pragma unroll 8
        for (int t = 0; t < LCH; ++t) { const size_t tok = tokb + t; const float av = __expf(bf2f(LGA[tok * 512 + ch])), bx = bf2f(BX[tok * 512 + ch]); hsv = av * hsv + bx;
            const float gt = bf2f(H[tok * 2816 + 1792 + ch]);
            CONCAT[tok * 1024 + 512 + ch] = f2bf(hsv * geluf_(gt)); } }
}
#ifndef REP_FFN
#define REP_FFN 1
#endif
#ifndef REP_P1
#define REP_P1 1
#endif
#ifndef REP_CB
#define REP_CB 1
#endif
#ifndef REP_P2
#define REP_P2 1
#endif
#ifndef REP_OPRE
#define REP_OPRE 1
#endif
#ifndef REP_AE
#define REP_AE 1
#endif
#ifndef REP_AT
#define REP_AT 1
#endif
#ifndef REP_LN
#define REP_LN 1
#endif
#ifndef REP_IN
#define REP_IN 1
#endif
#ifndef REP_CV
#define REP_CV 1
#endif
#ifndef REP_LC
#define REP_LC 1
#endif
#ifndef REP_R2
#define REP_R2 1
#endif
#ifndef REP_SYNC
#define REP_SYNC 0
#endif
#ifdef SKIP_E
#define SK_E(x)
#else
#define SK_E(x) x
#endif
#ifdef SKIP_O
#define SK_O(x)
#else
#define SK_O(x) x
#endif
#ifdef SKIP_S
#define SK_S(x)
#else
#define SK_S(x) x
#endif
#ifdef SKIP_A
#define SK_A(x)
#else
#define SK_A(x) x
#endif
__global__ __launch_bounds__(512, 2) void mega_fwd(Args a_unused) {
    extern __shared__ __attribute__((aligned(16))) unsigned char shm[];
    cg::grid_group grid = cg::this_grid();
#define a argp()
#define ws (a->ws)
#define P_W ((bf16_t*)(ws + WS_W))
#define P_XB ((bf16_t*)(ws + WS_XB))
#define P_H ((bf16_t*)(ws + WS_H))
#define P_LO ((bf16_t*)(ws + WS_LO))
#define P_AP ((bf16_t*)(ws + WS_AP))
#define P_XC ((bf16_t*)(ws + WS_XC))
#define P_LGA ((bf16_t*)(ws + WS_LA))
#define P_BX (P_LGA + (size_t)NTOK * 512)
#define P_Kb ((bf16_t*)(ws + WS_MISC))
#define P_VT ((bf16_t*)(ws + WS_MISC + MiB))
#define P_MEMB ((bf16_t*)(ws + WS_MISC + 2 * MiB))
#define P_Qb P_H
#define P_Ob (P_H + (size_t)NTOK * DM)
    volatile LAS unsigned* xst = (volatile LAS unsigned*)(shm + LDS_BYTES - 16);
    if (otid() == 0) { xst[0] = 0u; xst[1] = 0u; }
    __syncthreads();
    const XcdBarrier xb = xcd_barrier_post((unsigned*)(ws + WS_BAR), xst);
    prologue_cast(a); convert_layer(a, 0, shm); grid.sync();
#define GSYNC() xcd_barrier(xb)
    for (int ls = 0; ls < 16; ++ls) {
        const int l = ls >> 2, st = ls & 3, e = l >> 1, odd = l & 1;
        const bf16_t* A2; const bf16_t* W2; int K2; float scale2;
        if (st == 0 || st == 3) {
            EpiSwiGLU E; E.O = P_H;
            for (int rep = 0; rep < REP_FFN; ++rep) { run_gemm(shm, P_XB, P_W + (st == 0 ? W_FF1IN : W_FF2IN), NTOK, 5632, 1024, E); GSYNC(); }
            A2 = P_H; W2 = P_W + (st == 0 ? W_FF1OUT : W_FF2OUT); K2 = 2816; scale2 = 0.5f;
        } else {
            EpiBf16g E; int N; const bf16_t* Win; E.O = P_H;
            if (st == 1) { Win = P_W + W_MIXIN; E.scale = 1.0f; if (odd) { N = 2816; E.ldc = 2816; E.gelu_from = 1000; } else { N = 1536; E.ldc = 1536; E.gelu_from = 2; } }
            else { Win = P_W + W_Q; N = 1024; E.ldc = 1024; E.gelu_from = 1000; E.scale = 0.0625f; }
            for (int rep = 0; rep < REP_IN; ++rep) { run_gemm(shm, P_XB, Win, NTOK, N, 1024, E); if (rep + 1 < REP_IN) GSYNC(); }
            GSYNC();
            if (st == 1) {
                if (!odd) {
                    for (int rep = 0; rep < REP_AE; ++rep) { SK_E(even_core(a, e, shm);) GSYNC(); }
                    EpiPool EP; EP.O = P_XB; EP.scl = a->in[14] + (size_t)e * 512;
                    run_gemm(shm, P_LO, P_W + W_AUX1, NTOK, 512, 512, EP); GSYNC();
                } else {
                    for (int rep = 0; rep < REP_OPRE; ++rep) {
                        SK_O(odd_prep(a, e);) GSYNC();
                        { EpiBf16g EL; EL.O = P_LO; EL.ldc = 1536; EL.gelu_from = 1000; EL.scale = 1.0f; run_gemm(shm, P_AP, P_W + W_AUX1, NTOK, 1536, 256, EL); }
                        { EpiLru ER; ER.XC = P_XC; ER.b_a = a->in[35] + (size_t)e * 512; ER.b_x = a->in[37] + (size_t)e * 512; ER.lam = a->in[38] + (size_t)e * 512; ER.LGA = P_LGA; ER.BX = P_BX;
                          run_gemm(shm, P_XC, P_W + W_AUX2, NTOK, 1024, 512, ER); }
                        GSYNC();
                    }
                    for (int rep = 0; rep < REP_P1; ++rep) {
                        const int wave = otid() >> 6; LAS float* pl = (LAS float*)shm + (wave >> 1) * RW_PAIR;
                        for (int it0 = blockIdx.x * 4; it0 < 16 * NCH; it0 += gridDim.x * 4) { const int item = it0 + (wave >> 1);
                            if (wave & 1) rwkv_pass1_pair<1>(a, e, item / NCH, item % NCH, pl); else rwkv_pass1_pair<0>(a, e, item / NCH, item % NCH, pl); }
                        SK_O(lru_pass_a(a, blockIdx.x * 512 + otid(), gridDim.x * 512);)
                        GSYNC();
                    }
                    for (int rep = 0; rep < REP_CB; ++rep) {
                        if (blockIdx.x < 128) { SK_O(rwkv_combine(a, blockIdx.x, shm);) }
                        else { SK_O(lru_pass_c2(a, ((int)blockIdx.x - 128) * 512 + otid(), ((int)gridDim.x - 128) * 512);) }
                        GSYNC();
                    }
                    for (int rep = 0; rep < REP_P2; ++rep) {
                        const int wave = otid() >> 6; LAS float* pl = (LAS float*)shm + (wave >> 1) * RW_PAIR;
                        for (int it0 = blockIdx.x * 4; it0 < 16 * NCH; it0 += gridDim.x * 4) { const int item = it0 + (wave >> 1); rwkv_pass2_pair(a, e, item / NCH, item % NCH, wave & 1, pl); }
                        GSYNC();
                    }
                }
                A2 = P_XB; W2 = P_W + W_MIXOUT; K2 = 1024; scale2 = 1.0f;
            } else {
                for (int rep = 0; rep < REP_AT; ++rep) { SK_A(attn_phase(P_Qb, P_Kb, P_VT, P_Ob, shm);) GSYNC(); }
                A2 = P_Ob; W2 = P_W + W_O; K2 = 1024; scale2 = 1.0f;
            }
        }
        { EpiResid ER; ER.res = (ls == 0) ? a->in[0] : a->out; ER.out = a->out; ER.MR = (const float*)(ws + WS_MR); ER.first = (ls == 0);
          ER.g = a->in[6] + (size_t)(ls > 0 ? ls - 1 : 0) * DM; ER.b = a->in[7] + (size_t)(ls > 0 ? ls - 1 : 0) * DM; ER.scale = scale2; run_gemm(shm, A2, W2, NTOK, 1024, K2, ER); }
        GSYNC();
        for (int rep = 0; rep < REP_SYNC; ++rep) GSYNC();
        if (st == 1) {
            if (blockIdx.x < 16) { EpiKV EK; EK.Kb = P_Kb; EK.VT = P_VT; run_gemm(shm, P_MEMB, P_W + W_KV, 512, 2048, 1024, EK, 16, (int)blockIdx.x); }
            else ln_phase<false>(a->out, P_XB, (float*)(ws + WS_MR), a->in[6] + (size_t)ls * DM, a->in[7] + (size_t)ls * DM, 16, (int)gridDim.x - 16);
        } else if (ls < 15) { for (int rep = 0; rep < REP_LN; ++rep) { ln_phase<false>(a->out, P_XB, (float*)(ws + WS_MR), a->in[6] + (size_t)ls * DM, a->in[7] + (size_t)ls * DM, 0, (int)gridDim.x); if (rep + 1 < REP_LN) GSYNC(); }
            if (st == 3) for (int rep = 0; rep < REP_CV; ++rep) { convert_layer(a, l + 1, shm); if (rep + 1 < REP_CV) GSYNC(); } }
        else ln_phase<true>(a->out, P_XB, (float*)(ws + WS_MR), a->in[6] + (size_t)ls * DM, a->in[7] + (size_t)ls * DM, 0, (int)gridDim.x);
        GSYNC();
    }
}

#undef a
#undef ws
#undef P_W
#undef P_XB
#undef P_H
#undef P_LO
#undef P_AP
#undef P_XC
#undef P_LGA
#undef P_BX
#undef P_Kb
#undef P_VT
#undef P_MEMB
#undef P_Qb
#undef P_Ob
extern "C" void kernel_launch(void* const* d_in, const int* in_sizes, int n_in, void* d_out, int out_size, void* d_ws, size_t ws_size, hipStream_t stream) {
    static int grid = 0;
    if (grid == 0) {
        if (n_in != 39 || out_size != NTOK * DM || ws_size < WS_END) { fprintf(stderr, "kernel_launch: unexpected shapes (n_in %d out %d ws %zu need %zu)\n", n_in, out_size, ws_size, (size_t)WS_END); grid = -1; return; }
        int dev = 0, cus = 0, per_cu = 0;
        hipGetDevice(&dev); hipDeviceGetAttribute(&cus, hipDeviceAttributeMultiprocessorCount, dev);
        if (hipFuncSetAttribute((const void*)mega_fwd, hipFuncAttributeMaxDynamicSharedMemorySize, LDS_BYTES) != hipSuccess) { fprintf(stderr, "kernel_launch: hipFuncSetAttribute failed\n"); }
        if (hipOccupancyMaxActiveBlocksPerMultiprocessor(&per_cu, (const void*)mega_fwd, 512, LDS_BYTES) != hipSuccess || per_cu < 1) { fprintf(stderr, "kernel_launch: occupancy query says %d\n", per_cu); per_cu = 1; }
        (void)hipGetLastError();
        grid = cus > 0 ? cus : 256;
    }
    if (grid < 0) return;
    if (hipMemsetAsync((char*)d_ws + WS_BAR, 0, 16384, stream) != hipSuccess) { fprintf(stderr, "kernel_launch: memset failed\n"); return; }
    Args a{};
    for (int i = 0; i < 39; ++i) a.in[i] = (const float*)d_in[i];
    a.out = (float*)d_out; a.ws = (unsigned char*)d_ws;
    void* args[] = {&a};
    hipError_t e = hipLaunchCooperativeKernel((const void*)mega_fwd, dim3(grid), dim3(512), args, LDS_BYTES, stream);
    if (e != hipSuccess) fprintf(stderr, "cooperative launch failed: %s (grid %d)\n", hipGetErrorString(e), grid);
}
```

```cpp
#include <hip/hip_runtime.h>
#include <hip/hip_cooperative_groups.h>
#include <cstdio>
namespace cg = cooperative_groups;
namespace pg8 {
#define PG8_LAS __attribute__((address_space(3)))
typedef unsigned short bf16_t;
typedef short bf16x8 __attribute__((ext_vector_type(8)));
typedef float f32x4 __attribute__((ext_vector_type(4)));
typedef unsigned u32x4 __attribute__((ext_vector_type(4)));
typedef unsigned u32x2 __attribute__((ext_vector_type(2)));
constexpr int BM = 256, BK = 64, HALF = 128, HTB = HALF * BK * 2  , STAGE_BYTES = 8 * HTB, NXCD = 8, WGM = 8;

__host__ __device__ __forceinline__ int lds_byte(int r, int c) { const int st = (r >> 4) * 2 + (c >> 5), rr = r & 15, cc = c & 31, ob = rr * 64 + cc * 2; return st * 1024 + (ob ^ (((ob >> 9) & 1) << 5)); }
__host__ __device__ __forceinline__ void stage_rc(int b, int& R, int& C) { const int st = b / 1024, sb = b % 1024, swz = sb ^ (((sb >> 9) & 1) << 5); R = (st >> 1) * 16 + swz / 64; C = (st & 1) * 32 + (swz % 64) / 2; }
__host__ __device__ __forceinline__ int perm32(int rho) { const int n = rho >> 4, i = rho & 15; return 8 * (i >> 2) + 4 * n + (i & 3); }

struct Unit { int pm, pn; };
struct Gemm { const bf16_t* A; const bf16_t* Bt; int M, N, K; };

struct StaticOrder {
    int nM, nN, nwg, G, c;
    __host__ __device__ void init(int M, int N, int G_, int c_) { nM = M / BM; nN = N / BM; nwg = nM * nN; G = G_; c = c_; }
    __host__ __device__ bool next(int i, Unit& u) const {
        const long L = (long)i * G + c; if (L >= nwg) return false;
        int wgid = (int)L; { const int q = nwg / NXCD, r = nwg % NXCD, xcd = wgid % NXCD, off = wgid / NXCD; wgid = (xcd < r ? xcd * (q + 1) : r * (q + 1) + (xcd - r) * q) + off; }
        const int nig = WGM * nN, gid = wgid / nig, fm = gid * WGM, gsz = (nM - fm) < WGM ? (nM - fm) : WGM;
        u.pm = fm + ((wgid % nig) % gsz); u.pn = (wgid % nig) / gsz; return true;
    }
    __device__ __forceinline__ void a_ready(const Unit&) const {}
    __device__ __forceinline__ void done(const Unit&) const {}
};
__device__ __forceinline__ unsigned cvt_pk_bf16(float lo, float hi) { unsigned r; asm volatile("v_cvt_pk_bf16_f32 %0, %1, %2" : "=v"(r) : "v"(lo), "v"(hi)); return r; }

template <class Epi, class Sched>
__device__ __forceinline__ void gemm_phase(PG8_LAS unsigned char* lds, const Gemm g, const Sched& S, const Epi& E) {
    int tid_ = threadIdx.x; asm volatile("" : "+v"(tid_));
    const int tid = tid_, wid = __builtin_amdgcn_readfirstlane(tid >> 6), lane = tid & 63, wr = wid >> 2, wc = wid & 3, fr = lane & 15, fq = lane >> 4;
    const int K = g.K, nt = K / BK;
    unsigned voffA[2], voffB[2];
#pragma unroll
    for (int i = 0; i < 2; ++i) { int R, C; stage_rc(tid * 16 + i * 8192, R, C); const int Rb = Epi::PERM ? ((R & ~31) + perm32(R & 31)) : R;
        voffA[i] = (unsigned)(R * K + C) * 2u; voffB[i] = (unsigned)(Rb * K + C) * 2u; }
    const size_t kstep = (size_t)(BK * 2);
    const size_t hstep = (size_t)HALF * K * 2;
    const size_t tstep = 2 * hstep;
    const unsigned ldsw = (unsigned)wid * 1024u;
    const int aoff = lds_byte(wr * 64 + fr, fq * 8), boff = lds_byte(wc * 32 + fr, fq * 8);
#define PG8_SA(b, h) (((b) * 2 + (h)) * HTB)
#define PG8_SB(b, h) ((4 + (b) * 2 + (h)) * HTB)
#define PG8_STAGE(bufoff, gbase, voff) do { _Pragma("unroll") for (int _i = 0; _i < 2; ++_i) \
        __builtin_amdgcn_global_load_lds((const unsigned*)((const char*)(gbase) + (voff)[_i]), (PG8_LAS unsigned*)(lds + (bufoff) + ldsw + _i * 8192), 16, 0, 0); } while (0)
#define PG8_LDA(dst, b, h) do { _Pragma("unroll") for (int m = 0; m < 4; ++m) _Pragma("unroll") for (int k = 0; k < 2; ++k) dst[m][k] = *(const PG8_LAS bf16x8*)(lds + PG8_SA(b, h) + aoff + m * 2048 + k * 1024); } while (0)
#define PG8_LDB(dst, b, h) do { _Pragma("unroll") for (int n = 0; n < 2; ++n) _Pragma("unroll") for (int k = 0; k < 2; ++k) dst[n][k] = *(const PG8_LAS bf16x8*)(lds + PG8_SB(b, h) + boff + n * 2048 + k * 1024); } while (0)
#define PG8_MMA(ai, bj, At, Bt) do { __builtin_amdgcn_s_setprio(1); _Pragma("unroll") for (int m = 0; m < 4; ++m) _Pragma("unroll") for (int n = 0; n < 2; ++n) _Pragma("unroll") for (int k = 0; k < 2; ++k) \
        acc[ai][bj][m][n] = __builtin_amdgcn_mfma_f32_16x16x32_bf16(Bt[n][k], At[m][k], acc[ai][bj][m][n], 0, 0, 0); __builtin_amdgcn_s_setprio(0); } while (0)
#define PG8_WAIT_V(n) asm volatile("s_waitcnt vmcnt(" #n ")" ::: "memory")
#define PG8_WAIT_L(n) asm volatile("s_waitcnt lgkmcnt(" #n ")" ::: "memory")
#define PG8_BAR __builtin_amdgcn_s_barrier()
#define PG8_SCHED __builtin_amdgcn_sched_barrier(0)
    Unit cur, nxt; int ui = 0;
    if (!S.next(0, cur)) return;
    f32x4 acc[2][2][4][2];
#pragma unroll
    for (int a = 0; a < 2; ++a)
#pragma unroll
        for (int b = 0; b < 2; ++b)
#pragma unroll
            for (int m = 0; m < 4; ++m)
#pragma unroll
                for (int n = 0; n < 2; ++n) acc[a][b][m][n] = (f32x4){0.f, 0.f, 0.f, 0.f};
    bf16x8 At[4][2], B0[2][2], B1[2][2];
    const char* cA = (const char*)g.A + (size_t)cur.pm * tstep; const char* cB = (const char*)g.Bt + (size_t)cur.pn * tstep;
    S.a_ready(cur);
    PG8_STAGE(PG8_SB(0, 0), cB, voffB); PG8_STAGE(PG8_SA(0, 0), cA, voffA); PG8_STAGE(PG8_SB(0, 1), cB + hstep, voffB); PG8_STAGE(PG8_SA(0, 1), cA + hstep, voffA);
    if (wr == 1) PG8_BAR;
    PG8_WAIT_V(4); PG8_BAR;
    PG8_STAGE(PG8_SB(1, 0), cB + kstep, voffB); PG8_STAGE(PG8_SA(1, 0), cA + kstep, voffA); PG8_STAGE(PG8_SB(1, 1), cB + hstep + kstep, voffB);
    PG8_WAIT_V(6); PG8_BAR;
    for (;;) {
        const bool has_next = S.next(ui + 1, nxt);
        const char* nA = has_next ? (const char*)g.A + (size_t)nxt.pm * tstep : cA; const char* nB = has_next ? (const char*)g.Bt + (size_t)nxt.pn * tstep : cB;
        for (int t = 0; t < nt; t += 2) {
            const bool last = (t == nt - 2);
            const char* a1 = cA + (size_t)(t + 1) * kstep;
            const char* a2 = last ? nA : cA + (size_t)(t + 2) * kstep; const char* b2 = last ? nB : cB + (size_t)(t + 2) * kstep;
            const char* a3 = a2 + kstep; const char* b3 = b2 + kstep;
            if (last && has_next) S.a_ready(nxt);
            PG8_LDB(B0, 0, 0); PG8_SCHED; PG8_LDA(At, 0, 0); PG8_STAGE(PG8_SA(1, 1), a1 + hstep, voffA);
            PG8_WAIT_L(8); PG8_BAR; PG8_WAIT_L(0); PG8_MMA(0, 0, At, B0); PG8_BAR; PG8_SCHED;
            PG8_LDB(B1, 0, 1); PG8_STAGE(PG8_SB(0, 0), b2, voffB);
            PG8_BAR; PG8_WAIT_L(0); PG8_MMA(0, 1, At, B1); PG8_BAR;
            PG8_LDA(At, 0, 1); PG8_STAGE(PG8_SA(0, 0), a2, voffA);
            PG8_BAR; PG8_WAIT_L(0); PG8_MMA(1, 0, At, B0); PG8_BAR; PG8_SCHED;
            PG8_STAGE(PG8_SB(0, 1), b2 + hstep, voffB);
            PG8_WAIT_V(6); PG8_BAR; PG8_MMA(1, 1, At, B1); PG8_BAR;
            PG8_LDB(B0, 1, 0); PG8_SCHED; PG8_LDA(At, 1, 0); PG8_STAGE(PG8_SA(0, 1), a2 + hstep, voffA);
            PG8_WAIT_L(8); PG8_BAR; PG8_WAIT_L(0); PG8_MMA(0, 0, At, B0); PG8_BAR; PG8_SCHED;
            PG8_LDB(B1, 1, 1); PG8_STAGE(PG8_SB(1, 0), b3, voffB);
            PG8_BAR; PG8_WAIT_L(0); PG8_MMA(0, 1, At, B1); PG8_BAR;
            PG8_LDA(At, 1, 1); PG8_STAGE(PG8_SA(1, 0), a3, voffA);
            PG8_BAR; PG8_WAIT_L(0); PG8_MMA(1, 0, At, B0); PG8_BAR; PG8_SCHED;
            PG8_STAGE(PG8_SB(1, 1), b3 + hstep, voffB);
            PG8_WAIT_V(6); PG8_BAR; PG8_MMA(1, 1, At, B1); PG8_BAR;
        }
        if constexpr (!Epi::AFTER_DRAIN) { E(acc, cur, wr, wc, fr, fq); S.done(cur); }
        if (!has_next) break;
#pragma unroll
        for (int a = 0; a < 2; ++a)
#pragma unroll
            for (int b = 0; b < 2; ++b)
#pragma unroll
                for (int m = 0; m < 4; ++m)
#pragma unroll
                    for (int n = 0; n < 2; ++n) acc[a][b][m][n] = (f32x4){0.f, 0.f, 0.f, 0.f};
        cur = nxt; cA = nA; cB = nB; ++ui;
    }
    PG8_WAIT_V(0);
    if (wr == 0) PG8_BAR;
    PG8_BAR;
    if constexpr (Epi::AFTER_DRAIN) { E.fused(acc, cur, wr, wc, fr, fq, lds, wid, lane); S.done(cur); }
#undef PG8_SA
#undef PG8_SB
#undef PG8_STAGE
#undef PG8_LDA
#undef PG8_LDB
#undef PG8_MMA
#undef PG8_WAIT_V
#undef PG8_WAIT_L
#undef PG8_BAR
#undef PG8_SCHED
}
}

using pg8::bf16_t; using pg8::bf16x8; using pg8::f32x4; using pg8::u32x4; using pg8::u32x2;
#define LAS __attribute__((address_space(3)))
constexpr int NTOK = 32768, SEQ = 16384, DM = 1024, FF = 2816;
constexpr int NCH = 64;
constexpr int TCH = SEQ / NCH;
constexpr int LCH = 128;
constexpr int NLCH = SEQ / LCH;
constexpr float ALPHA = 1.681792830507429f;
constexpr int LDS_BYTES = 136 * 1024;

constexpr size_t MiB = 1024 * 1024;
constexpr size_t E_FFIN = (size_t)5632 * 1024, E_FFOUT = (size_t)1024 * 2816, E_SQ = (size_t)1024 * 1024, E_KV = (size_t)2048 * 1024, E_MIXIN = (size_t)2816 * 1024;
constexpr size_t W_FF1IN = 0, W_FF1OUT = W_FF1IN + E_FFIN, W_FF2IN = W_FF1OUT + E_FFOUT, W_FF2OUT = W_FF2IN + E_FFIN, W_Q = W_FF2OUT + E_FFOUT, W_KV = W_Q + E_SQ, W_O = W_KV + E_KV,
                 W_MIXIN = W_O + E_SQ, W_MIXOUT = W_MIXIN + E_MIXIN, W_AUX1 = W_MIXOUT + E_SQ, W_AUX2 = W_AUX1 + (size_t)1536 * 256, W_END = W_AUX2 + (size_t)1024 * 512;
constexpr size_t WS_W = 0;
constexpr size_t WS_XB = 52 * MiB;
constexpr size_t WS_H = WS_XB + 64 * MiB;
constexpr size_t WS_LO = WS_H + 176 * MiB;
constexpr size_t WS_AP = WS_LO + 96 * MiB;
constexpr size_t WS_XC = WS_AP + 16 * MiB;
constexpr size_t WS_LA = WS_XC + 32 * MiB;
constexpr size_t WS_MISC = WS_LA + 64 * MiB;
constexpr size_t WS_BAR = WS_MISC + 4 * MiB;
constexpr size_t WS_MR = WS_BAR + 1 * MiB;
constexpr size_t WS_END = WS_MR + 1 * MiB;
static_assert(W_END * 2 <= 52 * MiB, "weights");
static_assert(WS_END <= 512 * MiB, "workspace");

struct Args { const float* in[39]; float* out; unsigned char* ws; };
typedef const __attribute__((address_space(4))) Args* CArgsP;
__device__ __forceinline__ CArgsP argp() { CArgsP p = (CArgsP)__builtin_amdgcn_kernarg_segment_ptr(); asm volatile("" : "+s"(p)); return p; }

__device__ __forceinline__ float bf2f(unsigned short b) { return __uint_as_float(((unsigned)b) << 16); }
__device__ __forceinline__ float bfs2f(short b) { return __uint_as_float(((unsigned)(unsigned short)b) << 16); }
__device__ __forceinline__ unsigned short f2bf(float f) { unsigned u = __float_as_uint(f); u += 0x7FFFu + ((u >> 16) & 1u); return (unsigned short)(u >> 16); }
__device__ __forceinline__ unsigned pk2(float lo, float hi) { return pg8::cvt_pk_bf16(lo, hi); }
__device__ __forceinline__ float sigmoidf_(float x) { return __builtin_amdgcn_rcpf(1.0f + __expf(-x)); }
__device__ __forceinline__ float siluf_(float x) { return x * sigmoidf_(x); }
__device__ __forceinline__ float tanhf_(float y) { return 1.0f - 2.0f * __builtin_amdgcn_rcpf(1.0f + __expf(2.0f * y)); }
__device__ __forceinline__ float geluf_(float x) { return 0.5f * x * (1.0f + tanhf_(0.7978845608028654f * (x + 0.044715f * x * x * x))); }
__device__ __forceinline__ float softplusf_(float x) { return fmaxf(x, 0.0f) + __logf(1.0f + __expf(-fabsf(x))); }
__device__ __forceinline__ float wave_sum(float v) {
#pragma unroll
    for (int o = 1; o < 64; o <<= 1) v += __shfl_xor(v, o);
    return v;
}
__device__ __forceinline__ int otid() { int t = threadIdx.x; asm volatile("" : "+v"(t)); return t; }
#define LDS_SYNC_WAVE() asm volatile("s_waitcnt lgkmcnt(0)" ::: "memory")

typedef const f32x4 (&AccRef)[2][2][4][2];
struct EpiSwiGLU { static constexpr bool PERM = true, AFTER_DRAIN = false; bf16_t* O;
    __device__ __forceinline__ void operator()(AccRef acc, const pg8::Unit& u, int wr, int wc, int fr, int fq) const {
        const int row0 = u.pm * 256 + wr * 64 + fr, col0 = u.pn * 128 + wc * 32 + 8 * fq;
#pragma unroll
        for (int ai = 0; ai < 2; ++ai)
#pragma unroll
            for (int m = 0; m < 4; ++m) { bf16_t* rowp = O + (size_t)(row0 + ai * 128 + m * 16) * FF + col0;
                const f32x4 g0 = acc[ai][0][m][0], g1 = acc[ai][0][m][1], u0 = acc[ai][1][m][0], u1 = acc[ai][1][m][1];
                u32x4 o; o.x = pk2(siluf_(g0[0]) * u0[0], siluf_(g0[1]) * u0[1]); o.y = pk2(siluf_(g0[2]) * u0[2], siluf_(g0[3]) * u0[3]);
                o.z = pk2(siluf_(g1[0]) * u1[0], siluf_(g1[1]) * u1[1]); o.w = pk2(siluf_(g1[2]) * u1[2], siluf_(g1[3]) * u1[3]);
                *(u32x4*)rowp = o; __builtin_amdgcn_sched_barrier(0); }
    } };
typedef _Float16 h16; typedef h16 h16x4 __attribute__((ext_vector_type(4))); typedef h16 h16x8 __attribute__((ext_vector_type(8)));
struct EpiResid { static constexpr bool PERM = false, AFTER_DRAIN = false; const h16* res; h16* out; const float* MR; const float* g; const float* b; float scale; int first;
    __device__ __forceinline__ void operator()(AccRef acc, const pg8::Unit& u, int wr, int wc, int fr, int fq) const {
        const int row0 = u.pm * 256 + wr * 64 + fr, col0 = u.pn * 256 + wc * 32 + 4 * fq;
        f32x4 g4[2][2], b4[2][2];
#pragma unroll
        for (int bj = 0; bj < 2; ++bj)
#pragma unroll
            for (int n = 0; n < 2; ++n) { if (first) { g4[bj][n] = (f32x4){1.f, 1.f, 1.f, 1.f}; b4[bj][n] = (f32x4){0.f, 0.f, 0.f, 0.f}; } else { g4[bj][n] = *(const f32x4*)(g + col0 + bj * 128 + n * 16); b4[bj][n] = *(const f32x4*)(b + col0 + bj * 128 + n * 16); } }
#pragma unroll
        for (int ai = 0; ai < 2; ++ai)
#pragma unroll
            for (int m = 0; m < 4; ++m) { const int row = row0 + ai * 128 + m * 16; const size_t off = (size_t)row * DM + col0;
                const float mean = MR[2 * row], rstd = MR[2 * row + 1];
#pragma unroll
                for (int bj = 0; bj < 2; ++bj)
#pragma unroll
                    for (int n = 0; n < 2; ++n) { const size_t o = off + bj * 128 + n * 16; const f32x4 r = __builtin_convertvector(*(const h16x4*)(res + o), f32x4);
                        const f32x4 x = (r - mean) * rstd * g4[bj][n] + b4[bj][n], z = x * ALPHA + acc[ai][bj][m][n] * scale;
                        *(h16x4*)(out + o) = __builtin_convertvector(z, h16x4); } }
    } };
struct EpiBf16g { static constexpr bool PERM = true, AFTER_DRAIN = false; bf16_t* O; int ldc; int gelu_from; float scale;
    __device__ __forceinline__ void operator()(AccRef acc, const pg8::Unit& u, int wr, int wc, int fr, int fq) const {
        const int row0 = u.pm * 256 + wr * 64 + fr, col0 = u.pn * 256 + wc * 32 + 8 * fq; const bool dog = u.pn >= gelu_from;
#pragma unroll
        for (int ai = 0; ai < 2; ++ai)
#pragma unroll
            for (int m = 0; m < 4; ++m) { bf16_t* rowp = O + (size_t)(row0 + ai * 128 + m * 16) * ldc + col0;
#pragma unroll
                for (int bj = 0; bj < 2; ++bj) { f32x4 v0 = acc[ai][bj][m][0] * scale, v1 = acc[ai][bj][m][1] * scale;
                    if (dog) {
#pragma unroll
                        for (int e = 0; e < 4; ++e) { v0[e] = geluf_(v0[e]); v1[e] = geluf_(v1[e]); } }
                    u32x4 o; o.x = pk2(v0[0], v0[1]); o.y = pk2(v0[2], v0[3]); o.z = pk2(v1[0], v1[1]); o.w = pk2(v1[2], v1[3]);
                    *(u32x4*)(rowp + bj * 128) = o; } }
    } };
struct EpiKV { static constexpr bool PERM = false, AFTER_DRAIN = false; bf16_t* Kb; bf16_t* VT;
    __device__ __forceinline__ void operator()(AccRef acc, const pg8::Unit& u, int wr, int wc, int fr, int fq) const {
        const int row0 = u.pm * 256 + wr * 64 + fr, col0 = u.pn * 256 + wc * 32 + 4 * fq;
#pragma unroll
        for (int ai = 0; ai < 2; ++ai)
#pragma unroll
            for (int m = 0; m < 4; ++m) { const int row = row0 + ai * 128 + m * 16;
#pragma unroll
                for (int bj = 0; bj < 2; ++bj)
#pragma unroll
                    for (int n = 0; n < 2; ++n) { const int col = col0 + bj * 128 + n * 16; const f32x4 v = acc[ai][bj][m][n];
                        if (u.pn < 4) { u32x2 o; o.x = pk2(v[0], v[1]); o.y = pk2(v[2], v[3]); *(u32x2*)(Kb + (size_t)row * 1024 + col) = o; }
                        else { const int cc = col - 1024, hh = cc >> 8, d = cc & 255, b = row >> 8, mm = row & 255;
#pragma unroll
                            for (int e = 0; e < 4; ++e) VT[(size_t)((b * 4 + hh) * 256 + d + e) * 256 + mm] = f2bf(v[e]); } } }
    } };
struct EpiLru { static constexpr bool PERM = true, AFTER_DRAIN = false; const bf16_t* XC; const float* b_a; const float* b_x; const float* lam; bf16_t* LGA; bf16_t* BX;
    __device__ __forceinline__ void operator()(AccRef acc, const pg8::Unit& u, int wr, int wc, int fr, int fq) const {
        const int row0 = u.pm * 256 + wr * 64 + fr, ch0 = u.pn * 128 + wc * 32 + 8 * fq;
#pragma unroll
        for (int n = 0; n < 2; ++n) { float sp[4]; const f32x4 lm = *(const f32x4*)(lam + ch0 + 4 * n), ba = *(const f32x4*)(b_a + ch0 + 4 * n), bx_ = *(const f32x4*)(b_x + ch0 + 4 * n);
#pragma unroll
            for (int e = 0; e < 4; ++e) sp[e] = -8.0f * softplusf_(-lm[e]);
            u32x2 xrr[2][4];
#pragma unroll
            for (int ai = 0; ai < 2; ++ai)
#pragma unroll
                for (int m = 0; m < 4; ++m) xrr[ai][m] = *(const u32x2*)(XC + (size_t)(row0 + ai * 128 + m * 16) * 512 + ch0 + 4 * n);
#pragma unroll
            for (int ai = 0; ai < 2; ++ai)
#pragma unroll
                for (int m = 0; m < 4; ++m) { const size_t off = (size_t)(row0 + ai * 128 + m * 16) * 512 + ch0 + 4 * n;
                    const u32x2 xr = xrr[ai][m]; float xc[4] = {__uint_as_float(xr.x << 16), __uint_as_float(xr.x & 0xffff0000u), __uint_as_float(xr.y << 16), __uint_as_float(xr.y & 0xffff0000u)};
                    float la[4], bb[4];
#pragma unroll
                    for (int e = 0; e < 4; ++e) { const float rec = sigmoidf_(acc[ai][0][m][n][e] + ba[e]), inp = sigmoidf_(acc[ai][1][m][n][e] + bx_[e]);
                        const float lg = sp[e] * rec; la[e] = lg; bb[e] = sqrtf(fmaxf(1.0f - __expf(2.0f * lg), 0.0f)) * (inp * xc[e]); }
                    u32x2 o; o.x = pk2(la[0], la[1]); o.y = pk2(la[2], la[3]); *(u32x2*)(LGA + off) = o;
                    o.x = pk2(bb[0], bb[1]); o.y = pk2(bb[2], bb[3]); *(u32x2*)(BX + off) = o; } }
    } };
struct EpiPool { static constexpr bool PERM = true, AFTER_DRAIN = false; bf16_t* O; const float* scl;
    __device__ __forceinline__ void operator()(AccRef acc, const pg8::Unit& u, int wr, int wc, int fr, int fq) const {
        const int row0 = u.pm * 256 + wr * 64 + fr, col0 = u.pn * 256 + wc * 32 + 8 * fq;
#pragma unroll
        for (int ai = 0; ai < 2; ++ai)
#pragma unroll
            for (int m = 0; m < 4; ++m) { bf16_t* rowp = O + (size_t)(row0 + ai * 128 + m * 16) * 1024 + col0;
#pragma unroll
                for (int bj = 0; bj < 2; ++bj) { float v[8];
#pragma unroll
                    for (int e = 0; e < 8; ++e) v[e] = acc[ai][bj][m][e >> 2][e & 3] * scl[col0 + bj * 128 + e];
                    u32x4 o; o.x = pk2(v[0], v[1]); o.y = pk2(v[2], v[3]); o.z = pk2(v[4], v[5]); o.w = pk2(v[6], v[7]);
                    *(u32x4*)(rowp + bj * 128) = o; } }
    } };

template <class Epi> __device__ __forceinline__ void run_gemm(unsigned char* shm, const bf16_t* A, const bf16_t* Bt, int M, int N, int K, const Epi& E, int G = 0, int c = -1) {
    pg8::Gemm g; g.A = A; g.Bt = Bt; g.M = M; g.N = N; g.K = K;
    pg8::StaticOrder S; S.init(M, N, G > 0 ? G : (int)gridDim.x, c >= 0 ? c : (int)blockIdx.x);
    pg8::gemm_phase<Epi, pg8::StaticOrder>((PG8_LAS unsigned char*)shm, g, S, E);
}

template <int MODE> __device__ __forceinline__ int rowmap(int n) {
    if (MODE == 0) return n;
    const int up = n >= FF, i = up ? n - FF : n; return (i >> 7) * 256 + up * 128 + (i & 127);
}
template <int MODE> __device__ __forceinline__ void conv_tile(const float* src, int K, int N, bf16_t* dst, int tile, float* tb) {
    const int tid = otid(), ntn = N >> 6, k0 = (tile / ntn) << 6, n0 = (tile % ntn) << 6;
#pragma unroll
    for (int i = 0; i < 8; ++i) { const int kk = i * 8 + (tid >> 6), nn = tid & 63; tb[kk * 65 + nn] = src[(size_t)(k0 + kk) * N + n0 + nn]; }
    __syncthreads();
#pragma unroll
    for (int i = 0; i < 4; ++i) { const int nn = i * 16 + (tid >> 5), kk = 2 * (tid & 31);
        *(unsigned*)(dst + (size_t)rowmap<MODE>(n0 + nn) * K + k0 + kk) = pk2(tb[kk * 65 + nn], tb[(kk + 1) * 65 + nn]); }
    __syncthreads();
}

#define XB_TMO      128
#define XB_XCNT(j)  (256  + 64 * (j))
#define XB_XSUB(j)  (1280 + 64 * (j))
#define XB_XGEN(j)  (2304 + 64 * (j))
#define XB_TOP      3328
#define XB_TOPGEN   3392
#define XCD_BAR_WORDS 3456
#define XB_SPIN_CAP (1u << 18)

__device__ __forceinline__ unsigned xb_ld(unsigned* p)              { return __hip_atomic_load(p, __ATOMIC_RELAXED, __HIP_MEMORY_SCOPE_AGENT); }
__device__ __forceinline__ unsigned xb_add(unsigned* p, unsigned v) { return __hip_atomic_fetch_add(p, v, __ATOMIC_RELAXED, __HIP_MEMORY_SCOPE_AGENT); }
__device__ __forceinline__ unsigned xb_xcc_id() { return (unsigned)__builtin_amdgcn_s_getreg((3 << 11) | 20) & 0xFu; }
#define XB_SPIN(cond, bar) do { unsigned _sp = 0; while (cond) { __builtin_amdgcn_s_sleep(1); \
    if ((++_sp & 255u) == 0u) { if (xb_ld(&(bar)[XB_TMO])) break; if (_sp > XB_SPIN_CAP) { atomicAdd(&(bar)[XB_TMO], 1u); break; } } } } while (0)

struct XcdBarrier {
    unsigned* bar; unsigned x;
    volatile LAS unsigned* st;
};

__device__ __forceinline__ XcdBarrier xcd_barrier_post(unsigned* bar, volatile LAS unsigned* st) {
    XcdBarrier b; b.bar = bar; b.x = xb_xcc_id(); b.st = st;
    if (otid() == 0) (void)xb_add(&bar[XB_XCNT(b.x)], 1u);
    return b;
}
__device__ __forceinline__ void xcd_barrier_complete(unsigned* bar, unsigned x, unsigned& nloc, unsigned& nx) {
    const unsigned G = gridDim.x * gridDim.y * gridDim.z;
    unsigned sum, cnt, mine, sp = 0u;
    for (;;) {
        sum = 0u; cnt = 0u; mine = 0u;
#pragma unroll
        for (unsigned j = 0; j < 16; ++j) { const unsigned c = xb_ld(&bar[XB_XCNT(j)]); sum += c; cnt += (c > 0u) ? 1u : 0u; mine = (j == x) ? c : mine; }
        if (sum == G) break;
        __builtin_amdgcn_s_sleep(1);
        if ((++sp & 255u) == 0u) { if (xb_ld(&bar[XB_TMO])) break; if (sp > XB_SPIN_CAP) { atomicAdd(&bar[XB_TMO], 1u); break; } }
    }
    nloc = mine > 0u ? mine : 1u; nx = cnt > 0u ? cnt : 1u;
}

__device__ __forceinline__ void xcd_barrier(const XcdBarrier& b) {
    asm volatile("s_waitcnt vmcnt(0)" ::: "memory");
    __syncthreads();
    if (otid() == 0) {
        unsigned* bar = b.bar;
        __builtin_amdgcn_s_waitcnt(0);
        unsigned nloc = b.st[0], nx = b.st[1];
        if (nloc == 0u) { xcd_barrier_complete(bar, b.x, nloc, nx); b.st[0] = nloc; b.st[1] = nx; }
        const unsigned old = xb_add(&bar[XB_XSUB(b.x)], 1u);
        const unsigned gen = old / nloc;
        if (old + 1u == (gen + 1u) * nloc) {
            __builtin_amdgcn_fence(__ATOMIC_RELEASE, "agent");
            asm volatile("s_waitcnt vmcnt(0)" ::: "memory");
            const unsigned og = xb_add(&bar[XB_TOP], 1u);
            const unsigned tg = og / nx;
            if (og + 1u == (tg + 1u) * nx) xb_add(&bar[XB_TOPGEN], 1u);
            else XB_SPIN(xb_ld(&bar[XB_TOPGEN]) == tg, bar);
            __builtin_amdgcn_fence(__ATOMIC_ACQUIRE, "agent");
            xb_add(&bar[XB_XGEN(b.x)], 1u);
            asm volatile("s_waitcnt vmcnt(0)" ::: "memory");
        } else {
            XB_SPIN(xb_ld(&bar[XB_XGEN(b.x)]) == gen, bar);
            __builtin_amdgcn_fence(__ATOMIC_ACQUIRE, "agent");
            asm volatile("s_waitcnt vmcnt(0)" ::: "memory");
        }
    }
    __syncthreads();
}

struct CvDesc { const float* src; bf16_t* dst; int K, N, mode, tile; };
__device__ __forceinline__ bool cv_decode(CArgsP a, int l, int it, CvDesc& d) {
    bf16_t* W = (bf16_t*)(a->ws + WS_W); const int e = l >> 1, odd = l & 1;
    constexpr int T_FFIN = 8 * 88, T_FFOUT = 22 * 16, T_SQ = 128, T_KV = 8 * 32;
    const int T_MIXIN = odd ? 8 * 44 : 8 * 24;
    int r = it; d.mode = 0;
    if (r < T_FFIN) { d.src = a->in[2] + (size_t)l * 1024 * 5632; d.K = 1024; d.N = 5632; d.dst = W + W_FF1IN; d.mode = 1; d.tile = r; return true; } r -= T_FFIN;
    if (r < T_FFIN) { d.src = a->in[4] + (size_t)l * 1024 * 5632; d.K = 1024; d.N = 5632; d.dst = W + W_FF2IN; d.mode = 1; d.tile = r; return true; } r -= T_FFIN;
    if (r < T_FFOUT) { d.src = a->in[3] + (size_t)l * 2816 * 1024; d.K = 2816; d.N = 1024; d.dst = W + W_FF1OUT; d.tile = r; return true; } r -= T_FFOUT;
    if (r < T_FFOUT) { d.src = a->in[5] + (size_t)l * 2816 * 1024; d.K = 2816; d.N = 1024; d.dst = W + W_FF2OUT; d.tile = r; return true; } r -= T_FFOUT;
    if (r < T_SQ) { d.src = a->in[8] + (size_t)l * 1024 * 1024; d.K = 1024; d.N = 1024; d.dst = W + W_Q; d.tile = r; return true; } r -= T_SQ;
    if (r < T_KV) { d.src = a->in[9] + (size_t)l * 1024 * 2048; d.K = 1024; d.N = 2048; d.dst = W + W_KV; d.tile = r; return true; } r -= T_KV;
    if (r < T_SQ) { d.src = a->in[10] + (size_t)l * 1024 * 1024; d.K = 1024; d.N = 1024; d.dst = W + W_O; d.tile = r; return true; } r -= T_SQ;
    if (r < T_SQ) { d.src = (odd ? a->in[20] : a->in[12]) + (size_t)e * 1024 * 1024; d.K = 1024; d.N = 1024; d.dst = W + W_MIXOUT; d.tile = r; return true; } r -= T_SQ;
    if (r < T_MIXIN) { d.K = 1024; d.dst = W + W_MIXIN; d.tile = r; if (odd) { d.src = a->in[19] + (size_t)e * 1024 * 2816; d.N = 2816; } else { d.src = a->in[11] + (size_t)e * 1024 * 1536; d.N = 1536; } return true; }
    return false;
}
__device__ __forceinline__ void cv_load(const CvDesc& d, int tid, float (&v)[16]) {
    const int ntn = d.N >> 6, k0 = (d.tile / ntn) << 7, n0 = (d.tile % ntn) << 6;
#pragma unroll
    for (int i = 0; i < 16; ++i) v[i] = d.src[(size_t)(k0 + i * 8 + (tid >> 6)) * d.N + n0 + (tid & 63)];
}
__device__ __forceinline__ void convert_layer(CArgsP a, int l, unsigned char* shm) {
    float* tb = (float*)shm; bf16_t* W = (bf16_t*)(a->ws + WS_W);
    const int e = l >> 1, odd = l & 1, tid = otid();
    {
        CvDesc d, nx; float v[16]; int it = blockIdx.x; bool have = cv_decode(a, l, it, d);
        if (have) cv_load(d, tid, v);
        while (have) {
#pragma unroll
            for (int i = 0; i < 16; ++i) tb[(i * 8 + (tid >> 6)) * 65 + (tid & 63)] = v[i];
            __syncthreads();
            it += gridDim.x; const bool hn = cv_decode(a, l, it, nx);
            if (hn) cv_load(nx, tid, v);
            const int ntn = d.N >> 6, k0 = (d.tile / ntn) << 7, n0 = (d.tile % ntn) << 6;
#pragma unroll
            for (int i = 0; i < 8; ++i) { const int nn = i * 8 + (tid >> 6), kk = 2 * (tid & 63), n = n0 + nn; const int row = d.mode ? rowmap<1>(n) : n;
                *(unsigned*)(d.dst + (size_t)row * d.K + k0 + kk) = pk2(tb[kk * 65 + nn], tb[(kk + 1) * 65 + nn]); }
            __syncthreads();
            d = nx; have = hn;
        }
    }
    const int gtid = blockIdx.x * 512 + otid(), nth = gridDim.x * 512;
    if (!odd) {
        const float* pw = a->in[13] + (size_t)e * 4 * 128 * 128;
        for (int idx = gtid; idx < 512 * 512; idx += nth) { const int n = idx >> 9, k = idx & 511, g = n >> 7, d = n & 127, g2 = k >> 7, c = k & 127;
            W[W_AUX1 + idx] = (g == g2) ? f2bf(pw[(g * 128 + c) * 128 + d]) : (bf16_t)0; }
    } else {
        const float* wup = a->in[23] + (size_t)e * 64 * 512; const float* aup = a->in[25] + (size_t)e * 64 * 512; const float* gup = a->in[26] + (size_t)e * 128 * 512;
        for (int idx = gtid; idx < 1536 * 256; idx += nth) { const int n = idx >> 8, k = idx & 255, kind = n >> 9, j = n & 511; float v = 0.f;
            if (kind == 0) { if (k < 64) v = wup[k * 512 + j]; } else if (kind == 1) { if (k >= 64 && k < 128) v = aup[(k - 64) * 512 + j]; } else { if (k >= 128) v = gup[(k - 128) * 512 + j]; }
            W[W_AUX1 + idx] = f2bf(v); }
        const float* wa = a->in[34] + (size_t)e * 8 * 64 * 64; const float* wx = a->in[36] + (size_t)e * 8 * 64 * 64;
        for (int idx = gtid; idx < 1024 * 512; idx += nth) { const int n = idx >> 9, k = idx & 511, pn = n >> 8, bj = (n >> 7) & 1, cc = n & 127, ch = pn * 128 + cc, hb = ch >> 6, jj = ch & 63; float v = 0.f;
            if ((k >> 6) == hb) v = (bj ? wx : wa)[(hb * 64 + (k & 63)) * 64 + jj];
            W[W_AUX2 + idx] = f2bf(v); }
    }
}
__device__ __forceinline__ void prologue_cast(CArgsP a) {
    const int gtid = blockIdx.x * 512 + otid(), nth = gridDim.x * 512;
    const f32x4* x4 = (const f32x4*)a->in[0]; u32x2* xb = (u32x2*)(a->ws + WS_XB);
    for (int i0 = gtid; i0 < NTOK * DM / 4; i0 += nth * 8) { f32x4 v[8];
#pragma unroll
        for (int u = 0; u < 8; ++u) { const int i = i0 + u * nth; v[u] = (i < NTOK * DM / 4) ? x4[i] : (f32x4){0.f, 0.f, 0.f, 0.f}; }
#pragma unroll
        for (int u = 0; u < 8; ++u) { const int i = i0 + u * nth; if (i < NTOK * DM / 4) { u32x2 o; o.x = pk2(v[u][0], v[u][1]); o.y = pk2(v[u][2], v[u][3]); xb[i] = o; ((h16x4*)a->out)[i] = __builtin_convertvector(v[u], h16x4); } } }
    { float* MR = (float*)(a->ws + WS_MR); for (int i = gtid; i < NTOK; i += nth) { MR[2 * i] = 0.f; MR[2 * i + 1] = 1.f; } }
    const f32x4* m4 = (const f32x4*)a->in[1]; u32x2* mb = (u32x2*)(a->ws + WS_MISC + 2 * MiB);
    for (int i = gtid; i < 512 * DM / 4; i += nth) { const f32x4 v = m4[i]; u32x2 o; o.x = pk2(v[0], v[1]); o.y = pk2(v[2], v[3]); mb[i] = o; }
}
#define DPP_F(v, ctrl) __builtin_bit_cast(float, __builtin_amdgcn_update_dpp(0, __builtin_bit_cast(int, (v)), (ctrl), 0xF, 0xF, false))
__device__ __forceinline__ float wsum_fast(float v) {
    v += DPP_F(v, 0xB1); v += DPP_F(v, 0x4E); v += DPP_F(v, 0x141); v += DPP_F(v, 0x140);
    const int iv = __builtin_bit_cast(int, v);
    const float s0 = __builtin_bit_cast(float, __builtin_amdgcn_readlane(iv, 0)), s1 = __builtin_bit_cast(float, __builtin_amdgcn_readlane(iv, 16));
    const float s2 = __builtin_bit_cast(float, __builtin_amdgcn_readlane(iv, 32)), s3 = __builtin_bit_cast(float, __builtin_amdgcn_readlane(iv, 48));
    return (s0 + s1) + (s2 + s3);
}
__device__ __forceinline__ void ln_phase(const void* zin, float* xo, bf16_t* XB, float* MR, const float* g, const float* b, int bofs, int nblk) {
    const int lane = otid() & 63, wave = otid() >> 6;
    int row = ((int)blockIdx.x - bofs) * 8 + wave; const int rstep = nblk * 8;
    {
        f32x4 g4[2][2], b4[2][2];
#pragma unroll
        for (int j = 0; j < 2; ++j)
#pragma unroll
            for (int q = 0; q < 2; ++q) { g4[j][q] = *(const f32x4*)(g + 8 * lane + 512 * j + 4 * q); b4[j][q] = *(const f32x4*)(b + 8 * lane + 512 * j + 4 * q); }
        h16x8 nx[2];
        if (row < NTOK) {
#pragma unroll
            for (int j = 0; j < 2; ++j) nx[j] = *(const h16x8*)((const h16*)zin + (size_t)row * DM + 8 * lane + 512 * j);
        }
        for (; row < NTOK; row += rstep) {
            float v[2][8]; float s = 0.f;
#pragma unroll
            for (int j = 0; j < 2; ++j)
#pragma unroll
                for (int q = 0; q < 8; ++q) { v[j][q] = (float)nx[j][q]; s += v[j][q]; }
            if (row + rstep < NTOK) {
#pragma unroll
                for (int j = 0; j < 2; ++j) nx[j] = *(const h16x8*)((const h16*)zin + (size_t)(row + rstep) * DM + 8 * lane + 512 * j);
            }
            const float mean = wsum_fast(s) * (1.f / DM); float s2 = 0.f;
#pragma unroll
            for (int j = 0; j < 2; ++j)
#pragma unroll
                for (int q = 0; q < 8; ++q) { v[j][q] -= mean; s2 += v[j][q] * v[j][q]; }
            const float rstd = rsqrtf(wsum_fast(s2) * (1.f / DM) + 1e-5f);
            if (lane == 0) { MR[2 * row] = mean; MR[2 * row + 1] = rstd; }
#pragma unroll
            for (int j = 0; j < 2; ++j) { float y[8];
#pragma unroll
                for (int q = 0; q < 8; ++q) y[q] = v[j][q] * rstd * g4[j][q >> 2][q & 3] + b4[j][q >> 2][q & 3];
                u32x4 o; o.x = pk2(y[0], y[1]); o.y = pk2(y[2], y[3]); o.z = pk2(y[4], y[5]); o.w = pk2(y[6], y[7]);
                *(u32x4*)(XB + (size_t)row * DM + 8 * lane + 512 * j) = o; }
        }
    }
}
__device__ __forceinline__ void ln_final_load(const h16* zin, h16x8 (&zr)[16][2]) {
    const int lane = otid() & 63, wave = otid() >> 6;
#pragma unroll
    for (int i = 0; i < 16; ++i) { const int row = (int)blockIdx.x * 8 + wave + i * (int)gridDim.x * 8;
#pragma unroll
        for (int j = 0; j < 2; ++j) zr[i][j] = (row < NTOK) ? *(const h16x8*)(zin + (size_t)row * DM + 8 * lane + 512 * j) : (h16x8)(h16)0; }
}
__device__ __forceinline__ void ln_final_store(const h16x8 (&zr)[16][2], float* xo, const float* g, const float* b) {
    const int lane = otid() & 63, wave = otid() >> 6;
    f32x4 g4[2][2], b4[2][2];
#pragma unroll
    for (int j = 0; j < 2; ++j)
#pragma unroll
        for (int q = 0; q < 2; ++q) { g4[j][q] = *(const f32x4*)(g + 8 * lane + 512 * j + 4 * q); b4[j][q] = *(const f32x4*)(b + 8 * lane + 512 * j + 4 * q); }
#pragma unroll
    for (int i = 0; i < 16; ++i) { const int row = (int)blockIdx.x * 8 + wave + i * (int)gridDim.x * 8; float v[2][8]; float s = 0.f;
#pragma unroll
        for (int j = 0; j < 2; ++j)
#pragma unroll
            for (int q = 0; q < 8; ++q) { v[j][q] = (float)zr[i][j][q]; s += v[j][q]; }
        const float mean = wsum_fast(s) * (1.f / DM); float s2 = 0.f;
#pragma unroll
        for (int j = 0; j < 2; ++j)
#pragma unroll
            for (int q = 0; q < 8; ++q) { v[j][q] -= mean; s2 += v[j][q] * v[j][q]; }
        const float rstd = rsqrtf(wsum_fast(s2) * (1.f / DM) + 1e-5f);
        if (row < NTOK) {
#pragma unroll
            for (int j = 0; j < 2; ++j)
#pragma unroll
                for (int q = 0; q < 2; ++q) { f32x4 y;
#pragma unroll
                    for (int t = 0; t < 4; ++t) y[t] = v[j][4 * q + t] * rstd * g4[j][q][t] + b4[j][q][t];
                    *(f32x4*)(xo + (size_t)row * DM + 8 * lane + 512 * j + 4 * q) = y; } } }
}
constexpr int AT_LD = 528;
__device__ __forceinline__ void attn_fill(LAS unsigned char* lds, const bf16_t* src, int ld_src, int tid) {
#pragma unroll 1
    for (int hb = 0; hb < 16; hb += 8) { u32x4 t[8];
#pragma unroll
        for (int i = 0; i < 8; ++i) { const int id = (hb + i) * 512 + tid, row = id >> 5, c = id & 31; t[i] = *(const u32x4*)(src + (size_t)row * ld_src + c * 8); }
#pragma unroll
        for (int i = 0; i < 8; ++i) { const int id = (hb + i) * 512 + tid, row = id >> 5, c = id & 31; *(LAS u32x4*)(lds + row * AT_LD + c * 16) = t[i]; } }
}
__device__ __forceinline__ void attn_phase(const bf16_t* Q, const bf16_t* Kb, const bf16_t* VT, bf16_t* O, unsigned char* shm) {
    const int tid = otid(), lane = tid & 63, wave = tid >> 6, fr = lane & 15, fq = lane >> 4;
    LAS unsigned char* lds = (LAS unsigned char*)shm;
    for (int item = blockIdx.x; item < 512; item += gridDim.x) {
        const int bh = item & 7, b = bh >> 2, h = bh & 3, row0 = b * SEQ + (item >> 3) * 256 + wave * 32;
        bf16x8 qf[2][8];
#pragma unroll
        for (int t = 0; t < 2; ++t)
#pragma unroll
            for (int ks = 0; ks < 8; ++ks) qf[t][ks] = *(const bf16x8*)(Q + (size_t)(row0 + t * 16 + fr) * DM + h * 256 + ks * 32 + fq * 8);
        attn_fill(lds, Kb + (size_t)(b * 256) * DM + h * 256, DM, tid);
        __syncthreads();
        f32x4 s[2][16];
        {
            bf16x8 kf[3][2]; f32x4 a0 = {0.f, 0.f, 0.f, 0.f}, a1 = {0.f, 0.f, 0.f, 0.f};
            const LAS unsigned char* kb = lds + fr * AT_LD + fq * 16;
#pragma unroll
            for (int pg = 0; pg < 2; ++pg)
#pragma unroll
                for (int ks = 0; ks < 2; ++ks) kf[pg][ks] = *(const LAS bf16x8*)(kb + pg * 128 + ks * 64);
#pragma unroll
            for (int g = 0; g < 64; ++g) { const int mt = g >> 2, qd = g & 3;
                if (g + 2 < 64) { const int ng = g + 2; const LAS unsigned char* np = kb + (ng >> 2) * 16 * AT_LD + (ng & 3) * 128;
#pragma unroll
                    for (int ks = 0; ks < 2; ++ks) kf[ng % 3][ks] = *(const LAS bf16x8*)(np + ks * 64); }
                __builtin_amdgcn_sched_barrier(0);
#pragma unroll
                for (int ks = 0; ks < 2; ++ks) { const bf16x8 kv = kf[g % 3][ks];
                    a0 = __builtin_amdgcn_mfma_f32_16x16x32_bf16(kv, qf[0][qd * 2 + ks], a0, 0, 0, 0); a1 = __builtin_amdgcn_mfma_f32_16x16x32_bf16(kv, qf[1][qd * 2 + ks], a1, 0, 0, 0); }
                if (qd == 3) { s[0][mt] = a0; s[1][mt] = a1; a0 = (f32x4){0.f, 0.f, 0.f, 0.f}; a1 = (f32x4){0.f, 0.f, 0.f, 0.f}; }
                __builtin_amdgcn_sched_barrier(0); }
        }
        bf16x8 pb[2][8]; float inv[2];
#pragma unroll
        for (int t = 0; t < 2; ++t) { float mx = -3.0e38f;
#pragma unroll
            for (int mt = 0; mt < 16; ++mt)
#pragma unroll
                for (int q = 0; q < 4; ++q) mx = fmaxf(mx, s[t][mt][q]);
            mx = fmaxf(mx, __shfl_xor(mx, 16)); mx = fmaxf(mx, __shfl_xor(mx, 32));
            float sum = 0.f;
#pragma unroll
            for (int mt = 0; mt < 16; ++mt)
#pragma unroll
                for (int q = 0; q < 4; ++q) { const float pv = __expf(s[t][mt][q] - mx); s[t][mt][q] = pv; sum += pv; }
            sum += __shfl_xor(sum, 16); sum += __shfl_xor(sum, 32); inv[t] = 1.0f / sum;
#pragma unroll
            for (int kp = 0; kp < 8; ++kp) { u32x4 tt; tt.x = pk2(s[t][2 * kp][0], s[t][2 * kp][1]); tt.y = pk2(s[t][2 * kp][2], s[t][2 * kp][3]); tt.z = pk2(s[t][2 * kp + 1][0], s[t][2 * kp + 1][1]); tt.w = pk2(s[t][2 * kp + 1][2], s[t][2 * kp + 1][3]);
                pb[t][kp] = __builtin_bit_cast(bf16x8, tt); } }
        __syncthreads();
        attn_fill(lds, VT + (size_t)((b * 4 + h) * 256) * 256, 256, tid);
        __syncthreads();
        {
            u32x2 vA[8], vB[8]; f32x4 a0 = {0.f, 0.f, 0.f, 0.f}, a1 = {0.f, 0.f, 0.f, 0.f};
            const LAS unsigned char* vb = lds + fr * AT_LD + fq * 8;
#pragma unroll
            for (int q = 0; q < 8; ++q) vA[q] = *(const LAS u32x2*)(vb + q * 32);
#pragma unroll
            for (int g = 0; g < 32; ++g) { const int dt = g >> 1, hf = g & 1;
                if (g + 1 < 32) { const int ndt = (g + 1) >> 1, nhf = (g + 1) & 1; const LAS unsigned char* np = vb + ndt * 16 * AT_LD + nhf * 256;
#pragma unroll
                    for (int q = 0; q < 8; ++q) { if (g & 1) vA[q] = *(const LAS u32x2*)(np + q * 32); else vB[q] = *(const LAS u32x2*)(np + q * 32); } }
                __builtin_amdgcn_sched_barrier(0);
#pragma unroll
                for (int kq = 0; kq < 4; ++kq) { const u32x2 lo = (g & 1) ? vB[2 * kq] : vA[2 * kq], hi = (g & 1) ? vB[2 * kq + 1] : vA[2 * kq + 1]; u32x4 tt; tt.x = lo.x; tt.y = lo.y; tt.z = hi.x; tt.w = hi.y;
                    const bf16x8 vf = __builtin_bit_cast(bf16x8, tt);
                    a0 = __builtin_amdgcn_mfma_f32_16x16x32_bf16(vf, pb[0][hf * 4 + kq], a0, 0, 0, 0); a1 = __builtin_amdgcn_mfma_f32_16x16x32_bf16(vf, pb[1][hf * 4 + kq], a1, 0, 0, 0); }
                if (hf) { u32x2 o; o.x = pk2(a0[0] * inv[0], a0[1] * inv[0]); o.y = pk2(a0[2] * inv[0], a0[3] * inv[0]);
                    *(u32x2*)(O + (size_t)(row0 + fr) * DM + h * 256 + dt * 16 + fq * 4) = o;
                    o.x = pk2(a1[0] * inv[1], a1[1] * inv[1]); o.y = pk2(a1[2] * inv[1], a1[3] * inv[1]);
                    *(u32x2*)(O + (size_t)(row0 + 16 + fr) * DM + h * 256 + dt * 16 + fq * 4) = o;
                    a0 = (f32x4){0.f, 0.f, 0.f, 0.f}; a1 = (f32x4){0.f, 0.f, 0.f, 0.f}; }
                __builtin_amdgcn_sched_barrier(0); }
        }
        __syncthreads();
    }
}
__device__ __forceinline__ void even_core(CArgsP a, int e, unsigned char* shm) {
    const bf16_t* H = (const bf16_t*)(a->ws + WS_H); bf16_t* POOLED = (bf16_t*)(a->ws + WS_LO); bf16_t* CONCAT = (bf16_t*)(a->ws + WS_XB);
    const int tid = otid(), lane = tid & 63, wave = tid >> 6;
    LAS float* Wl = (LAS float*)shm; LAS float* Vl = Wl + 128 * 129; LAS float* st = Vl + 128 * 128;
    const float* sgw = a->in[17] + (size_t)e * 4 * 128 * 128; const float* sgb = a->in[18] + (size_t)e * 4 * 128;
    const float* lng = a->in[15] + (size_t)e * 512; const float* lnb = a->in[16] + (size_t)e * 512;
    for (int chunk = blockIdx.x; chunk < NTOK / 128; chunk += gridDim.x) {
        const int tok0 = chunk * 128, tseq0 = tok0 & (SEQ - 1);
        {
            const int c = tid, grp = c >> 7; float hist[16]; hist[0] = 0.f;
#pragma unroll
            for (int u = 1; u < 16; ++u) { const int p = u - 16; hist[u] = (tseq0 + p >= 0) ? bf2f(H[(size_t)(tok0 + p) * 1536 + c]) : 0.f; }
            for (int tb = 0; tb < 128; tb += 16) {
#pragma unroll
                for (int u = 0; u < 16; ++u) { const int t = tb + u; const float x = bf2f(H[(size_t)(tok0 + t) * 1536 + c]); hist[u] = x;
                    const float s2 = x + hist[(u + 15) & 15];
                    const float s4 = s2 + hist[(u + 14) & 15] + hist[(u + 13) & 15];
                    const float s8 = s4 + (hist[(u + 12) & 15] + hist[(u + 11) & 15]) + (hist[(u + 10) & 15] + hist[(u + 9) & 15]);
                    const float s16 = s8 + ((hist[(u + 8) & 15] + hist[(u + 7) & 15]) + (hist[(u + 6) & 15] + hist[(u + 5) & 15])) + ((hist[(u + 4) & 15] + hist[(u + 3) & 15]) + (hist[(u + 2) & 15] + hist[(u + 1) & 15]));
                    const float sum = grp == 0 ? s2 : grp == 1 ? s4 : grp == 2 ? s8 : s16; const int win = 2 << grp, pos = tseq0 + t + 1;
                    const float dv = (float)(pos < win ? pos : win);
                    POOLED[(size_t)(tok0 + t) * 512 + c] = f2bf(sum / dv - x); }
            }
        }
#pragma unroll 8
        for (int i = 0; i < 16; ++i) { const int t = wave + 8 * i; const bf16x8 v8 = *(const bf16x8*)(H + (size_t)(tok0 + t) * 1536 + 1024 + lane * 8); float f[8], s = 0.f;
#pragma unroll
            for (int q = 0; q < 8; ++q) { f[q] = bfs2f(v8[q]); s += f[q]; }
            const float mean = wsum_fast(s) * (1.f / 512.f); float s2 = 0.f;
#pragma unroll
            for (int q = 0; q < 8; ++q) { const float d = f[q] - mean; s2 += d * d; }
            const float var = wsum_fast(s2) * (1.f / 512.f);
            if (lane == 0) { st[2 * t] = mean; st[2 * t + 1] = rsqrtf(var + 1e-5f); } }
        __syncthreads();
        for (int h = 0; h < 4; ++h) {
#pragma unroll
            for (int it = 0; it < 8; ++it) { const int idx = it * 512 + tid, t = idx >> 5, s0 = (idx & 31) * 4; const f32x4 w4 = *(const f32x4*)(sgw + (size_t)(h * 128 + t) * 128 + s0);
#pragma unroll
                for (int q = 0; q < 4; ++q) Wl[t * 129 + s0 + q] = (s0 + q <= t) ? w4[q] : 0.f; }
#pragma unroll
            for (int it = 0; it < 4; ++it) { const int idx = it * 512 + tid, s = idx >> 4, d0 = (idx & 15) * 8; const bf16x8 v8 = *(const bf16x8*)(H + (size_t)(tok0 + s) * 1536 + 1024 + h * 128 + d0);
                const float mean = st[2 * s], rstd = st[2 * s + 1];
#pragma unroll
                for (int q = 0; q < 8; ++q) Vl[s * 128 + d0 + q] = (bfs2f(v8[q]) - mean) * rstd * lng[h * 128 + d0 + q] + lnb[h * 128 + d0 + q]; }
            __syncthreads();
            const int d0 = (tid & 15) * 8, t0 = (tid >> 4) * 4;
            float acc[4][8];
#pragma unroll
            for (int i = 0; i < 4; ++i)
#pragma unroll
                for (int q = 0; q < 8; ++q) acc[i][q] = 0.f;
            for (int s = 0; s <= t0 + 3; ++s) { const f32x4 va = *(const LAS f32x4*)(Vl + s * 128 + d0), vb = *(const LAS f32x4*)(Vl + s * 128 + d0 + 4);
#pragma unroll
                for (int i = 0; i < 4; ++i) { const float w = Wl[(t0 + i) * 129 + s];
#pragma unroll
                    for (int q = 0; q < 4; ++q) { acc[i][q] += w * va[q]; acc[i][4 + q] += w * vb[q]; } } }
#pragma unroll
            for (int i = 0; i < 4; ++i) { const int t = t0 + i; const float bias = sgb[h * 128 + t]; const bf16x8 u8 = *(const bf16x8*)(H + (size_t)(tok0 + t) * 1536 + 512 + h * 128 + d0);
                float o[8];
#pragma unroll
                for (int q = 0; q < 8; ++q) o[q] = bfs2f(u8[q]) * (acc[i][q] + bias);
                u32x4 ov; ov.x = pk2(o[0], o[1]); ov.y = pk2(o[2], o[3]); ov.z = pk2(o[4], o[5]); ov.w = pk2(o[6], o[7]);
                *(u32x4*)(CONCAT + (size_t)(tok0 + t) * 1024 + 512 + h * 128 + d0) = ov; }
            __syncthreads();
        }
    }
}
__device__ __forceinline__ void odd_prep(CArgsP a, int e) {
    const bf16_t* H = (const bf16_t*)(a->ws + WS_H); bf16_t* AP = (bf16_t*)(a->ws + WS_AP); bf16_t* XC = (bf16_t*)(a->ws + WS_XC);
    const float* mu = a->in[21] + (size_t)e * 1792; const float* cw = a->in[32] + (size_t)e * 4 * 512; const float* cb = a->in[33] + (size_t)e * 512;
    const int gtid = blockIdx.x * 512 + otid(), nth = gridDim.x * 512;
    const bf16x8 z8 = {0, 0, 0, 0, 0, 0, 0, 0};
    for (int it0 = gtid; it0 < NTOK * 32; it0 += nth * 4) { bf16x8 cur[4], prv[4];
#pragma unroll
        for (int u = 0; u < 4; ++u) { const int it = it0 + u * nth, tok = it >> 5, c0 = (it & 31) * 8; const bool ok = it < NTOK * 32;
            cur[u] = ok ? *(const bf16x8*)(H + (size_t)tok * 2816 + 1536 + c0) : z8;
            prv[u] = (ok && (tok & (SEQ - 1))) ? *(const bf16x8*)(H + (size_t)(tok - 1) * 2816 + 1536 + c0) : z8; }
#pragma unroll
        for (int u = 0; u < 4; ++u) { const int it = it0 + u * nth, tok = it >> 5, c0 = (it & 31) * 8; if (it < NTOK * 32) { float v[8];
#pragma unroll
            for (int q = 0; q < 8; ++q) { const float c = bfs2f(cur[u][q]), z = c + mu[1536 + c0 + q] * (bfs2f(prv[u][q]) - c); v[q] = c0 < 64 ? tanhf_(z) : (c0 < 128 ? z : sigmoidf_(z)); }
            u32x4 o; o.x = pk2(v[0], v[1]); o.y = pk2(v[2], v[3]); o.z = pk2(v[4], v[5]); o.w = pk2(v[6], v[7]); *(u32x4*)(AP + (size_t)tok * 256 + c0) = o; } } }
    for (int it0 = gtid; it0 < NTOK * 64; it0 += nth * 4) { bf16x8 x8[4][4];
#pragma unroll
        for (int u = 0; u < 4; ++u) { const int it = it0 + u * nth, tok = it >> 6, c0 = (it & 63) * 8, tseq = tok & (SEQ - 1); const bool ok = it < NTOK * 64;
#pragma unroll
            for (int i = 0; i < 4; ++i) x8[u][i] = (ok && tseq - 3 + i >= 0) ? *(const bf16x8*)(H + (size_t)(tok - 3 + i) * 2816 + 2304 + c0) : z8; }
#pragma unroll
        for (int u = 0; u < 4; ++u) { const int it = it0 + u * nth, tok = it >> 6, c0 = (it & 63) * 8; if (it < NTOK * 64) { float v[8];
#pragma unroll
            for (int q = 0; q < 8; ++q) v[q] = cb[c0 + q];
#pragma unroll
            for (int i = 0; i < 4; ++i)
#pragma unroll
                for (int q = 0; q < 8; ++q) v[q] += cw[i * 512 + c0 + q] * bfs2f(x8[u][i][q]);
            u32x4 o; o.x = pk2(v[0], v[1]); o.y = pk2(v[2], v[3]); o.z = pk2(v[4], v[5]); o.w = pk2(v[6], v[7]); *(u32x4*)(XC + (size_t)tok * 512 + c0) = o; } } }
}
constexpr int RW_STEP = 448, RW_WAVE = 8 * RW_STEP + 8;
typedef float f32x2 __attribute__((ext_vector_type(2)));
__device__ __forceinline__ float red8(float v) {
    v += __builtin_bit_cast(float, __builtin_amdgcn_update_dpp(0, __builtin_bit_cast(int, v), 0xB1, 0xF, 0xF, false));
    v += __builtin_bit_cast(float, __builtin_amdgcn_update_dpp(0, __builtin_bit_cast(int, v), 0x4E, 0xF, 0xF, false));
    v += __builtin_bit_cast(float, __builtin_amdgcn_update_dpp(0, __builtin_bit_cast(int, v), 0x141, 0xF, 0xF, false));
    return v;
}
__device__ __forceinline__ float red4(float v) { v += DPP_F(v, 0xB1); v += DPP_F(v, 0x4E); return v; }
#define LD8P(dst, ptr) do { _Pragma("unroll") for (int _q = 0; _q < 4; ++_q) { const f32x4 _t = *(const LAS f32x4*)((ptr) + 4 * _q); dst[2 * _q] = (f32x2){_t[0], _t[1]}; dst[2 * _q + 1] = (f32x2){_t[2], _t[3]}; } } while (0)
template <int MODE> __device__ __forceinline__ void rwkv_scan(CArgsP a, int e, int bh, int c, LAS float* wl) {
    const int lane = otid() & 63, b = bh >> 3, h = bh & 7, cj = h * 64 + lane, ib = lane >> 2, jb = lane & 3;
    const bf16_t* H = (const bf16_t*)(a->ws + WS_H); const bf16_t* LO = (const bf16_t*)(a->ws + WS_LO); bf16_t* CONCAT = (bf16_t*)(a->ws + WS_XB);
    float* Lc = (float*)(a->ws + WS_AP); float* Mc = Lc + (size_t)16 * NCH * 4096; float* Ss = Mc + (size_t)16 * NCH * 4096;
    const size_t sidx = ((size_t)bh * NCH + c) * 4096 + (size_t)(ib * 4) * 64 + jb * 16;
    const int tok0 = b * SEQ + c * TCH;
    const float* mu = a->in[21] + (size_t)e * 1792;
    const float mu_r = mu[cj], mu_k = mu[512 + cj], mu_v = mu[1024 + cj], kkc = a->in[27][e * 512 + cj], kac = a->in[28][e * 512 + cj], rkc = a->in[29][e * 512 + cj];
    const float gng = a->in[30][e * 512 + cj], gnb = a->in[31][e * 512 + cj];
    const float w0c = a->in[22][e * 512 + cj], a0c = a->in[24][e * 512 + cj];
    f32x2 S[4][8];
    if (MODE == 2) {
#pragma unroll
        for (int r = 0; r < 4; ++r)
#pragma unroll
            for (int q = 0; q < 4; ++q) { const f32x4 t = *(const f32x4*)(Ss + sidx + r * 64 + 4 * q); S[r][2 * q] = (f32x2){t[0], t[1]}; S[r][2 * q + 1] = (f32x2){t[2], t[3]}; }
    } else {
#pragma unroll
        for (int r = 0; r < 4; ++r)
#pragma unroll
            for (int q = 0; q < 8; ++q) { const int row = ib * 4 + r, col = jb * 16 + 2 * q; S[r][q][0] = (MODE == 1 && row == col) ? 1.f : 0.f; S[r][q][1] = (MODE == 1 && row == col + 1) ? 1.f : 0.f; }
    }
    float pr = 0.f, pk = 0.f, pv = 0.f;
    if (c > 0) { const bf16_t* hp = H + (size_t)(tok0 - 1) * 2816 + cj; pr = bf2f(hp[0]); pk = bf2f(hp[512]); pv = bf2f(hp[1024]); }
    unsigned short rw[8][6];
#define RW_LOAD(T0) do { _Pragma("unroll") for (int s = 0; s < 8; ++s) { const size_t tok = (size_t)(tok0 + (T0) + s); const bf16_t* hp = H + tok * 2816 + cj; const bf16_t* lp = LO + tok * 1536 + cj; \
        rw[s][0] = hp[0]; rw[s][1] = hp[512]; rw[s][2] = hp[1024]; rw[s][3] = lp[0]; rw[s][4] = lp[512]; if (MODE == 2) rw[s][5] = lp[1024]; } } while (0)
    RW_LOAD(0);
    for (int t0 = 0; t0 < TCH; t0 += 8) {
#pragma unroll
        for (int s = 0; s < 8; ++s) {
            const float rr = bf2f(rw[s][0]), kr = bf2f(rw[s][1]), vr = bf2f(rw[s][2]), ee = __expf(-softplusf_(-(w0c + bf2f(rw[s][3]))) - 0.5f), aa = sigmoidf_(a0c + bf2f(rw[s][4]));
            const float rl = rr + mu_r * (pr - rr), kl = kr + mu_k * (pk - kr), vl = vr + mu_v * (pv - vr); pr = rr; pk = kr; pv = vr;
            const float kkj = kl * kkc, ss = wsum_fast(kkj * kkj), kn = kkj * rsqrtf(fmaxf(ss, 1e-24f));
            const float kp = kl * (1.0f + (aa - 1.0f) * kac), dec = __expf(-ee);
            LAS float* base = wl + s * RW_STEP;
            base[lane] = -kn; base[64 + lane] = dec; base[128 + lane] = kn * aa; base[192 + lane] = kp; base[320 + lane] = vl;
            if (MODE == 2) { base[256 + lane] = rl; base[384 + lane] = bf2f(rw[s][5]); const float bd = wsum_fast(rl * kp * rkc); if (lane == 0) wl[8 * RW_STEP + s] = bd; } }
        if (t0 + 8 < TCH) RW_LOAD(t0 + 8);
        LDS_SYNC_WAVE();
#pragma unroll 2
        for (int s = 0; s < 8; ++s) { const LAS float* base = wl + s * RW_STEP;
            f32x2 av[8], dc[8], bv[8], kp[8]; f32x4 vr4 = {0.f, 0.f, 0.f, 0.f};
            LD8P(av, base + jb * 16); LD8P(dc, base + 64 + jb * 16); LD8P(bv, base + 128 + jb * 16);
            if (MODE != 1) { LD8P(kp, base + 192 + jb * 16); vr4 = *(const LAS f32x4*)(base + 320 + ib * 4); }
            float sa[4];
#pragma unroll
            for (int r = 0; r < 4; ++r) { f32x2 p = S[r][0] * av[0];
#pragma unroll
                for (int q = 1; q < 8; ++q) p += S[r][q] * av[q];
                sa[r] = red4(p[0] + p[1]); }
#pragma unroll
            for (int r = 0; r < 4; ++r) { const f32x2 sa2 = (f32x2){sa[r], sa[r]};
                if (MODE == 1) {
#pragma unroll
                    for (int q = 0; q < 8; ++q) S[r][q] = S[r][q] * dc[q] + sa2 * bv[q];
                } else { const f32x2 v2 = (f32x2){vr4[r], vr4[r]};
#pragma unroll
                    for (int q = 0; q < 8; ++q) S[r][q] = S[r][q] * dc[q] + (sa2 * bv[q] + v2 * kp[q]); } }
            if (MODE == 2) { f32x2 rv[8]; LD8P(rv, base + 256 + jb * 16);
                float y = 0.f;
#pragma unroll
                for (int r = 0; r < 4; ++r) { f32x2 p = S[r][0] * rv[0];
#pragma unroll
                    for (int q = 1; q < 8; ++q) p += S[r][q] * rv[q];
                    const float yr = red4(p[0] + p[1]); y = (jb == r) ? yr : y; }
                const float vi = base[320 + lane];
                const float mean = wsum_fast(y) * (1.f / 64.f), ey2 = wsum_fast(y * y) * (1.f / 64.f), dl = y - mean, var = fmaxf(ey2 - mean * mean, 0.f);
                const float yn = dl * rsqrtf(var + 64e-5f) * gng + gnb;
                const float o = (yn + wl[8 * RW_STEP + s] * vi) * base[384 + lane];
                CONCAT[(size_t)(tok0 + t0 + s) * 1024 + cj] = f2bf(o); } }
        LDS_SYNC_WAVE();
    }
#undef RW_LOAD
    if (MODE != 2) { float* dst = (MODE == 0 ? Lc : Mc) + sidx;
#pragma unroll
        for (int r = 0; r < 4; ++r)
#pragma unroll
            for (int q = 0; q < 4; ++q) { f32x4 t; t[0] = S[r][2 * q][0]; t[1] = S[r][2 * q][1]; t[2] = S[r][2 * q + 1][0]; t[3] = S[r][2 * q + 1][1]; *(f32x4*)(dst + r * 64 + 4 * q) = t; } }
}
template <int MODE> __device__ __forceinline__ void rwkv_pass1_pair(CArgsP a, int e, int bh, int c, LAS float* pl) {
    const int lane = otid() & 63, b = bh >> 3, h = bh & 7, cj = h * 64 + lane, ib = lane >> 2, jb = lane & 3;
    const bf16_t* H = (const bf16_t*)(a->ws + WS_H); const bf16_t* LO = (const bf16_t*)(a->ws + WS_LO);
    float* Lc = (float*)(a->ws + WS_AP); float* Mc = Lc + (size_t)16 * NCH * 4096;
    const size_t sidx = ((size_t)bh * NCH + c) * 4096 + (size_t)(ib * 4) * 64 + jb * 16;
    const int tok0 = b * SEQ + c * TCH;
    const float* mu = a->in[21] + (size_t)e * 1792;
    const float mu_k = mu[512 + cj], mu_v = mu[1024 + cj], kkc = a->in[27][e * 512 + cj], kac = a->in[28][e * 512 + cj];
    const float w0c = a->in[22][e * 512 + cj], a0c = a->in[24][e * 512 + cj];
    f32x2 S[4][8];
#pragma unroll
    for (int r = 0; r < 4; ++r)
#pragma unroll
        for (int q = 0; q < 8; ++q) { const int row = ib * 4 + r, col = jb * 16 + 2 * q; S[r][q][0] = (MODE == 1 && row == col) ? 1.f : 0.f; S[r][q][1] = (MODE == 1 && row == col + 1) ? 1.f : 0.f; }
    unsigned short rw[5][4];
#define RW1_LOAD(T0) do { _Pragma("unroll") for (int s = 0; s < 5; ++s) { const int tk = tok0 + (T0) + MODE * 4 + s - 1; const bf16_t* hp = H + (size_t)tk * 2816 + cj; const bf16_t* lp = LO + (size_t)tk * 1536 + cj; \
        if (s == 0) { const bool have = (c > 0) || ((T0) + MODE * 4 > 0); rw[0][0] = have ? hp[512] : (unsigned short)0; rw[0][1] = have ? hp[1024] : (unsigned short)0; } \
        else { rw[s][0] = hp[512]; rw[s][1] = hp[1024]; rw[s][2] = lp[0]; rw[s][3] = lp[512]; } } } while (0)
    RW1_LOAD(0);
    for (int t0 = 0; t0 < TCH; t0 += 8) {
        float pk = bf2f(rw[0][0]), pv = bf2f(rw[0][1]);
#pragma unroll
        for (int u = 0; u < 4; ++u) { const int s = MODE * 4 + u;
            const float kr = bf2f(rw[u + 1][0]), vr = bf2f(rw[u + 1][1]), ee = __expf(-softplusf_(-(w0c + bf2f(rw[u + 1][2]))) - 0.5f), aa = sigmoidf_(a0c + bf2f(rw[u + 1][3]));
            const float kl = kr + mu_k * (pk - kr), vl = vr + mu_v * (pv - vr); pk = kr; pv = vr;
            const float kkj = kl * kkc, ss = wsum_fast(kkj * kkj), kn = kkj * rsqrtf(fmaxf(ss, 1e-24f));
            const float kp = kl * (1.0f + (aa - 1.0f) * kac), dec = __expf(-ee);
            LAS float* base = pl + s * RW_STEP;
            base[lane] = -kn; base[64 + lane] = dec; base[128 + lane] = kn * aa; base[192 + lane] = kp; base[320 + lane] = vl; }
        if (t0 + 8 < TCH) RW1_LOAD(t0 + 8);
        __syncthreads();
#pragma unroll 2
        for (int s = 0; s < 8; ++s) { const LAS float* base = pl + s * RW_STEP;
            f32x2 av[8], dc[8], bv[8], kp[8]; f32x4 vr4 = {0.f, 0.f, 0.f, 0.f};
            LD8P(av, base + jb * 16); LD8P(dc, base + 64 + jb * 16); LD8P(bv, base + 128 + jb * 16);
            if (MODE == 0) { LD8P(kp, base + 192 + jb * 16); vr4 = *(const LAS f32x4*)(base + 320 + ib * 4); }
            float sa[4];
#pragma unroll
            for (int r = 0; r < 4; ++r) { f32x2 pp = S[r][0] * av[0];
#pragma unroll
                for (int q = 1; q < 8; ++q) pp += S[r][q] * av[q];
                sa[r] = red4(pp[0] + pp[1]); }
#pragma unroll
            for (int r = 0; r < 4; ++r) { const f32x2 sa2 = (f32x2){sa[r], sa[r]};
                if (MODE == 1) {
#pragma unroll
                    for (int q = 0; q < 8; ++q) S[r][q] = S[r][q] * dc[q] + sa2 * bv[q];
                } else { const f32x2 v2 = (f32x2){vr4[r], vr4[r]};
#pragma unroll
                    for (int q = 0; q < 8; ++q) S[r][q] = S[r][q] * dc[q] + (sa2 * bv[q] + v2 * kp[q]); } } }
        __syncthreads();
    }
#undef RW1_LOAD
    float* dst = (MODE == 0 ? Lc : Mc) + sidx;
#pragma unroll
    for (int r = 0; r < 4; ++r)
#pragma unroll
        for (int q = 0; q < 4; ++q) { f32x4 t; t[0] = S[r][2 * q][0]; t[1] = S[r][2 * q][1]; t[2] = S[r][2 * q + 1][0]; t[3] = S[r][2 * q + 1][1]; *(f32x4*)(dst + r * 64 + 4 * q) = t; }
}
#define LD4P(dst, ptr) do { const f32x4 _t0 = *(const LAS f32x4*)(ptr), _t1 = *(const LAS f32x4*)((ptr) + 4); dst[0] = (f32x2){_t0[0], _t0[1]}; dst[1] = (f32x2){_t0[2], _t0[3]}; dst[2] = (f32x2){_t1[0], _t1[1]}; dst[3] = (f32x2){_t1[2], _t1[3]}; } while (0)
constexpr int RW_PAIR = RW_WAVE + 1024;
__device__ __forceinline__ void rwkv_pass2_pair(CArgsP a, int e, int bh, int c, int hf, LAS float* pl) {
    const int lane = otid() & 63, b = bh >> 3, h = bh & 7, cj = h * 64 + lane, ib = lane >> 3, jb = lane & 7;
    const bf16_t* H = (const bf16_t*)(a->ws + WS_H); const bf16_t* LO = (const bf16_t*)(a->ws + WS_LO); bf16_t* CONCAT = (bf16_t*)(a->ws + WS_XB);
    const float* Ss = (const float*)(a->ws + WS_AP) + (size_t)2 * 16 * NCH * 4096;
    const size_t sidx = ((size_t)bh * NCH + c) * 4096 + (size_t)(hf * 32 + ib * 4) * 64 + jb * 8;
    const int tok0 = b * SEQ + c * TCH;
    const float* mu = a->in[21] + (size_t)e * 1792;
    const float mu_r = mu[cj], mu_k = mu[512 + cj], mu_v = mu[1024 + cj], kkc = a->in[27][e * 512 + cj], kac = a->in[28][e * 512 + cj], rkc = a->in[29][e * 512 + cj];
    const float gng = a->in[30][e * 512 + cj], gnb = a->in[31][e * 512 + cj];
    const float w0c = a->in[22][e * 512 + cj], a0c = a->in[24][e * 512 + cj];
    LAS float* yb = pl + RW_WAVE;
    f32x2 S[4][4];
#pragma unroll
    for (int r = 0; r < 4; ++r) { const f32x4 t0 = *(const f32x4*)(Ss + sidx + r * 64), t1 = *(const f32x4*)(Ss + sidx + r * 64 + 4);
        S[r][0] = (f32x2){t0[0], t0[1]}; S[r][1] = (f32x2){t0[2], t0[3]}; S[r][2] = (f32x2){t1[0], t1[1]}; S[r][3] = (f32x2){t1[2], t1[3]}; }
    unsigned short rw[5][6];
#define RW2_LOAD(T0) do { _Pragma("unroll") for (int s = 0; s < 5; ++s) { const int tk = tok0 + (T0) + hf * 4 + s - 1; const bool ok = ((tk & (SEQ - 1)) != SEQ - 1) || s > 0 || true; \
        const bf16_t* hp = H + (size_t)tk * 2816 + cj; const bf16_t* lp = LO + (size_t)tk * 1536 + cj; (void)ok; \
        if (s == 0) { const bool have = (c > 0) || ((T0) + hf * 4 > 0); rw[0][0] = have ? hp[0] : (unsigned short)0; rw[0][1] = have ? hp[512] : (unsigned short)0; rw[0][2] = have ? hp[1024] : (unsigned short)0; } \
        else { rw[s][0] = hp[0]; rw[s][1] = hp[512]; rw[s][2] = hp[1024]; rw[s][3] = lp[0]; rw[s][4] = lp[512]; rw[s][5] = lp[1024]; } } } while (0)
    RW2_LOAD(0);
    for (int t0 = 0; t0 < TCH; t0 += 8) {
        float pr = bf2f(rw[0][0]), pk = bf2f(rw[0][1]), pv = bf2f(rw[0][2]);
#pragma unroll
        for (int u = 0; u < 4; ++u) { const int s = hf * 4 + u;
            const float rr = bf2f(rw[u + 1][0]), kr = bf2f(rw[u + 1][1]), vr = bf2f(rw[u + 1][2]), ee = __expf(-softplusf_(-(w0c + bf2f(rw[u + 1][3]))) - 0.5f), aa = sigmoidf_(a0c + bf2f(rw[u + 1][4]));
            const float rl = rr + mu_r * (pr - rr), kl = kr + mu_k * (pk - kr), vl = vr + mu_v * (pv - vr); pr = rr; pk = kr; pv = vr;
            const float kkj = kl * kkc, ss = wsum_fast(kkj * kkj), kn = kkj * rsqrtf(fmaxf(ss, 1e-24f));
            const float kp = kl * (1.0f + (aa - 1.0f) * kac), dec = __expf(-ee);
            LAS float* base = pl + s * RW_STEP;
            base[lane] = -kn; base[64 + lane] = dec; base[128 + lane] = kn * aa; base[192 + lane] = kp; base[256 + lane] = rl; base[320 + lane] = vl; base[384 + lane] = bf2f(rw[u + 1][5]);
            const float bd = wsum_fast(rl * kp * rkc); if (lane == 0) pl[8 * RW_STEP + s] = bd; }
        if (t0 + 8 < TCH) RW2_LOAD(t0 + 8);
        __syncthreads();
#pragma unroll 2
        for (int s = 0; s < 8; ++s) { const LAS float* base = pl + s * RW_STEP;
            f32x2 av[4], dc[4], bv[4], kp[4], rv[4];
            LD4P(av, base + jb * 8); LD4P(dc, base + 64 + jb * 8); LD4P(bv, base + 128 + jb * 8); LD4P(kp, base + 192 + jb * 8); LD4P(rv, base + 256 + jb * 8);
            const f32x4 v4 = *(const LAS f32x4*)(base + 320 + hf * 32 + ib * 4);
            float sa[4];
#pragma unroll
            for (int r = 0; r < 4; ++r) { f32x2 pp = S[r][0] * av[0]; pp += S[r][1] * av[1]; pp += S[r][2] * av[2]; pp += S[r][3] * av[3]; sa[r] = red8(pp[0] + pp[1]); }
            float ysel = 0.f;
#pragma unroll
            for (int r = 0; r < 4; ++r) { const f32x2 sa2 = (f32x2){sa[r], sa[r]}, v2 = (f32x2){v4[r], v4[r]};
#pragma unroll
                for (int q = 0; q < 4; ++q) S[r][q] = S[r][q] * dc[q] + (sa2 * bv[q] + v2 * kp[q]);
                f32x2 pp = S[r][0] * rv[0]; pp += S[r][1] * rv[1]; pp += S[r][2] * rv[2]; pp += S[r][3] * rv[3]; const float yr = red8(pp[0] + pp[1]); ysel = (jb == r) ? yr : ysel; }
            if (jb < 4) yb[s * 64 + hf * 32 + ib * 4 + jb] = ysel; }
        __syncthreads();
#pragma unroll
        for (int u = 0; u < 4; ++u) { const int s = hf * 4 + u; const LAS float* base = pl + s * RW_STEP; const float y = yb[s * 64 + lane], vi = base[320 + lane];
            const float mean = wsum_fast(y) * (1.f / 64.f), ey2 = wsum_fast(y * y) * (1.f / 64.f), dl = y - mean, var = fmaxf(ey2 - mean * mean, 0.f);
            const float yn = dl * rsqrtf(var + 64e-5f) * gng + gnb;
            const float o = (yn + pl[8 * RW_STEP + s] * vi) * base[384 + lane];
            CONCAT[(size_t)(tok0 + t0 + s) * 1024 + cj] = f2bf(o); }
        __syncthreads();
    }
#undef RW2_LOAD
}
__device__ __forceinline__ void rwkv_combine(CArgsP a, int blk, unsigned char* shm) {
    float* Lc = (float*)(a->ws + WS_AP); float* Mc = Lc + (size_t)16 * NCH * 4096; float* Ss = Mc + (size_t)16 * NCH * 4096;
    LAS float* Sc = (LAS float*)shm; LAS float* Mb = Sc + 512;
    const int tid = otid(), bh = blk >> 3, rg = blk & 7, r = tid >> 6, j = tid & 63;
    const size_t mbase = (size_t)bh * NCH * 4096, rowoff = (size_t)(rg * 8 + r) * 64 + j;
    float cur = 0.f;
    f32x4 mn0 = *(const f32x4*)(Mc + mbase + tid * 8), mn1 = *(const f32x4*)(Mc + mbase + tid * 8 + 4); float ln = Lc[mbase + rowoff];
    for (int c = 0; c < NCH; ++c) {
        Ss[mbase + (size_t)c * 4096 + rowoff] = cur;
        Sc[r * 64 + j] = cur; *(LAS f32x4*)(Mb + tid * 8) = mn0; *(LAS f32x4*)(Mb + tid * 8 + 4) = mn1;
        float acc = ln;
        __syncthreads();
        if (c + 1 < NCH) { const size_t nb = mbase + (size_t)(c + 1) * 4096; mn0 = *(const f32x4*)(Mc + nb + tid * 8); mn1 = *(const f32x4*)(Mc + nb + tid * 8 + 4); ln = Lc[nb + rowoff]; }
#pragma unroll
        for (int k = 0; k < 64; k += 4) { const f32x4 s4 = *(const LAS f32x4*)(Sc + r * 64 + k);
            acc += s4[0] * Mb[k * 64 + j]; acc += s4[1] * Mb[(k + 1) * 64 + j]; acc += s4[2] * Mb[(k + 2) * 64 + j]; acc += s4[3] * Mb[(k + 3) * 64 + j]; }
        cur = acc;
        __syncthreads();
    }
}
__device__ __forceinline__ void lru_pass_a(CArgsP a, int gtid, int nth) {
    const bf16_t* LGA = (const bf16_t*)(a->ws + WS_LA); const bf16_t* BX = LGA + (size_t)NTOK * 512; float2* PE = (float2*)(a->ws + WS_MISC + 3 * MiB);
    for (int it = gtid; it < 2 * NLCH * 512; it += nth) { const int ch = it & 511, cc = (it >> 9) & (NLCH - 1), b = it >> 16; const size_t base = ((size_t)b * SEQ + (size_t)cc * LCH) * 512 + ch;
        float P = 1.f, E = 0.f;
#pragma unroll 32
        for (int t = 0; t < LCH; ++t) { const float av = __expf(bf2f(LGA[base + (size_t)t * 512])), bx = bf2f(BX[base + (size_t)t * 512]); P *= av; E = av * E + bx; }
        PE[it] = make_float2(P, E); }
}
__device__ __forceinline__ void lru_pass_c2(CArgsP a, int gtid, int nth) {
    const unsigned* LGA = (const unsigned*)(a->ws + WS_LA); const unsigned* BX = LGA + (size_t)NTOK * 256; const f32x4* PE = (const f32x4*)(a->ws + WS_MISC + 3 * MiB);
    const unsigned* H = (const unsigned*)(a->ws + WS_H); unsigned* CONCAT = (unsigned*)(a->ws + WS_XB);
    for (int it = gtid; it < 2 * NLCH * 256; it += nth) { const int chp = it & 255, cc = (it >> 8) & (NLCH - 1), b = it >> 15; const size_t tokb = (size_t)b * SEQ + (size_t)cc * LCH;
        float h0 = 0.f, h1 = 0.f;
#pragma unroll 8
        for (int c2 = 0; c2 < cc; ++c2) { const f32x4 pe = PE[(b << 15) + (c2 << 8) + chp]; h0 = pe[0] * h0 + pe[1]; h1 = pe[2] * h1 + pe[3]; }
#pragma unroll 8
        for (int t = 0; t < LCH; ++t) { const size_t tok = tokb + t; const unsigned la = LGA[tok * 256 + chp], bx = BX[tok * 256 + chp], gt = H[tok * 1408 + 896 + chp];
            h0 = __expf(__uint_as_float(la << 16)) * h0 + __uint_as_float(bx << 16); h1 = __expf(__uint_as_float(la & 0xffff0000u)) * h1 + __uint_as_float(bx & 0xffff0000u);
            CONCAT[tok * 512 + 256 + chp] = pk2(h0 * geluf_(__uint_as_float(gt << 16)), h1 * geluf_(__uint_as_float(gt & 0xffff0000u))); } }
}
__device__ __forceinline__ void lru_carry(CArgsP a, int gtid) {
    if (gtid >= 1024) return;
    const float2* PE = (const float2*)(a->ws + WS_MISC + 3 * MiB); float* CY = (float*)(a->ws + WS_MR + 512 * 1024);
    const int b = gtid >> 9, ch = gtid & 511; float hsv = 0.f;
#pragma unroll 16
    for (int cc = 0; cc < NLCH; ++cc) { const int idx = (b << 16) + (cc << 9) + ch; const float2 pe = PE[idx]; CY[idx] = hsv; hsv = pe.x * hsv + pe.y; }
}
__device__ __forceinline__ void lru_pass_c(CArgsP a, int gtid, int nth) {
    const bf16_t* LGA = (const bf16_t*)(a->ws + WS_LA); const bf16_t* BX = LGA + (size_t)NTOK * 512; const float2* PE = (const float2*)(a->ws + WS_MISC + 3 * MiB);
    const bf16_t* H = (const bf16_t*)(a->ws + WS_H); bf16_t* CONCAT = (bf16_t*)(a->ws + WS_XB);
    for (int it = gtid; it < 2 * NLCH * 512; it += nth) { const int ch = it & 511, cc = (it >> 9) & (NLCH - 1), b = it >> 16; const size_t tokb = (size_t)b * SEQ + (size_t)cc * LCH;
        float hsv = ((const float*)(a->ws + WS_MR + 512 * 1024))[it];
#pragma unroll 8
        for (int t = 0; t < LCH; ++t) { const size_t tok = tokb + t; const float av = __expf(bf2f(LGA[tok * 512 + ch])), bx = bf2f(BX[tok * 512 + ch]); hsv = av * hsv + bx;
            const float gt = bf2f(H[tok * 2816 + 1792 + ch]);
            CONCAT[tok * 1024 + 512 + ch] = f2bf(hsv * geluf_(gt)); } }
}
#ifndef REP_FFN
#define REP_FFN 1
#endif
#ifndef REP_P1
#define REP_P1 1
#endif
#ifndef REP_CB
#define REP_CB 1
#endif
#ifndef REP_P2
#define REP_P2 1
#endif
#ifndef REP_OPRE
#define REP_OPRE 1
#endif
#ifndef REP_AE
#define REP_AE 1
#endif
#ifndef REP_AT
#define REP_AT 1
#endif
#ifndef REP_LN
#define REP_LN 1
#endif
#ifndef REP_IN
#define REP_IN 1
#endif
#ifndef REP_CV
#define REP_CV 1
#endif
#ifndef REP_LC
#define REP_LC 1
#endif
#ifndef REP_R2
#define REP_R2 1
#endif
#ifndef REP_SYNC
#define REP_SYNC 0
#endif
#ifdef SKIP_E
#define SK_E(x)
#else
#define SK_E(x) x
#endif
#ifdef SKIP_O
#define SK_O(x)
#else
#define SK_O(x) x
#endif
#ifdef SKIP_S
#define SK_S(x)
#else
#define SK_S(x) x
#endif
#ifdef SKIP_A
#define SK_A(x)
#else
#define SK_A(x) x
#endif
__global__ __launch_bounds__(512, 2) void mega_fwd(Args a_unused) {
    extern __shared__ __attribute__((aligned(16))) unsigned char shm[];
    cg::grid_group grid = cg::this_grid();
#define a argp()
#define ws (a->ws)
#define P_W ((bf16_t*)(ws + WS_W))
#define P_XB ((bf16_t*)(ws + WS_XB))
#define P_H ((bf16_t*)(ws + WS_H))
#define P_LO ((bf16_t*)(ws + WS_LO))
#define P_AP ((bf16_t*)(ws + WS_AP))
#define P_XC ((bf16_t*)(ws + WS_XC))
#define P_LGA ((bf16_t*)(ws + WS_LA))
#define P_BX (P_LGA + (size_t)NTOK * 512)
#define P_Kb ((bf16_t*)(ws + WS_MISC))
#define P_VT ((bf16_t*)(ws + WS_MISC + MiB))
#define P_MEMB ((bf16_t*)(ws + WS_MISC + 2 * MiB))
#define P_Qb P_H
#define P_Ob (P_H + (size_t)NTOK * DM)
    volatile LAS unsigned* xst = (volatile LAS unsigned*)(shm + LDS_BYTES - 16);
    if (otid() == 0) { xst[0] = 0u; xst[1] = 0u; }
    __syncthreads();
    const XcdBarrier xb = xcd_barrier_post((unsigned*)(ws + WS_BAR), xst);
    prologue_cast(a); convert_layer(a, 0, shm); grid.sync();
#define GSYNC() xcd_barrier(xb)
    for (int ls = 0; ls < 16; ++ls) {
        const int l = ls >> 2, st = ls & 3, e = l >> 1, odd = l & 1;
        const bf16_t* A2; const bf16_t* W2; int K2; float scale2;
        if (st == 0 || st == 3) {
            EpiSwiGLU E; E.O = P_H;
            for (int rep = 0; rep < REP_FFN; ++rep) { run_gemm(shm, P_XB, P_W + (st == 0 ? W_FF1IN : W_FF2IN), NTOK, 5632, 1024, E); GSYNC(); }
            A2 = P_H; W2 = P_W + (st == 0 ? W_FF1OUT : W_FF2OUT); K2 = 2816; scale2 = 0.5f;
        } else {
            EpiBf16g E; int N; const bf16_t* Win; E.O = P_H;
            if (st == 1) { Win = P_W + W_MIXIN; E.scale = 1.0f; if (odd) { N = 2816; E.ldc = 2816; E.gelu_from = 1000; } else { N = 1536; E.ldc = 1536; E.gelu_from = 2; } }
            else { Win = P_W + W_Q; N = 1024; E.ldc = 1024; E.gelu_from = 1000; E.scale = 0.0625f; }
            for (int rep = 0; rep < REP_IN; ++rep) { run_gemm(shm, P_XB, Win, NTOK, N, 1024, E); if (rep + 1 < REP_IN) GSYNC(); }
            GSYNC();
            if (st == 1) {
                if (!odd) {
                    for (int rep = 0; rep < REP_AE; ++rep) { SK_E(even_core(a, e, shm);) GSYNC(); }
                    EpiPool EP; EP.O = P_XB; EP.scl = a->in[14] + (size_t)e * 512;
                    run_gemm(shm, P_LO, P_W + W_AUX1, NTOK, 512, 512, EP); GSYNC();
                } else {
                    for (int rep = 0; rep < REP_OPRE; ++rep) {
                        SK_O(odd_prep(a, e);) GSYNC();
                        { EpiBf16g EL; EL.O = P_LO; EL.ldc = 1536; EL.gelu_from = 1000; EL.scale = 1.0f; run_gemm(shm, P_AP, P_W + W_AUX1, NTOK, 1536, 256, EL); }
                        { EpiLru ER; ER.XC = P_XC; ER.b_a = a->in[35] + (size_t)e * 512; ER.b_x = a->in[37] + (size_t)e * 512; ER.lam = a->in[38] + (size_t)e * 512; ER.LGA = P_LGA; ER.BX = P_BX;
                          run_gemm(shm, P_XC, P_W + W_AUX2, NTOK, 1024, 512, ER); }
                        GSYNC();
                    }
                    for (int rep = 0; rep < REP_P1; ++rep) {
                        const int wave = otid() >> 6; LAS float* pl = (LAS float*)shm + (wave >> 1) * RW_PAIR;
                        for (int it0 = blockIdx.x * 4; it0 < 16 * NCH; it0 += gridDim.x * 4) { const int item = it0 + (wave >> 1);
                            if (wave & 1) rwkv_pass1_pair<1>(a, e, item / NCH, item % NCH, pl); else rwkv_pass1_pair<0>(a, e, item / NCH, item % NCH, pl); }
                        SK_O(lru_pass_a(a, blockIdx.x * 512 + otid(), gridDim.x * 512);)
                        GSYNC();
                    }
                    for (int rep = 0; rep < REP_CB; ++rep) {
                        if (blockIdx.x < 128) { SK_O(rwkv_combine(a, blockIdx.x, shm);) }
                        else { SK_O(lru_pass_c2(a, ((int)blockIdx.x - 128) * 512 + otid(), ((int)gridDim.x - 128) * 512);) }
                        GSYNC();
                    }
                    for (int rep = 0; rep < REP_P2; ++rep) {
                        const int wave = otid() >> 6; LAS float* pl = (LAS float*)shm + (wave >> 1) * RW_PAIR;
                        for (int it0 = blockIdx.x * 4; it0 < 16 * NCH; it0 += gridDim.x * 4) { const int item = it0 + (wave >> 1); rwkv_pass2_pair(a, e, item / NCH, item % NCH, wave & 1, pl); }
                        GSYNC();
                    }
                }
                A2 = P_XB; W2 = P_W + W_MIXOUT; K2 = 1024; scale2 = 1.0f;
            } else {
                for (int rep = 0; rep < REP_AT; ++rep) { SK_A(attn_phase(P_Qb, P_Kb, P_VT, P_Ob, shm);) GSYNC(); }
                A2 = P_Ob; W2 = P_W + W_O; K2 = 1024; scale2 = 1.0f;
            }
        }
        {
            EpiResid ER; ER.res = (const h16*)a->out; ER.out = (h16*)a->out; ER.MR = (const float*)(ws + WS_MR); ER.first = (ls == 0);
            ER.g = a->in[6] + (size_t)(ls > 0 ? ls - 1 : 0) * DM; ER.b = a->in[7] + (size_t)(ls > 0 ? ls - 1 : 0) * DM; ER.scale = scale2; run_gemm(shm, A2, W2, NTOK, 1024, K2, ER); }
        GSYNC();
        for (int rep = 0; rep < REP_SYNC; ++rep) GSYNC();
        if (st == 1) {
            if (blockIdx.x < 16) { EpiKV EK; EK.Kb = P_Kb; EK.VT = P_VT; run_gemm(shm, P_MEMB, P_W + W_KV, 512, 2048, 1024, EK, 16, (int)blockIdx.x); }
            else ln_phase(a->out, nullptr, P_XB, (float*)(ws + WS_MR), a->in[6] + (size_t)ls * DM, a->in[7] + (size_t)ls * DM, 16, (int)gridDim.x - 16);
        } else if (ls < 15) { for (int rep = 0; rep < REP_LN; ++rep) { ln_phase(a->out, nullptr, P_XB, (float*)(ws + WS_MR), a->in[6] + (size_t)ls * DM, a->in[7] + (size_t)ls * DM, 0, (int)gridDim.x); if (rep + 1 < REP_LN) GSYNC(); }
            if (st == 3) for (int rep = 0; rep < REP_CV; ++rep) { convert_layer(a, l + 1, shm); if (rep + 1 < REP_CV) GSYNC(); } }
        else { h16x8 zr[16][2]; ln_final_load((const h16*)a->out, zr); GSYNC(); ln_final_store(zr, a->out, a->in[6] + (size_t)ls * DM, a->in[7] + (size_t)ls * DM); }
        GSYNC();
    }
}

#undef a
#undef ws
#undef P_W
#undef P_XB
#undef P_H
#undef P_LO
#undef P_AP
#undef P_XC
#undef P_LGA
#undef P_BX
#undef P_Kb
#undef P_VT
#undef P_MEMB
#undef P_Qb
#undef P_Ob
extern "C" void kernel_launch(void* const* d_in, const int* in_sizes, int n_in, void* d_out, int out_size, void* d_ws, size_t ws_size, hipStream_t stream) {
    static int grid = 0;
    if (grid == 0) {
        if (n_in != 39 || out_size != NTOK * DM || ws_size < WS_END) { fprintf(stderr, "kernel_launch: unexpected shapes (n_in %d out %d ws %zu need %zu)\n", n_in, out_size, ws_size, (size_t)WS_END); grid = -1; return; }
        int dev = 0, cus = 0, per_cu = 0;
        hipGetDevice(&dev); hipDeviceGetAttribute(&cus, hipDeviceAttributeMultiprocessorCount, dev);
        if (hipFuncSetAttribute((const void*)mega_fwd, hipFuncAttributeMaxDynamicSharedMemorySize, LDS_BYTES) != hipSuccess) { fprintf(stderr, "kernel_launch: hipFuncSetAttribute failed\n"); }
        if (hipOccupancyMaxActiveBlocksPerMultiprocessor(&per_cu, (const void*)mega_fwd, 512, LDS_BYTES) != hipSuccess || per_cu < 1) { fprintf(stderr, "kernel_launch: occupancy query says %d\n", per_cu); per_cu = 1; }
        (void)hipGetLastError();
        grid = cus > 0 ? cus : 256;
    }
    if (grid < 0) return;
    if (hipMemsetAsync((char*)d_ws + WS_BAR, 0, 16384, stream) != hipSuccess) { fprintf(stderr, "kernel_launch: memset failed\n"); return; }
    Args a{};
    for (int i = 0; i < 39; ++i) a.in[i] = (const float*)d_in[i];
    a.out = (float*)d_out; a.ws = (unsigned char*)d_ws;
    void* args[] = {&a};
    hipError_t e = hipLaunchCooperativeKernel((const void*)mega_fwd, dim3(grid), dim3(512), args, LDS_BYTES, stream);
    if (e != hipSuccess) fprintf(stderr, "cooperative launch failed: %s (grid %d)\n", hipGetErrorString(e), grid);
}
```

```cpp
#include <hip/hip_runtime.h>
#include <hip/hip_cooperative_groups.h>
#include <cstdio>
namespace cg = cooperative_groups;
namespace pg8 {
#define PG8_LAS __attribute__((address_space(3)))
typedef unsigned short bf16_t;
typedef short bf16x8 __attribute__((ext_vector_type(8)));
typedef float f32x4 __attribute__((ext_vector_type(4)));
typedef unsigned u32x4 __attribute__((ext_vector_type(4)));
typedef unsigned u32x2 __attribute__((ext_vector_type(2)));
constexpr int BM = 256, BK = 64, HALF = 128, HTB = HALF * BK * 2  , STAGE_BYTES = 8 * HTB, NXCD = 8, WGM = 8;

__host__ __device__ __forceinline__ int lds_byte(int r, int c) { const int st = (r >> 4) * 2 + (c >> 5), rr = r & 15, cc = c & 31, ob = rr * 64 + cc * 2; return st * 1024 + (ob ^ (((ob >> 9) & 1) << 5)); }
__host__ __device__ __forceinline__ void stage_rc(int b, int& R, int& C) { const int st = b / 1024, sb = b % 1024, swz = sb ^ (((sb >> 9) & 1) << 5); R = (st >> 1) * 16 + swz / 64; C = (st & 1) * 32 + (swz % 64) / 2; }
__host__ __device__ __forceinline__ int perm32(int rho) { const int n = rho >> 4, i = rho & 15; return 8 * (i >> 2) + 4 * n + (i & 3); }

struct Unit { int pm, pn; };
struct Gemm { const bf16_t* A; const bf16_t* Bt; int M, N, K; };

struct StaticOrder {
    int nM, nN, nwg, G, c;
    __host__ __device__ void init(int M, int N, int G_, int c_) { nM = M / BM; nN = N / BM; nwg = nM * nN; G = G_; c = c_; }
    __host__ __device__ bool next(int i, Unit& u) const {
        const long L = (long)i * G + c; if (L >= nwg) return false;
        int wgid = (int)L; { const int q = nwg / NXCD, r = nwg % NXCD, xcd = wgid % NXCD, off = wgid / NXCD; wgid = (xcd < r ? xcd * (q + 1) : r * (q + 1) + (xcd - r) * q) + off; }
        const int nig = WGM * nN, gid = wgid / nig, fm = gid * WGM, gsz = (nM - fm) < WGM ? (nM - fm) : WGM;
        u.pm = fm + ((wgid % nig) % gsz); u.pn = (wgid % nig) / gsz; return true;
    }
    __device__ __forceinline__ void a_ready(const Unit&) const {}
    __device__ __forceinline__ void done(const Unit&) const {}
};
__device__ __forceinline__ unsigned cvt_pk_bf16(float lo, float hi) { unsigned r; asm volatile("v_cvt_pk_bf16_f32 %0, %1, %2" : "=v"(r) : "v"(lo), "v"(hi)); return r; }

template <class Epi, class Sched>
__device__ __forceinline__ void gemm_phase(PG8_LAS unsigned char* lds, const Gemm g, const Sched& S, const Epi& E) {
    int tid_ = threadIdx.x; asm volatile("" : "+v"(tid_));
    const int tid = tid_, wid = __builtin_amdgcn_readfirstlane(tid >> 6), lane = tid & 63, wr = wid >> 2, wc = wid & 3, fr = lane & 15, fq = lane >> 4;
    const int K = g.K, nt = K / BK;
    unsigned voffA[2], voffB[2];
#pragma unroll
    for (int i = 0; i < 2; ++i) { int R, C; stage_rc(tid * 16 + i * 8192, R, C); const int Rb = Epi::PERM ? ((R & ~31) + perm32(R & 31)) : R;
        voffA[i] = (unsigned)(R * K + C) * 2u; voffB[i] = (unsigned)(Rb * K + C) * 2u; }
    const size_t kstep = (size_t)(BK * 2);
    const size_t hstep = (size_t)HALF * K * 2;
    const size_t tstep = 2 * hstep;
    const unsigned ldsw = (unsigned)wid * 1024u;
    const int aoff = lds_byte(wr * 64 + fr, fq * 8), boff = lds_byte(wc * 32 + fr, fq * 8);
#define PG8_SA(b, h) (((b) * 2 + (h)) * HTB)
#define PG8_SB(b, h) ((4 + (b) * 2 + (h)) * HTB)
#define PG8_STAGE(bufoff, gbase, voff) do { _Pragma("unroll") for (int _i = 0; _i < 2; ++_i) \
        __builtin_amdgcn_global_load_lds((const unsigned*)((const char*)(gbase) + (voff)[_i]), (PG8_LAS unsigned*)(lds + (bufoff) + ldsw + _i * 8192), 16, 0, 0); } while (0)
#define PG8_LDA(dst, b, h) do { _Pragma("unroll") for (int m = 0; m < 4; ++m) _Pragma("unroll") for (int k = 0; k < 2; ++k) dst[m][k] = *(const PG8_LAS bf16x8*)(lds + PG8_SA(b, h) + aoff + m * 2048 + k * 1024); } while (0)
#define PG8_LDB(dst, b, h) do { _Pragma("unroll") for (int n = 0; n < 2; ++n) _Pragma("unroll") for (int k = 0; k < 2; ++k) dst[n][k] = *(const PG8_LAS bf16x8*)(lds + PG8_SB(b, h) + boff + n * 2048 + k * 1024); } while (0)
#define PG8_MMA(ai, bj, At, Bt) do { __builtin_amdgcn_s_setprio(1); _Pragma("unroll") for (int m = 0; m < 4; ++m) _Pragma("unroll") for (int n = 0; n < 2; ++n) _Pragma("unroll") for (int k = 0; k < 2; ++k) \
        acc[ai][bj][m][n] = __builtin_amdgcn_mfma_f32_16x16x32_bf16(Bt[n][k], At[m][k], acc[ai][bj][m][n], 0, 0, 0); __builtin_amdgcn_s_setprio(0); } while (0)
#define PG8_WAIT_V(n) asm volatile("s_waitcnt vmcnt(" #n ")" ::: "memory")
#define PG8_WAIT_L(n) asm volatile("s_waitcnt lgkmcnt(" #n ")" ::: "memory")
#define PG8_BAR __builtin_amdgcn_s_barrier()
#define PG8_SCHED __builtin_amdgcn_sched_barrier(0)
    Unit cur, nxt; int ui = 0;
    if (!S.next(0, cur)) return;
    f32x4 acc[2][2][4][2];
#pragma unroll
    for (int a = 0; a < 2; ++a)
#pragma unroll
        for (int b = 0; b < 2; ++b)
#pragma unroll
            for (int m = 0; m < 4; ++m)
#pragma unroll
                for (int n = 0; n < 2; ++n) acc[a][b][m][n] = (f32x4){0.f, 0.f, 0.f, 0.f};
    bf16x8 At[4][2], B0[2][2], B1[2][2];
    const char* cA = (const char*)g.A + (size_t)cur.pm * tstep; const char* cB = (const char*)g.Bt + (size_t)cur.pn * tstep;
    S.a_ready(cur);
    PG8_STAGE(PG8_SB(0, 0), cB, voffB); PG8_STAGE(PG8_SA(0, 0), cA, voffA); PG8_STAGE(PG8_SB(0, 1), cB + hstep, voffB); PG8_STAGE(PG8_SA(0, 1), cA + hstep, voffA);
    if (wr == 1) PG8_BAR;
    PG8_WAIT_V(4); PG8_BAR;
    PG8_STAGE(PG8_SB(1, 0), cB + kstep, voffB); PG8_STAGE(PG8_SA(1, 0), cA + kstep, voffA); PG8_STAGE(PG8_SB(1, 1), cB + hstep + kstep, voffB);
    PG8_WAIT_V(6); PG8_BAR;
    for (;;) {
        const bool has_next = S.next(ui + 1, nxt);
        const char* nA = has_next ? (const char*)g.A + (size_t)nxt.pm * tstep : cA; const char* nB = has_next ? (const char*)g.Bt + (size_t)nxt.pn * tstep : cB;
        for (int t = 0; t < nt; t += 2) {
            const bool last = (t == nt - 2);
            const char* a1 = cA + (size_t)(t + 1) * kstep;
            const char* a2 = last ? nA : cA + (size_t)(t + 2) * kstep; const char* b2 = last ? nB : cB + (size_t)(t + 2) * kstep;
            const char* a3 = a2 + kstep; const char* b3 = b2 + kstep;
            if (last && has_next) S.a_ready(nxt);
            PG8_LDB(B0, 0, 0); PG8_SCHED; PG8_LDA(At, 0, 0); PG8_STAGE(PG8_SA(1, 1), a1 + hstep, voffA);
            PG8_WAIT_L(8); PG8_BAR; PG8_WAIT_L(0); PG8_MMA(0, 0, At, B0); PG8_BAR; PG8_SCHED;
            PG8_LDB(B1, 0, 1); PG8_STAGE(PG8_SB(0, 0), b2, voffB);
            PG8_BAR; PG8_WAIT_L(0); PG8_MMA(0, 1, At, B1); PG8_BAR;
            PG8_LDA(At, 0, 1); PG8_STAGE(PG8_SA(0, 0), a2, voffA);
            PG8_BAR; PG8_WAIT_L(0); PG8_MMA(1, 0, At, B0); PG8_BAR; PG8_SCHED;
            PG8_STAGE(PG8_SB(0, 1), b2 + hstep, voffB);
            PG8_WAIT_V(6); PG8_BAR; PG8_MMA(1, 1, At, B1); PG8_BAR;
            PG8_LDB(B0, 1, 0); PG8_SCHED; PG8_LDA(At, 1, 0); PG8_STAGE(PG8_SA(0, 1), a2 + hstep, voffA);
            PG8_WAIT_L(8); PG8_BAR; PG8_WAIT_L(0); PG8_MMA(0, 0, At, B0); PG8_BAR; PG8_SCHED;
            PG8_LDB(B1, 1, 1); PG8_STAGE(PG8_SB(1, 0), b3, voffB);
            PG8_BAR; PG8_WAIT_L(0); PG8_MMA(0, 1, At, B1); PG8_BAR;
            PG8_LDA(At, 1, 1); PG8_STAGE(PG8_SA(1, 0), a3, voffA);
            PG8_BAR; PG8_WAIT_L(0); PG8_MMA(1, 0, At, B0); PG8_BAR; PG8_SCHED;
            PG8_STAGE(PG8_SB(1, 1), b3 + hstep, voffB);
            PG8_WAIT_V(6); PG8_BAR; PG8_MMA(1, 1, At, B1); PG8_BAR;
        }
        if constexpr (!Epi::AFTER_DRAIN) { E(acc, cur, wr, wc, fr, fq); S.done(cur); }
        if (!has_next) break;
#pragma unroll
        for (int a = 0; a < 2; ++a)
#pragma unroll
            for (int b = 0; b < 2; ++b)
#pragma unroll
                for (int m = 0; m < 4; ++m)
#pragma unroll
                    for (int n = 0; n < 2; ++n) acc[a][b][m][n] = (f32x4){0.f, 0.f, 0.f, 0.f};
        cur = nxt; cA = nA; cB = nB; ++ui;
    }
    PG8_WAIT_V(0);
    if (wr == 0) PG8_BAR;
    PG8_BAR;
    if constexpr (Epi::AFTER_DRAIN) { E.fused(acc, cur, wr, wc, fr, fq, lds, wid, lane); S.done(cur); }
#undef PG8_SA
#undef PG8_SB
#undef PG8_STAGE
#undef PG8_LDA
#undef PG8_LDB
#undef PG8_MMA
#undef PG8_WAIT_V
#undef PG8_WAIT_L
#undef PG8_BAR
#undef PG8_SCHED
}
}

using pg8::bf16_t; using pg8::bf16x8; using pg8::f32x4; using pg8::u32x4; using pg8::u32x2;
#define LAS __attribute__((address_space(3)))
constexpr int NTOK = 32768, SEQ = 16384, DM = 1024, FF = 2816;
constexpr int NCH = 64;
constexpr int TCH = SEQ / NCH;
constexpr int LCH = 128;
constexpr int NLCH = SEQ / LCH;
constexpr float ALPHA = 1.681792830507429f;
constexpr int LDS_BYTES = 136 * 1024;

constexpr size_t MiB = 1024 * 1024;
constexpr size_t E_FFIN = (size_t)5632 * 1024, E_FFOUT = (size_t)1024 * 2816, E_SQ = (size_t)1024 * 1024, E_KV = (size_t)2048 * 1024, E_MIXIN = (size_t)2816 * 1024;
constexpr size_t W_FF1IN = 0, W_FF1OUT = W_FF1IN + E_FFIN, W_FF2IN = W_FF1OUT + E_FFOUT, W_FF2OUT = W_FF2IN + E_FFIN, W_Q = W_FF2OUT + E_FFOUT, W_KV = W_Q + E_SQ, W_O = W_KV + E_KV,
                 W_MIXIN = W_O + E_SQ, W_MIXOUT = W_MIXIN + E_MIXIN, W_AUX1 = W_MIXOUT + E_SQ, W_AUX2 = W_AUX1 + (size_t)1536 * 256, W_END = W_AUX2 + (size_t)1024 * 512;
constexpr size_t WS_W = 0;
constexpr size_t WS_XB = 52 * MiB;
constexpr size_t WS_H = WS_XB + 64 * MiB;
constexpr size_t WS_LO = WS_H + 176 * MiB;
constexpr size_t WS_AP = WS_LO + 96 * MiB;
constexpr size_t WS_XC = WS_AP + 16 * MiB;
constexpr size_t WS_LA = WS_XC + 32 * MiB;
constexpr size_t WS_MISC = WS_LA + 64 * MiB;
constexpr size_t WS_BAR = WS_MISC + 4 * MiB;
constexpr size_t WS_MR = WS_BAR + 1 * MiB;
constexpr size_t WS_END = WS_MR + 1 * MiB;
static_assert(W_END * 2 <= 52 * MiB, "weights");
static_assert(WS_END <= 512 * MiB, "workspace");

struct Args { const float* in[39]; float* out; unsigned char* ws; };
typedef const __attribute__((address_space(4))) Args* CArgsP;
__device__ __forceinline__ CArgsP argp() { CArgsP p = (CArgsP)__builtin_amdgcn_kernarg_segment_ptr(); asm volatile("" : "+s"(p)); return p; }

__device__ __forceinline__ float bf2f(unsigned short b) { return __uint_as_float(((unsigned)b) << 16); }
__device__ __forceinline__ float bfs2f(short b) { return __uint_as_float(((unsigned)(unsigned short)b) << 16); }
__device__ __forceinline__ unsigned short f2bf(float f) { unsigned u = __float_as_uint(f); u += 0x7FFFu + ((u >> 16) & 1u); return (unsigned short)(u >> 16); }
__device__ __forceinline__ unsigned pk2(float lo, float hi) { return pg8::cvt_pk_bf16(lo, hi); }
__device__ __forceinline__ float sigmoidf_(float x) { return __builtin_amdgcn_rcpf(1.0f + __expf(-x)); }
__device__ __forceinline__ float siluf_(float x) { return x * sigmoidf_(x); }
__device__ __forceinline__ float tanhf_(float y) { return 1.0f - 2.0f * __builtin_amdgcn_rcpf(1.0f + __expf(2.0f * y)); }
__device__ __forceinline__ float geluf_(float x) { return 0.5f * x * (1.0f + tanhf_(0.7978845608028654f * (x + 0.044715f * x * x * x))); }
__device__ __forceinline__ float softplusf_(float x) { return fmaxf(x, 0.0f) + __logf(1.0f + __expf(-fabsf(x))); }
__device__ __forceinline__ float wave_sum(float v) {
#pragma unroll
    for (int o = 1; o < 64; o <<= 1) v += __shfl_xor(v, o);
    return v;
}
__device__ __forceinline__ int otid() { int t = threadIdx.x; asm volatile("" : "+v"(t)); return t; }
#define LDS_SYNC_WAVE() asm volatile("s_waitcnt lgkmcnt(0)" ::: "memory")

typedef const f32x4 (&AccRef)[2][2][4][2];
struct EpiSwiGLU { static constexpr bool PERM = true, AFTER_DRAIN = false; bf16_t* O;
    __device__ __forceinline__ void operator()(AccRef acc, const pg8::Unit& u, int wr, int wc, int fr, int fq) const {
        const int row0 = u.pm * 256 + wr * 64 + fr, col0 = u.pn * 128 + wc * 32 + 8 * fq;
#pragma unroll
        for (int ai = 0; ai < 2; ++ai)
#pragma unroll
            for (int m = 0; m < 4; ++m) { bf16_t* rowp = O + (size_t)(row0 + ai * 128 + m * 16) * FF + col0;
                const f32x4 g0 = acc[ai][0][m][0], g1 = acc[ai][0][m][1], u0 = acc[ai][1][m][0], u1 = acc[ai][1][m][1];
                u32x4 o; o.x = pk2(siluf_(g0[0]) * u0[0], siluf_(g0[1]) * u0[1]); o.y = pk2(siluf_(g0[2]) * u0[2], siluf_(g0[3]) * u0[3]);
                o.z = pk2(siluf_(g1[0]) * u1[0], siluf_(g1[1]) * u1[1]); o.w = pk2(siluf_(g1[2]) * u1[2], siluf_(g1[3]) * u1[3]);
                *(u32x4*)rowp = o; __builtin_amdgcn_sched_barrier(0); }
    } };
typedef _Float16 h16; typedef h16 h16x4 __attribute__((ext_vector_type(4))); typedef h16 h16x8 __attribute__((ext_vector_type(8)));
struct EpiResid { static constexpr bool PERM = false, AFTER_DRAIN = false; const h16* res; h16* out; const float* MR; const float* g; const float* b; float scale; int first;
    __device__ __forceinline__ void operator()(AccRef acc, const pg8::Unit& u, int wr, int wc, int fr, int fq) const {
        const int row0 = u.pm * 256 + wr * 64 + fr, col0 = u.pn * 256 + wc * 32 + 4 * fq;
        f32x4 g4[2][2], b4[2][2];
#pragma unroll
        for (int bj = 0; bj < 2; ++bj)
#pragma unroll
            for (int n = 0; n < 2; ++n) { if (first) { g4[bj][n] = (f32x4){1.f, 1.f, 1.f, 1.f}; b4[bj][n] = (f32x4){0.f, 0.f, 0.f, 0.f}; } else { g4[bj][n] = *(const f32x4*)(g + col0 + bj * 128 + n * 16); b4[bj][n] = *(const f32x4*)(b + col0 + bj * 128 + n * 16); } }
#pragma unroll
        for (int ai = 0; ai < 2; ++ai)
#pragma unroll
        for (int mh = 0; mh < 4; mh += 2) {
            float mean[2], rstd[2]; h16x4 rr[2][2][2];
#pragma unroll
            for (int mm = 0; mm < 2; ++mm) { const int row = row0 + ai * 128 + (mh + mm) * 16; const size_t off = (size_t)row * DM + col0; mean[mm] = MR[2 * row]; rstd[mm] = MR[2 * row + 1];
#pragma unroll
                for (int bj = 0; bj < 2; ++bj)
#pragma unroll
                    for (int n = 0; n < 2; ++n) rr[mm][bj][n] = *(const h16x4*)(res + off + bj * 128 + n * 16); }
#pragma unroll
            for (int mm = 0; mm < 2; ++mm) { const int m = mh + mm, row = row0 + ai * 128 + m * 16; const size_t off = (size_t)row * DM + col0;
#pragma unroll
                for (int bj = 0; bj < 2; ++bj)
#pragma unroll
                    for (int n = 0; n < 2; ++n) { const f32x4 r = __builtin_convertvector(rr[mm][bj][n], f32x4);
                        const f32x4 x = (r - mean[mm]) * rstd[mm] * g4[bj][n] + b4[bj][n], z = x * ALPHA + acc[ai][bj][m][n] * scale;
                        *(h16x4*)(out + off + bj * 128 + n * 16) = __builtin_convertvector(z, h16x4); } } }
    } };
struct EpiBf16g { static constexpr bool PERM = true, AFTER_DRAIN = false; bf16_t* O; int ldc; int gelu_from; float scale;
    __device__ __forceinline__ void operator()(AccRef acc, const pg8::Unit& u, int wr, int wc, int fr, int fq) const {
        const int row0 = u.pm * 256 + wr * 64 + fr, col0 = u.pn * 256 + wc * 32 + 8 * fq; const bool dog = u.pn >= gelu_from;
#pragma unroll
        for (int ai = 0; ai < 2; ++ai)
#pragma unroll
            for (int m = 0; m < 4; ++m) { bf16_t* rowp = O + (size_t)(row0 + ai * 128 + m * 16) * ldc + col0;
#pragma unroll
                for (int bj = 0; bj < 2; ++bj) { f32x4 v0 = acc[ai][bj][m][0] * scale, v1 = acc[ai][bj][m][1] * scale;
                    if (dog) {
#pragma unroll
                        for (int e = 0; e < 4; ++e) { v0[e] = geluf_(v0[e]); v1[e] = geluf_(v1[e]); } }
                    u32x4 o; o.x = pk2(v0[0], v0[1]); o.y = pk2(v0[2], v0[3]); o.z = pk2(v1[0], v1[1]); o.w = pk2(v1[2], v1[3]);
                    *(u32x4*)(rowp + bj * 128) = o; } }
    } };
struct EpiKV { static constexpr bool PERM = false, AFTER_DRAIN = false; bf16_t* Kb; bf16_t* VT;
    __device__ __forceinline__ void operator()(AccRef acc, const pg8::Unit& u, int wr, int wc, int fr, int fq) const {
        const int row0 = u.pm * 256 + wr * 64 + fr, col0 = u.pn * 256 + wc * 32 + 4 * fq;
#pragma unroll
        for (int ai = 0; ai < 2; ++ai)
#pragma unroll
            for (int m = 0; m < 4; ++m) { const int row = row0 + ai * 128 + m * 16;
#pragma unroll
                for (int bj = 0; bj < 2; ++bj)
#pragma unroll
                    for (int n = 0; n < 2; ++n) { const int col = col0 + bj * 128 + n * 16; const f32x4 v = acc[ai][bj][m][n];
                        if (u.pn < 4) { u32x2 o; o.x = pk2(v[0], v[1]); o.y = pk2(v[2], v[3]); *(u32x2*)(Kb + (size_t)row * 1024 + col) = o; }
                        else { const int cc = col - 1024, hh = cc >> 8, d = cc & 255, b = row >> 8, mm = row & 255;
#pragma unroll
                            for (int e = 0; e < 4; ++e) VT[(size_t)((b * 4 + hh) * 256 + d + e) * 256 + mm] = f2bf(v[e]); } } }
    } };
struct EpiLru { static constexpr bool PERM = true, AFTER_DRAIN = false; const bf16_t* XC; const float* b_a; const float* b_x; const float* lam; bf16_t* LGA; bf16_t* BX;
    __device__ __forceinline__ void operator()(AccRef acc, const pg8::Unit& u, int wr, int wc, int fr, int fq) const {
        const int row0 = u.pm * 256 + wr * 64 + fr, ch0 = u.pn * 128 + wc * 32 + 8 * fq;
#pragma unroll
        for (int n = 0; n < 2; ++n) { float sp[4]; const f32x4 lm = *(const f32x4*)(lam + ch0 + 4 * n), ba = *(const f32x4*)(b_a + ch0 + 4 * n), bx_ = *(const f32x4*)(b_x + ch0 + 4 * n);
#pragma unroll
            for (int e = 0; e < 4; ++e) sp[e] = -8.0f * softplusf_(-lm[e]);
            u32x2 xrr[2][4];
#pragma unroll
            for (int ai = 0; ai < 2; ++ai)
#pragma unroll
                for (int m = 0; m < 4; ++m) xrr[ai][m] = *(const u32x2*)(XC + (size_t)(row0 + ai * 128 + m * 16) * 512 + ch0 + 4 * n);
#pragma unroll
            for (int ai = 0; ai < 2; ++ai)
#pragma unroll
                for (int m = 0; m < 4; ++m) { const size_t off = (size_t)(row0 + ai * 128 + m * 16) * 512 + ch0 + 4 * n;
                    const u32x2 xr = xrr[ai][m]; float xc[4] = {__uint_as_float(xr.x << 16), __uint_as_float(xr.x & 0xffff0000u), __uint_as_float(xr.y << 16), __uint_as_float(xr.y & 0xffff0000u)};
                    float la[4], bb[4];
#pragma unroll
                    for (int e = 0; e < 4; ++e) { const float rec = sigmoidf_(acc[ai][0][m][n][e] + ba[e]), inp = sigmoidf_(acc[ai][1][m][n][e] + bx_[e]);
                        const float lg = sp[e] * rec; la[e] = lg; bb[e] = sqrtf(fmaxf(1.0f - __expf(2.0f * lg), 0.0f)) * (inp * xc[e]); }
                    u32x2 o; o.x = pk2(la[0], la[1]); o.y = pk2(la[2], la[3]); *(u32x2*)(LGA + off) = o;
                    o.x = pk2(bb[0], bb[1]); o.y = pk2(bb[2], bb[3]); *(u32x2*)(BX + off) = o; } }
    } };
struct EpiPool { static constexpr bool PERM = true, AFTER_DRAIN = false; bf16_t* O; const float* scl;
    __device__ __forceinline__ void operator()(AccRef acc, const pg8::Unit& u, int wr, int wc, int fr, int fq) const {
        const int row0 = u.pm * 256 + wr * 64 + fr, col0 = u.pn * 256 + wc * 32 + 8 * fq;
#pragma unroll
        for (int ai = 0; ai < 2; ++ai)
#pragma unroll
            for (int m = 0; m < 4; ++m) { bf16_t* rowp = O + (size_t)(row0 + ai * 128 + m * 16) * 1024 + col0;
#pragma unroll
                for (int bj = 0; bj < 2; ++bj) { float v[8];
#pragma unroll
                    for (int e = 0; e < 8; ++e) v[e] = acc[ai][bj][m][e >> 2][e & 3] * scl[col0 + bj * 128 + e];
                    u32x4 o; o.x = pk2(v[0], v[1]); o.y = pk2(v[2], v[3]); o.z = pk2(v[4], v[5]); o.w = pk2(v[6], v[7]);
                    *(u32x4*)(rowp + bj * 128) = o; } }
    } };

template <class Epi> __device__ __forceinline__ void run_gemm(unsigned char* shm, const bf16_t* A, const bf16_t* Bt, int M, int N, int K, const Epi& E, int G = 0, int c = -1) {
    pg8::Gemm g; g.A = A; g.Bt = Bt; g.M = M; g.N = N; g.K = K;
    pg8::StaticOrder S; S.init(M, N, G > 0 ? G : (int)gridDim.x, c >= 0 ? c : (int)blockIdx.x);
    pg8::gemm_phase<Epi, pg8::StaticOrder>((PG8_LAS unsigned char*)shm, g, S, E);
}

template <int MODE> __device__ __forceinline__ int rowmap(int n) {
    if (MODE == 0) return n;
    const int up = n >= FF, i = up ? n - FF : n; return (i >> 7) * 256 + up * 128 + (i & 127);
}
template <int MODE> __device__ __forceinline__ void conv_tile(const float* src, int K, int N, bf16_t* dst, int tile, float* tb) {
    const int tid = otid(), ntn = N >> 6, k0 = (tile / ntn) << 6, n0 = (tile % ntn) << 6;
#pragma unroll
    for (int i = 0; i < 8; ++i) { const int kk = i * 8 + (tid >> 6), nn = tid & 63; tb[kk * 65 + nn] = src[(size_t)(k0 + kk) * N + n0 + nn]; }
    __syncthreads();
#pragma unroll
    for (int i = 0; i < 4; ++i) { const int nn = i * 16 + (tid >> 5), kk = 2 * (tid & 31);
        *(unsigned*)(dst + (size_t)rowmap<MODE>(n0 + nn) * K + k0 + kk) = pk2(tb[kk * 65 + nn], tb[(kk + 1) * 65 + nn]); }
    __syncthreads();
}

#define XB_TMO      128
#define XB_XCNT(j)  (256  + 64 * (j))
#define XB_XSUB(j)  (1280 + 64 * (j))
#define XB_XGEN(j)  (2304 + 64 * (j))
#define XB_TOP      3328
#define XB_TOPGEN   3392
#define XCD_BAR_WORDS 3456
#define XB_SPIN_CAP (1u << 18)

__device__ __forceinline__ unsigned xb_ld(unsigned* p)              { return __hip_atomic_load(p, __ATOMIC_RELAXED, __HIP_MEMORY_SCOPE_AGENT); }
__device__ __forceinline__ unsigned xb_add(unsigned* p, unsigned v) { return __hip_atomic_fetch_add(p, v, __ATOMIC_RELAXED, __HIP_MEMORY_SCOPE_AGENT); }
__device__ __forceinline__ unsigned xb_xcc_id() { return (unsigned)__builtin_amdgcn_s_getreg((3 << 11) | 20) & 0xFu; }
#define XB_SPIN(cond, bar) do { unsigned _sp = 0; while (cond) { __builtin_amdgcn_s_sleep(1); \
    if ((++_sp & 255u) == 0u) { if (xb_ld(&(bar)[XB_TMO])) break; if (_sp > XB_SPIN_CAP) { atomicAdd(&(bar)[XB_TMO], 1u); break; } } } } while (0)

struct XcdBarrier {
    unsigned* bar; unsigned x;
    volatile LAS unsigned* st;
};

__device__ __forceinline__ XcdBarrier xcd_barrier_post(unsigned* bar, volatile LAS unsigned* st) {
    XcdBarrier b; b.bar = bar; b.x = xb_xcc_id(); b.st = st;
    if (otid() == 0) (void)xb_add(&bar[XB_XCNT(b.x)], 1u);
    return b;
}
__device__ __forceinline__ void xcd_barrier_complete(unsigned* bar, unsigned x, unsigned& nloc, unsigned& nx) {
    const unsigned G = gridDim.x * gridDim.y * gridDim.z;
    unsigned sum, cnt, mine, sp = 0u;
    for (;;) {
        sum = 0u; cnt = 0u; mine = 0u;
#pragma unroll
        for (unsigned j = 0; j < 16; ++j) { const unsigned c = xb_ld(&bar[XB_XCNT(j)]); sum += c; cnt += (c > 0u) ? 1u : 0u; mine = (j == x) ? c : mine; }
        if (sum == G) break;
        __builtin_amdgcn_s_sleep(1);
        if ((++sp & 255u) == 0u) { if (xb_ld(&bar[XB_TMO])) break; if (sp > XB_SPIN_CAP) { atomicAdd(&bar[XB_TMO], 1u); break; } }
    }
    nloc = mine > 0u ? mine : 1u; nx = cnt > 0u ? cnt : 1u;
}

__device__ __forceinline__ void xcd_barrier(const XcdBarrier& b) {
    asm volatile("s_waitcnt vmcnt(0)" ::: "memory");
    __syncthreads();
    if (otid() == 0) {
        unsigned* bar = b.bar;
        __builtin_amdgcn_s_waitcnt(0);
        unsigned nloc = b.st[0], nx = b.st[1];
        if (nloc == 0u) { xcd_barrier_complete(bar, b.x, nloc, nx); b.st[0] = nloc; b.st[1] = nx; }
        const unsigned old = xb_add(&bar[XB_XSUB(b.x)], 1u);
        const unsigned gen = old / nloc;
        if (old + 1u == (gen + 1u) * nloc) {
            __builtin_amdgcn_fence(__ATOMIC_RELEASE, "agent");
            asm volatile("s_waitcnt vmcnt(0)" ::: "memory");
            const unsigned og = xb_add(&bar[XB_TOP], 1u);
            const unsigned tg = og / nx;
            if (og + 1u == (tg + 1u) * nx) xb_add(&bar[XB_TOPGEN], 1u);
            else XB_SPIN(xb_ld(&bar[XB_TOPGEN]) == tg, bar);
            __builtin_amdgcn_fence(__ATOMIC_ACQUIRE, "agent");
            xb_add(&bar[XB_XGEN(b.x)], 1u);
            asm volatile("s_waitcnt vmcnt(0)" ::: "memory");
        } else {
            XB_SPIN(xb_ld(&bar[XB_XGEN(b.x)]) == gen, bar);
            __builtin_amdgcn_fence(__ATOMIC_ACQUIRE, "agent");
            asm volatile("s_waitcnt vmcnt(0)" ::: "memory");
        }
    }
    __syncthreads();
}

struct CvDesc { const float* src; bf16_t* dst; int K, N, mode, tile; };
__device__ __forceinline__ bool cv_decode(CArgsP a, int l, int it, CvDesc& d) {
    bf16_t* W = (bf16_t*)(a->ws + WS_W); const int e = l >> 1, odd = l & 1;
    constexpr int T_FFIN = 8 * 88, T_FFOUT = 22 * 16, T_SQ = 128, T_KV = 8 * 32;
    const int T_MIXIN = odd ? 8 * 44 : 8 * 24;
    int r = it; d.mode = 0;
    if (r < T_FFIN) { d.src = a->in[2] + (size_t)l * 1024 * 5632; d.K = 1024; d.N = 5632; d.dst = W + W_FF1IN; d.mode = 1; d.tile = r; return true; } r -= T_FFIN;
    if (r < T_FFIN) { d.src = a->in[4] + (size_t)l * 1024 * 5632; d.K = 1024; d.N = 5632; d.dst = W + W_FF2IN; d.mode = 1; d.tile = r; return true; } r -= T_FFIN;
    if (r < T_FFOUT) { d.src = a->in[3] + (size_t)l * 2816 * 1024; d.K = 2816; d.N = 1024; d.dst = W + W_FF1OUT; d.tile = r; return true; } r -= T_FFOUT;
    if (r < T_FFOUT) { d.src = a->in[5] + (size_t)l * 2816 * 1024; d.K = 2816; d.N = 1024; d.dst = W + W_FF2OUT; d.tile = r; return true; } r -= T_FFOUT;
    if (r < T_SQ) { d.src = a->in[8] + (size_t)l * 1024 * 1024; d.K = 1024; d.N = 1024; d.dst = W + W_Q; d.tile = r; return true; } r -= T_SQ;
    if (r < T_KV) { d.src = a->in[9] + (size_t)l * 1024 * 2048; d.K = 1024; d.N = 2048; d.dst = W + W_KV; d.tile = r; return true; } r -= T_KV;
    if (r < T_SQ) { d.src = a->in[10] + (size_t)l * 1024 * 1024; d.K = 1024; d.N = 1024; d.dst = W + W_O; d.tile = r; return true; } r -= T_SQ;
    if (r < T_SQ) { d.src = (odd ? a->in[20] : a->in[12]) + (size_t)e * 1024 * 1024; d.K = 1024; d.N = 1024; d.dst = W + W_MIXOUT; d.tile = r; return true; } r -= T_SQ;
    if (r < T_MIXIN) { d.K = 1024; d.dst = W + W_MIXIN; d.tile = r; if (odd) { d.src = a->in[19] + (size_t)e * 1024 * 2816; d.N = 2816; } else { d.src = a->in[11] + (size_t)e * 1024 * 1536; d.N = 1536; } return true; }
    return false;
}
__device__ __forceinline__ void cv_load(const CvDesc& d, int tid, float (&v)[16]) {
    const int ntn = d.N >> 6, k0 = (d.tile / ntn) << 7, n0 = (d.tile % ntn) << 6;
#pragma unroll
    for (int i = 0; i < 16; ++i) v[i] = d.src[(size_t)(k0 + i * 8 + (tid >> 6)) * d.N + n0 + (tid & 63)];
}
__device__ __forceinline__ void convert_layer(CArgsP a, int l, unsigned char* shm) {
    float* tb = (float*)shm; bf16_t* W = (bf16_t*)(a->ws + WS_W);
    const int e = l >> 1, odd = l & 1, tid = otid();
    {
        CvDesc d, nx; float v[16]; int it = blockIdx.x; bool have = cv_decode(a, l, it, d);
        if (have) cv_load(d, tid, v);
        while (have) {
#pragma unroll
            for (int i = 0; i < 16; ++i) tb[(i * 8 + (tid >> 6)) * 65 + (tid & 63)] = v[i];
            __syncthreads();
            it += gridDim.x; const bool hn = cv_decode(a, l, it, nx);
            if (hn) cv_load(nx, tid, v);
            const int ntn = d.N >> 6, k0 = (d.tile / ntn) << 7, n0 = (d.tile % ntn) << 6;
#pragma unroll
            for (int i = 0; i < 8; ++i) { const int nn = i * 8 + (tid >> 6), kk = 2 * (tid & 63), n = n0 + nn; const int row = d.mode ? rowmap<1>(n) : n;
                *(unsigned*)(d.dst + (size_t)row * d.K + k0 + kk) = pk2(tb[kk * 65 + nn], tb[(kk + 1) * 65 + nn]); }
            __syncthreads();
            d = nx; have = hn;
        }
    }
    const int gtid = blockIdx.x * 512 + otid(), nth = gridDim.x * 512;
    if (!odd) {
        const float* pw = a->in[13] + (size_t)e * 4 * 128 * 128;
        for (int idx = gtid; idx < 512 * 512; idx += nth) { const int n = idx >> 9, k = idx & 511, g = n >> 7, d = n & 127, g2 = k >> 7, c = k & 127;
            W[W_AUX1 + idx] = (g == g2) ? f2bf(pw[(g * 128 + c) * 128 + d]) : (bf16_t)0; }
    } else {
        const float* wup = a->in[23] + (size_t)e * 64 * 512; const float* aup = a->in[25] + (size_t)e * 64 * 512; const float* gup = a->in[26] + (size_t)e * 128 * 512;
        for (int idx = gtid; idx < 1536 * 256; idx += nth) { const int n = idx >> 8, k = idx & 255, kind = n >> 9, j = n & 511; float v = 0.f;
            if (kind == 0) { if (k < 64) v = wup[k * 512 + j]; } else if (kind == 1) { if (k >= 64 && k < 128) v = aup[(k - 64) * 512 + j]; } else { if (k >= 128) v = gup[(k - 128) * 512 + j]; }
            W[W_AUX1 + idx] = f2bf(v); }
        const float* wa = a->in[34] + (size_t)e * 8 * 64 * 64; const float* wx = a->in[36] + (size_t)e * 8 * 64 * 64;
        for (int idx = gtid; idx < 1024 * 512; idx += nth) { const int n = idx >> 9, k = idx & 511, pn = n >> 8, bj = (n >> 7) & 1, cc = n & 127, ch = pn * 128 + cc, hb = ch >> 6, jj = ch & 63; float v = 0.f;
            if ((k >> 6) == hb) v = (bj ? wx : wa)[(hb * 64 + (k & 63)) * 64 + jj];
            W[W_AUX2 + idx] = f2bf(v); }
    }
}
__device__ __forceinline__ void prologue_cast(CArgsP a) {
    const int gtid = blockIdx.x * 512 + otid(), nth = gridDim.x * 512;
    const f32x4* x4 = (const f32x4*)a->in[0]; u32x2* xb = (u32x2*)(a->ws + WS_XB);
    for (int i0 = gtid; i0 < NTOK * DM / 4; i0 += nth * 8) { f32x4 v[8];
#pragma unroll
        for (int u = 0; u < 8; ++u) { const int i = i0 + u * nth; v[u] = (i < NTOK * DM / 4) ? x4[i] : (f32x4){0.f, 0.f, 0.f, 0.f}; }
#pragma unroll
        for (int u = 0; u < 8; ++u) { const int i = i0 + u * nth; if (i < NTOK * DM / 4) { u32x2 o; o.x = pk2(v[u][0], v[u][1]); o.y = pk2(v[u][2], v[u][3]); xb[i] = o; ((h16x4*)a->out)[i] = __builtin_convertvector(v[u], h16x4); } } }
    { float* MR = (float*)(a->ws + WS_MR); for (int i = gtid; i < NTOK; i += nth) { MR[2 * i] = 0.f; MR[2 * i + 1] = 1.f; } }
    const f32x4* m4 = (const f32x4*)a->in[1]; u32x2* mb = (u32x2*)(a->ws + WS_MISC + 2 * MiB);
    for (int i = gtid; i < 512 * DM / 4; i += nth) { const f32x4 v = m4[i]; u32x2 o; o.x = pk2(v[0], v[1]); o.y = pk2(v[2], v[3]); mb[i] = o; }
}
#define DPP_F(v, ctrl) __builtin_bit_cast(float, __builtin_amdgcn_update_dpp(0, __builtin_bit_cast(int, (v)), (ctrl), 0xF, 0xF, false))
__device__ __forceinline__ float wsum_fast(float v) {
    v += DPP_F(v, 0xB1); v += DPP_F(v, 0x4E); v += DPP_F(v, 0x141); v += DPP_F(v, 0x140);
    const int iv = __builtin_bit_cast(int, v);
    const float s0 = __builtin_bit_cast(float, __builtin_amdgcn_readlane(iv, 0)), s1 = __builtin_bit_cast(float, __builtin_amdgcn_readlane(iv, 16));
    const float s2 = __builtin_bit_cast(float, __builtin_amdgcn_readlane(iv, 32)), s3 = __builtin_bit_cast(float, __builtin_amdgcn_readlane(iv, 48));
    return (s0 + s1) + (s2 + s3);
}
__device__ __forceinline__ void ln_phase(const void* zin, float* xo, bf16_t* XB, float* MR, const float* g, const float* b, int bofs, int nblk) {
    const int lane = otid() & 63, wave = otid() >> 6;
    int row = ((int)blockIdx.x - bofs) * 8 + wave; const int rstep = nblk * 8;
    {
        f32x4 g4[2][2], b4[2][2];
#pragma unroll
        for (int j = 0; j < 2; ++j)
#pragma unroll
            for (int q = 0; q < 2; ++q) { g4[j][q] = *(const f32x4*)(g + 8 * lane + 512 * j + 4 * q); b4[j][q] = *(const f32x4*)(b + 8 * lane + 512 * j + 4 * q); }
        h16x8 nx[2];
        if (row < NTOK) {
#pragma unroll
            for (int j = 0; j < 2; ++j) nx[j] = *(const h16x8*)((const h16*)zin + (size_t)row * DM + 8 * lane + 512 * j);
        }
        for (; row < NTOK; row += rstep) {
            float v[2][8]; float s = 0.f;
#pragma unroll
            for (int j = 0; j < 2; ++j)
#pragma unroll
                for (int q = 0; q < 8; ++q) { v[j][q] = (float)nx[j][q]; s += v[j][q]; }
            if (row + rstep < NTOK) {
#pragma unroll
                for (int j = 0; j < 2; ++j) nx[j] = *(const h16x8*)((const h16*)zin + (size_t)(row + rstep) * DM + 8 * lane + 512 * j);
            }
            const float mean = wsum_fast(s) * (1.f / DM); float s2 = 0.f;
#pragma unroll
            for (int j = 0; j < 2; ++j)
#pragma unroll
                for (int q = 0; q < 8; ++q) { v[j][q] -= mean; s2 += v[j][q] * v[j][q]; }
            const float rstd = rsqrtf(wsum_fast(s2) * (1.f / DM) + 1e-5f);
            if (lane == 0) { MR[2 * row] = mean; MR[2 * row + 1] = rstd; }
#pragma unroll
            for (int j = 0; j < 2; ++j) { float y[8];
#pragma unroll
                for (int q = 0; q < 8; ++q) y[q] = v[j][q] * rstd * g4[j][q >> 2][q & 3] + b4[j][q >> 2][q & 3];
                u32x4 o; o.x = pk2(y[0], y[1]); o.y = pk2(y[2], y[3]); o.z = pk2(y[4], y[5]); o.w = pk2(y[6], y[7]);
                *(u32x4*)(XB + (size_t)row * DM + 8 * lane + 512 * j) = o; }
        }
    }
}
__device__ __forceinline__ void ln_final_load(const h16* zin, h16x8 (&zr)[16][2]) {
    const int lane = otid() & 63, wave = otid() >> 6;
#pragma unroll
    for (int i = 0; i < 16; ++i) { const int row = (int)blockIdx.x * 8 + wave + i * (int)gridDim.x * 8;
#pragma unroll
        for (int j = 0; j < 2; ++j) zr[i][j] = (row < NTOK) ? *(const h16x8*)(zin + (size_t)row * DM + 8 * lane + 512 * j) : (h16x8)(h16)0; }
}
__device__ __forceinline__ void ln_final_store(const h16x8 (&zr)[16][2], float* xo, const float* g, const float* b) {
    const int lane = otid() & 63, wave = otid() >> 6;
    f32x4 g4[2][2], b4[2][2];
#pragma unroll
    for (int j = 0; j < 2; ++j)
#pragma unroll
        for (int q = 0; q < 2; ++q) { g4[j][q] = *(const f32x4*)(g + 8 * lane + 512 * j + 4 * q); b4[j][q] = *(const f32x4*)(b + 8 * lane + 512 * j + 4 * q); }
#pragma unroll
    for (int i = 0; i < 16; ++i) { const int row = (int)blockIdx.x * 8 + wave + i * (int)gridDim.x * 8; float v[2][8]; float s = 0.f;
#pragma unroll
        for (int j = 0; j < 2; ++j)
#pragma unroll
            for (int q = 0; q < 8; ++q) { v[j][q] = (float)zr[i][j][q]; s += v[j][q]; }
        const float mean = wsum_fast(s) * (1.f / DM); float s2 = 0.f;
#pragma unroll
        for (int j = 0; j < 2; ++j)
#pragma unroll
            for (int q = 0; q < 8; ++q) { v[j][q] -= mean; s2 += v[j][q] * v[j][q]; }
        const float rstd = rsqrtf(wsum_fast(s2) * (1.f / DM) + 1e-5f);
        if (row < NTOK) {
#pragma unroll
            for (int j = 0; j < 2; ++j)
#pragma unroll
                for (int q = 0; q < 2; ++q) { f32x4 y;
#pragma unroll
                    for (int t = 0; t < 4; ++t) y[t] = v[j][4 * q + t] * rstd * g4[j][q][t] + b4[j][q][t];
                    *(f32x4*)(xo + (size_t)row * DM + 8 * lane + 512 * j + 4 * q) = y; } } }
}
constexpr int AT_LD = 528;
__device__ __forceinline__ void attn_fill(LAS unsigned char* lds, const bf16_t* src, int ld_src, int tid) {
#pragma unroll 1
    for (int hb = 0; hb < 16; hb += 8) { u32x4 t[8];
#pragma unroll
        for (int i = 0; i < 8; ++i) { const int id = (hb + i) * 512 + tid, row = id >> 5, c = id & 31; t[i] = *(const u32x4*)(src + (size_t)row * ld_src + c * 8); }
#pragma unroll
        for (int i = 0; i < 8; ++i) { const int id = (hb + i) * 512 + tid, row = id >> 5, c = id & 31; *(LAS u32x4*)(lds + row * AT_LD + c * 16) = t[i]; } }
}
__device__ __forceinline__ void attn_phase(const bf16_t* Q, const bf16_t* Kb, const bf16_t* VT, bf16_t* O, unsigned char* shm) {
    const int tid = otid(), lane = tid & 63, wave = tid >> 6, fr = lane & 15, fq = lane >> 4;
    LAS unsigned char* lds = (LAS unsigned char*)shm;
    for (int item = blockIdx.x; item < 512; item += gridDim.x) {
        const int bh = item & 7, b = bh >> 2, h = bh & 3, row0 = b * SEQ + (item >> 3) * 256 + wave * 32;
        bf16x8 qf[2][8];
#pragma unroll
        for (int t = 0; t < 2; ++t)
#pragma unroll
            for (int ks = 0; ks < 8; ++ks) qf[t][ks] = *(const bf16x8*)(Q + (size_t)(row0 + t * 16 + fr) * DM + h * 256 + ks * 32 + fq * 8);
        attn_fill(lds, Kb + (size_t)(b * 256) * DM + h * 256, DM, tid);
        __syncthreads();
        f32x4 s[2][16];
        {
            bf16x8 kf[3][2]; f32x4 a0 = {0.f, 0.f, 0.f, 0.f}, a1 = {0.f, 0.f, 0.f, 0.f};
            const LAS unsigned char* kb = lds + fr * AT_LD + fq * 16;
#pragma unroll
            for (int pg = 0; pg < 2; ++pg)
#pragma unroll
                for (int ks = 0; ks < 2; ++ks) kf[pg][ks] = *(const LAS bf16x8*)(kb + pg * 128 + ks * 64);
#pragma unroll
            for (int g = 0; g < 64; ++g) { const int mt = g >> 2, qd = g & 3;
                if (g + 2 < 64) { const int ng = g + 2; const LAS unsigned char* np = kb + (ng >> 2) * 16 * AT_LD + (ng & 3) * 128;
#pragma unroll
                    for (int ks = 0; ks < 2; ++ks) kf[ng % 3][ks] = *(const LAS bf16x8*)(np + ks * 64); }
                __builtin_amdgcn_sched_barrier(0);
#pragma unroll
                for (int ks = 0; ks < 2; ++ks) { const bf16x8 kv = kf[g % 3][ks];
                    a0 = __builtin_amdgcn_mfma_f32_16x16x32_bf16(kv, qf[0][qd * 2 + ks], a0, 0, 0, 0); a1 = __builtin_amdgcn_mfma_f32_16x16x32_bf16(kv, qf[1][qd * 2 + ks], a1, 0, 0, 0); }
                if (qd == 3) { s[0][mt] = a0; s[1][mt] = a1; a0 = (f32x4){0.f, 0.f, 0.f, 0.f}; a1 = (f32x4){0.f, 0.f, 0.f, 0.f}; }
                __builtin_amdgcn_sched_barrier(0); }
        }
        bf16x8 pb[2][8]; float inv[2];
#pragma unroll
        for (int t = 0; t < 2; ++t) { float mx = -3.0e38f;
#pragma unroll
            for (int mt = 0; mt < 16; ++mt)
#pragma unroll
                for (int q = 0; q < 4; ++q) mx = fmaxf(mx, s[t][mt][q]);
            mx = fmaxf(mx, __shfl_xor(mx, 16)); mx = fmaxf(mx, __shfl_xor(mx, 32));
            float sum = 0.f;
#pragma unroll
            for (int mt = 0; mt < 16; ++mt)
#pragma unroll
                for (int q = 0; q < 4; ++q) { const float pv = __expf(s[t][mt][q] - mx); s[t][mt][q] = pv; sum += pv; }
            sum += __shfl_xor(sum, 16); sum += __shfl_xor(sum, 32); inv[t] = 1.0f / sum;
#pragma unroll
            for (int kp = 0; kp < 8; ++kp) { u32x4 tt; tt.x = pk2(s[t][2 * kp][0], s[t][2 * kp][1]); tt.y = pk2(s[t][2 * kp][2], s[t][2 * kp][3]); tt.z = pk2(s[t][2 * kp + 1][0], s[t][2 * kp + 1][1]); tt.w = pk2(s[t][2 * kp + 1][2], s[t][2 * kp + 1][3]);
                pb[t][kp] = __builtin_bit_cast(bf16x8, tt); } }
        __syncthreads();
        attn_fill(lds, VT + (size_t)((b * 4 + h) * 256) * 256, 256, tid);
        __syncthreads();
        {
            u32x2 vA[8], vB[8]; f32x4 a0 = {0.f, 0.f, 0.f, 0.f}, a1 = {0.f, 0.f, 0.f, 0.f};
            const LAS unsigned char* vb = lds + fr * AT_LD + fq * 8;
#pragma unroll
            for (int q = 0; q < 8; ++q) vA[q] = *(const LAS u32x2*)(vb + q * 32);
#pragma unroll
            for (int g = 0; g < 32; ++g) { const int dt = g >> 1, hf = g & 1;
                if (g + 1 < 32) { const int ndt = (g + 1) >> 1, nhf = (g + 1) & 1; const LAS unsigned char* np = vb + ndt * 16 * AT_LD + nhf * 256;
#pragma unroll
                    for (int q = 0; q < 8; ++q) { if (g & 1) vA[q] = *(const LAS u32x2*)(np + q * 32); else vB[q] = *(const LAS u32x2*)(np + q * 32); } }
                __builtin_amdgcn_sched_barrier(0);
#pragma unroll
                for (int kq = 0; kq < 4; ++kq) { const u32x2 lo = (g & 1) ? vB[2 * kq] : vA[2 * kq], hi = (g & 1) ? vB[2 * kq + 1] : vA[2 * kq + 1]; u32x4 tt; tt.x = lo.x; tt.y = lo.y; tt.z = hi.x; tt.w = hi.y;
                    const bf16x8 vf = __builtin_bit_cast(bf16x8, tt);
                    a0 = __builtin_amdgcn_mfma_f32_16x16x32_bf16(vf, pb[0][hf * 4 + kq], a0, 0, 0, 0); a1 = __builtin_amdgcn_mfma_f32_16x16x32_bf16(vf, pb[1][hf * 4 + kq], a1, 0, 0, 0); }
                if (hf) { u32x2 o; o.x = pk2(a0[0] * inv[0], a0[1] * inv[0]); o.y = pk2(a0[2] * inv[0], a0[3] * inv[0]);
                    *(u32x2*)(O + (size_t)(row0 + fr) * DM + h * 256 + dt * 16 + fq * 4) = o;
                    o.x = pk2(a1[0] * inv[1], a1[1] * inv[1]); o.y = pk2(a1[2] * inv[1], a1[3] * inv[1]);
                    *(u32x2*)(O + (size_t)(row0 + 16 + fr) * DM + h * 256 + dt * 16 + fq * 4) = o;
                    a0 = (f32x4){0.f, 0.f, 0.f, 0.f}; a1 = (f32x4){0.f, 0.f, 0.f, 0.f}; }
                __builtin_amdgcn_sched_barrier(0); }
        }
        __syncthreads();
    }
}
__device__ __forceinline__ void even_core(CArgsP a, int e, unsigned char* shm) {
    const bf16_t* H = (const bf16_t*)(a->ws + WS_H); bf16_t* POOLED = (bf16_t*)(a->ws + WS_LO); bf16_t* CONCAT = (bf16_t*)(a->ws + WS_XB);
    const int tid = otid(), lane = tid & 63, wave = tid >> 6;
    LAS float* Wl = (LAS float*)shm; LAS float* Vl = Wl + 128 * 129; LAS float* st = Vl + 128 * 128;
    const float* sgw = a->in[17] + (size_t)e * 4 * 128 * 128; const float* sgb = a->in[18] + (size_t)e * 4 * 128;
    const float* lng = a->in[15] + (size_t)e * 512; const float* lnb = a->in[16] + (size_t)e * 512;
    for (int chunk = blockIdx.x; chunk < NTOK / 128; chunk += gridDim.x) {
        const int tok0 = chunk * 128, tseq0 = tok0 & (SEQ - 1);
        {
            const int c = tid, grp = c >> 7; float hist[16]; hist[0] = 0.f;
#pragma unroll
            for (int u = 1; u < 16; ++u) { const int p = u - 16; hist[u] = (tseq0 + p >= 0) ? bf2f(H[(size_t)(tok0 + p) * 1536 + c]) : 0.f; }
            for (int tb = 0; tb < 128; tb += 16) {
#pragma unroll
                for (int u = 0; u < 16; ++u) { const int t = tb + u; const float x = bf2f(H[(size_t)(tok0 + t) * 1536 + c]); hist[u] = x;
                    const float s2 = x + hist[(u + 15) & 15];
                    const float s4 = s2 + hist[(u + 14) & 15] + hist[(u + 13) & 15];
                    const float s8 = s4 + (hist[(u + 12) & 15] + hist[(u + 11) & 15]) + (hist[(u + 10) & 15] + hist[(u + 9) & 15]);
                    const float s16 = s8 + ((hist[(u + 8) & 15] + hist[(u + 7) & 15]) + (hist[(u + 6) & 15] + hist[(u + 5) & 15])) + ((hist[(u + 4) & 15] + hist[(u + 3) & 15]) + (hist[(u + 2) & 15] + hist[(u + 1) & 15]));
                    const float sum = grp == 0 ? s2 : grp == 1 ? s4 : grp == 2 ? s8 : s16; const int win = 2 << grp, pos = tseq0 + t + 1;
                    const float dv = (float)(pos < win ? pos : win);
                    POOLED[(size_t)(tok0 + t) * 512 + c] = f2bf(sum / dv - x); }
            }
        }
#pragma unroll 8
        for (int i = 0; i < 16; ++i) { const int t = wave + 8 * i; const bf16x8 v8 = *(const bf16x8*)(H + (size_t)(tok0 + t) * 1536 + 1024 + lane * 8); float f[8], s = 0.f;
#pragma unroll
            for (int q = 0; q < 8; ++q) { f[q] = bfs2f(v8[q]); s += f[q]; }
            const float mean = wsum_fast(s) * (1.f / 512.f); float s2 = 0.f;
#pragma unroll
            for (int q = 0; q < 8; ++q) { const float d = f[q] - mean; s2 += d * d; }
            const float var = wsum_fast(s2) * (1.f / 512.f);
            if (lane == 0) { st[2 * t] = mean; st[2 * t + 1] = rsqrtf(var + 1e-5f); } }
        __syncthreads();
        for (int h = 0; h < 4; ++h) {
#pragma unroll
            for (int it = 0; it < 8; ++it) { const int idx = it * 512 + tid, t = idx >> 5, s0 = (idx & 31) * 4; const f32x4 w4 = *(const f32x4*)(sgw + (size_t)(h * 128 + t) * 128 + s0);
#pragma unroll
                for (int q = 0; q < 4; ++q) Wl[t * 129 + s0 + q] = (s0 + q <= t) ? w4[q] : 0.f; }
#pragma unroll
            for (int it = 0; it < 4; ++it) { const int idx = it * 512 + tid, s = idx >> 4, d0 = (idx & 15) * 8; const bf16x8 v8 = *(const bf16x8*)(H + (size_t)(tok0 + s) * 1536 + 1024 + h * 128 + d0);
                const float mean = st[2 * s], rstd = st[2 * s + 1];
#pragma unroll
                for (int q = 0; q < 8; ++q) Vl[s * 128 + d0 + q] = (bfs2f(v8[q]) - mean) * rstd * lng[h * 128 + d0 + q] + lnb[h * 128 + d0 + q]; }
            __syncthreads();
            const int d0 = (tid & 15) * 8, t0 = (tid >> 4) * 4;
            float acc[4][8];
#pragma unroll
            for (int i = 0; i < 4; ++i)
#pragma unroll
                for (int q = 0; q < 8; ++q) acc[i][q] = 0.f;
            for (int s = 0; s <= t0 + 3; ++s) { const f32x4 va = *(const LAS f32x4*)(Vl + s * 128 + d0), vb = *(const LAS f32x4*)(Vl + s * 128 + d0 + 4);
#pragma unroll
                for (int i = 0; i < 4; ++i) { const float w = Wl[(t0 + i) * 129 + s];
#pragma unroll
                    for (int q = 0; q < 4; ++q) { acc[i][q] += w * va[q]; acc[i][4 + q] += w * vb[q]; } } }
#pragma unroll
            for (int i = 0; i < 4; ++i) { const int t = t0 + i; const float bias = sgb[h * 128 + t]; const bf16x8 u8 = *(const bf16x8*)(H + (size_t)(tok0 + t) * 1536 + 512 + h * 128 + d0);
                float o[8];
#pragma unroll
                for (int q = 0; q < 8; ++q) o[q] = bfs2f(u8[q]) * (acc[i][q] + bias);
                u32x4 ov; ov.x = pk2(o[0], o[1]); ov.y = pk2(o[2], o[3]); ov.z = pk2(o[4], o[5]); ov.w = pk2(o[6], o[7]);
                *(u32x4*)(CONCAT + (size_t)(tok0 + t) * 1024 + 512 + h * 128 + d0) = ov; }
            __syncthreads();
        }
    }
}
__device__ __forceinline__ void odd_prep(CArgsP a, int e) {
    const bf16_t* H = (const bf16_t*)(a->ws + WS_H); bf16_t* AP = (bf16_t*)(a->ws + WS_AP); bf16_t* XC = (bf16_t*)(a->ws + WS_XC);
    const float* mu = a->in[21] + (size_t)e * 1792; const float* cw = a->in[32] + (size_t)e * 4 * 512; const float* cb = a->in[33] + (size_t)e * 512;
    const int gtid = blockIdx.x * 512 + otid(), nth = gridDim.x * 512;
    const bf16x8 z8 = {0, 0, 0, 0, 0, 0, 0, 0};
    for (int it0 = gtid; it0 < NTOK * 32; it0 += nth * 4) { bf16x8 cur[4], prv[4];
#pragma unroll
        for (int u = 0; u < 4; ++u) { const int it = it0 + u * nth, tok = it >> 5, c0 = (it & 31) * 8; const bool ok = it < NTOK * 32;
            cur[u] = ok ? *(const bf16x8*)(H + (size_t)tok * 2816 + 1536 + c0) : z8;
            prv[u] = (ok && (tok & (SEQ - 1))) ? *(const bf16x8*)(H + (size_t)(tok - 1) * 2816 + 1536 + c0) : z8; }
#pragma unroll
        for (int u = 0; u < 4; ++u) { const int it = it0 + u * nth, tok = it >> 5, c0 = (it & 31) * 8; if (it < NTOK * 32) { float v[8];
#pragma unroll
            for (int q = 0; q < 8; ++q) { const float c = bfs2f(cur[u][q]), z = c + mu[1536 + c0 + q] * (bfs2f(prv[u][q]) - c); v[q] = c0 < 64 ? tanhf_(z) : (c0 < 128 ? z : sigmoidf_(z)); }
            u32x4 o; o.x = pk2(v[0], v[1]); o.y = pk2(v[2], v[3]); o.z = pk2(v[4], v[5]); o.w = pk2(v[6], v[7]); *(u32x4*)(AP + (size_t)tok * 256 + c0) = o; } } }
    for (int it0 = gtid; it0 < NTOK * 64; it0 += nth * 4) { bf16x8 x8[4][4];
#pragma unroll
        for (int u = 0; u < 4; ++u) { const int it = it0 + u * nth, tok = it >> 6, c0 = (it & 63) * 8, tseq = tok & (SEQ - 1); const bool ok = it < NTOK * 64;
#pragma unroll
            for (int i = 0; i < 4; ++i) x8[u][i] = (ok && tseq - 3 + i >= 0) ? *(const bf16x8*)(H + (size_t)(tok - 3 + i) * 2816 + 2304 + c0) : z8; }
#pragma unroll
        for (int u = 0; u < 4; ++u) { const int it = it0 + u * nth, tok = it >> 6, c0 = (it & 63) * 8; if (it < NTOK * 64) { float v[8];
#pragma unroll
            for (int q = 0; q < 8; ++q) v[q] = cb[c0 + q];
#pragma unroll
            for (int i = 0; i < 4; ++i)
#pragma unroll
                for (int q = 0; q < 8; ++q) v[q] += cw[i * 512 + c0 + q] * bfs2f(x8[u][i][q]);
            u32x4 o; o.x = pk2(v[0], v[1]); o.y = pk2(v[2], v[3]); o.z = pk2(v[4], v[5]); o.w = pk2(v[6], v[7]); *(u32x4*)(XC + (size_t)tok * 512 + c0) = o; } } }
}
constexpr int RW_STEP = 448, RW_WAVE = 8 * RW_STEP + 8;
typedef float f32x2 __attribute__((ext_vector_type(2)));
__device__ __forceinline__ float red8(float v) {
    v += __builtin_bit_cast(float, __builtin_amdgcn_update_dpp(0, __builtin_bit_cast(int, v), 0xB1, 0xF, 0xF, false));
    v += __builtin_bit_cast(float, __builtin_amdgcn_update_dpp(0, __builtin_bit_cast(int, v), 0x4E, 0xF, 0xF, false));
    v += __builtin_bit_cast(float, __builtin_amdgcn_update_dpp(0, __builtin_bit_cast(int, v), 0x141, 0xF, 0xF, false));
    return v;
}
__device__ __forceinline__ float red4(float v) { v += DPP_F(v, 0xB1); v += DPP_F(v, 0x4E); return v; }
#define LD8P(dst, ptr) do { _Pragma("unroll") for (int _q = 0; _q < 4; ++_q) { const f32x4 _t = *(const LAS f32x4*)((ptr) + 4 * _q); dst[2 * _q] = (f32x2){_t[0], _t[1]}; dst[2 * _q + 1] = (f32x2){_t[2], _t[3]}; } } while (0)
template <int MODE> __device__ __forceinline__ void rwkv_scan(CArgsP a, int e, int bh, int c, LAS float* wl) {
    const int lane = otid() & 63, b = bh >> 3, h = bh & 7, cj = h * 64 + lane, ib = lane >> 2, jb = lane & 3;
    const bf16_t* H = (const bf16_t*)(a->ws + WS_H); const bf16_t* LO = (const bf16_t*)(a->ws + WS_LO); bf16_t* CONCAT = (bf16_t*)(a->ws + WS_XB);
    float* Lc = (float*)(a->ws + WS_AP); float* Mc = Lc + (size_t)16 * NCH * 4096; float* Ss = Mc + (size_t)16 * NCH * 4096;
    const size_t sidx = ((size_t)bh * NCH + c) * 4096 + (size_t)(ib * 4) * 64 + jb * 16;
    const int tok0 = b * SEQ + c * TCH;
    const float* mu = a->in[21] + (size_t)e * 1792;
    const float mu_r = mu[cj], mu_k = mu[512 + cj], mu_v = mu[1024 + cj], kkc = a->in[27][e * 512 + cj], kac = a->in[28][e * 512 + cj], rkc = a->in[29][e * 512 + cj];
    const float gng = a->in[30][e * 512 + cj], gnb = a->in[31][e * 512 + cj];
    const float w0c = a->in[22][e * 512 + cj], a0c = a->in[24][e * 512 + cj];
    f32x2 S[4][8];
    if (MODE == 2) {
#pragma unroll
        for (int r = 0; r < 4; ++r)
#pragma unroll
            for (int q = 0; q < 4; ++q) { const f32x4 t = *(const f32x4*)(Ss + sidx + r * 64 + 4 * q); S[r][2 * q] = (f32x2){t[0], t[1]}; S[r][2 * q + 1] = (f32x2){t[2], t[3]}; }
    } else {
#pragma unroll
        for (int r = 0; r < 4; ++r)
#pragma unroll
            for (int q = 0; q < 8; ++q) { const int row = ib * 4 + r, col = jb * 16 + 2 * q; S[r][q][0] = (MODE == 1 && row == col) ? 1.f : 0.f; S[r][q][1] = (MODE == 1 && row == col + 1) ? 1.f : 0.f; }
    }
    float pr = 0.f, pk = 0.f, pv = 0.f;
    if (c > 0) { const bf16_t* hp = H + (size_t)(tok0 - 1) * 2816 + cj; pr = bf2f(hp[0]); pk = bf2f(hp[512]); pv = bf2f(hp[1024]); }
    unsigned short rw[8][6];
#define RW_LOAD(T0) do { _Pragma("unroll") for (int s = 0; s < 8; ++s) { const size_t tok = (size_t)(tok0 + (T0) + s); const bf16_t* hp = H + tok * 2816 + cj; const bf16_t* lp = LO + tok * 1536 + cj; \
        rw[s][0] = hp[0]; rw[s][1] = hp[512]; rw[s][2] = hp[1024]; rw[s][3] = lp[0]; rw[s][4] = lp[512]; if (MODE == 2) rw[s][5] = lp[1024]; } } while (0)
    RW_LOAD(0);
    for (int t0 = 0; t0 < TCH; t0 += 8) {
#pragma unroll
        for (int s = 0; s < 8; ++s) {
            const float rr = bf2f(rw[s][0]), kr = bf2f(rw[s][1]), vr = bf2f(rw[s][2]), ee = __expf(-softplusf_(-(w0c + bf2f(rw[s][3]))) - 0.5f), aa = sigmoidf_(a0c + bf2f(rw[s][4]));
            const float rl = rr + mu_r * (pr - rr), kl = kr + mu_k * (pk - kr), vl = vr + mu_v * (pv - vr); pr = rr; pk = kr; pv = vr;
            const float kkj = kl * kkc, ss = wsum_fast(kkj * kkj), kn = kkj * rsqrtf(fmaxf(ss, 1e-24f));
            const float kp = kl * (1.0f + (aa - 1.0f) * kac), dec = __expf(-ee);
            LAS float* base = wl + s * RW_STEP;
            base[lane] = -kn; base[64 + lane] = dec; base[128 + lane] = kn * aa; base[192 + lane] = kp; base[320 + lane] = vl;
            if (MODE == 2) { base[256 + lane] = rl; base[384 + lane] = bf2f(rw[s][5]); const float bd = wsum_fast(rl * kp * rkc); if (lane == 0) wl[8 * RW_STEP + s] = bd; } }
        if (t0 + 8 < TCH) RW_LOAD(t0 + 8);
        LDS_SYNC_WAVE();
#pragma unroll 2
        for (int s = 0; s < 8; ++s) { const LAS float* base = wl + s * RW_STEP;
            f32x2 av[8], dc[8], bv[8], kp[8]; f32x4 vr4 = {0.f, 0.f, 0.f, 0.f};
            LD8P(av, base + jb * 16); LD8P(dc, base + 64 + jb * 16); LD8P(bv, base + 128 + jb * 16);
            if (MODE != 1) { LD8P(kp, base + 192 + jb * 16); vr4 = *(const LAS f32x4*)(base + 320 + ib * 4); }
            float sa[4];
#pragma unroll
            for (int r = 0; r < 4; ++r) { f32x2 p = S[r][0] * av[0];
#pragma unroll
                for (int q = 1; q < 8; ++q) p += S[r][q] * av[q];
                sa[r] = red4(p[0] + p[1]); }
#pragma unroll
            for (int r = 0; r < 4; ++r) { const f32x2 sa2 = (f32x2){sa[r], sa[r]};
                if (MODE == 1) {
#pragma unroll
                    for (int q = 0; q < 8; ++q) S[r][q] = S[r][q] * dc[q] + sa2 * bv[q];
                } else { const f32x2 v2 = (f32x2){vr4[r], vr4[r]};
#pragma unroll
                    for (int q = 0; q < 8; ++q) S[r][q] = S[r][q] * dc[q] + (sa2 * bv[q] + v2 * kp[q]); } }
            if (MODE == 2) { f32x2 rv[8]; LD8P(rv, base + 256 + jb * 16);
                float y = 0.f;
#pragma unroll
                for (int r = 0; r < 4; ++r) { f32x2 p = S[r][0] * rv[0];
#pragma unroll
                    for (int q = 1; q < 8; ++q) p += S[r][q] * rv[q];
                    const float yr = red4(p[0] + p[1]); y = (jb == r) ? yr : y; }
                const float vi = base[320 + lane];
                const float mean = wsum_fast(y) * (1.f / 64.f), ey2 = wsum_fast(y * y) * (1.f / 64.f), dl = y - mean, var = fmaxf(ey2 - mean * mean, 0.f);
                const float yn = dl * rsqrtf(var + 64e-5f) * gng + gnb;
                const float o = (yn + wl[8 * RW_STEP + s] * vi) * base[384 + lane];
                CONCAT[(size_t)(tok0 + t0 + s) * 1024 + cj] = f2bf(o); } }
        LDS_SYNC_WAVE();
    }
#undef RW_LOAD
    if (MODE != 2) { float* dst = (MODE == 0 ? Lc : Mc) + sidx;
#pragma unroll
        for (int r = 0; r < 4; ++r)
#pragma unroll
            for (int q = 0; q < 4; ++q) { f32x4 t; t[0] = S[r][2 * q][0]; t[1] = S[r][2 * q][1]; t[2] = S[r][2 * q + 1][0]; t[3] = S[r][2 * q + 1][1]; *(f32x4*)(dst + r * 64 + 4 * q) = t; } }
}
template <int MODE> __device__ __forceinline__ void rwkv_pass1_pair(CArgsP a, int e, int bh, int c, LAS float* pl) {
    const int lane = otid() & 63, b = bh >> 3, h = bh & 7, cj = h * 64 + lane, ib = lane >> 2, jb = lane & 3;
    const bf16_t* H = (const bf16_t*)(a->ws + WS_H); const bf16_t* LO = (const bf16_t*)(a->ws + WS_LO);
    float* Lc = (float*)(a->ws + WS_AP); float* Mc = Lc + (size_t)16 * NCH * 4096;
    const size_t sidx = ((size_t)bh * NCH + c) * 4096 + (size_t)(ib * 4) * 64 + jb * 16;
    const int tok0 = b * SEQ + c * TCH;
    const float* mu = a->in[21] + (size_t)e * 1792;
    const float mu_k = mu[512 + cj], mu_v = mu[1024 + cj], kkc = a->in[27][e * 512 + cj], kac = a->in[28][e * 512 + cj];
    const float w0c = a->in[22][e * 512 + cj], a0c = a->in[24][e * 512 + cj];
    f32x2 S[4][8];
#pragma unroll
    for (int r = 0; r < 4; ++r)
#pragma unroll
        for (int q = 0; q < 8; ++q) { const int row = ib * 4 + r, col = jb * 16 + 2 * q; S[r][q][0] = (MODE == 1 && row == col) ? 1.f : 0.f; S[r][q][1] = (MODE == 1 && row == col + 1) ? 1.f : 0.f; }
    unsigned short rw[5][4];
#define RW1_LOAD(T0) do { _Pragma("unroll") for (int s = 0; s < 5; ++s) { const int tk = tok0 + (T0) + MODE * 4 + s - 1; const bf16_t* hp = H + (size_t)tk * 2816 + cj; const bf16_t* lp = LO + (size_t)tk * 1536 + cj; \
        if (s == 0) { const bool have = (c > 0) || ((T0) + MODE * 4 > 0); rw[0][0] = have ? hp[512] : (unsigned short)0; rw[0][1] = have ? hp[1024] : (unsigned short)0; } \
        else { rw[s][0] = hp[512]; rw[s][1] = hp[1024]; rw[s][2] = lp[0]; rw[s][3] = lp[512]; } } } while (0)
    RW1_LOAD(0);
    for (int t0 = 0; t0 < TCH; t0 += 8) {
        float pk = bf2f(rw[0][0]), pv = bf2f(rw[0][1]);
#pragma unroll
        for (int u = 0; u < 4; ++u) { const int s = MODE * 4 + u;
            const float kr = bf2f(rw[u + 1][0]), vr = bf2f(rw[u + 1][1]), ee = __expf(-softplusf_(-(w0c + bf2f(rw[u + 1][2]))) - 0.5f), aa = sigmoidf_(a0c + bf2f(rw[u + 1][3]));
            const float kl = kr + mu_k * (pk - kr), vl = vr + mu_v * (pv - vr); pk = kr; pv = vr;
            const float kkj = kl * kkc, ss = wsum_fast(kkj * kkj), kn = kkj * rsqrtf(fmaxf(ss, 1e-24f));
            const float kp = kl * (1.0f + (aa - 1.0f) * kac), dec = __expf(-ee);
            LAS float* base = pl + s * RW_STEP;
            base[lane] = -kn; base[64 + lane] = dec; base[128 + lane] = kn * aa; base[192 + lane] = kp; base[320 + lane] = vl; }
        if (t0 + 8 < TCH) RW1_LOAD(t0 + 8);
        __syncthreads();
#pragma unroll 2
        for (int s = 0; s < 8; ++s) { const LAS float* base = pl + s * RW_STEP;
            f32x2 av[8], dc[8], bv[8], kp[8]; f32x4 vr4 = {0.f, 0.f, 0.f, 0.f};
            LD8P(av, base + jb * 16); LD8P(dc, base + 64 + jb * 16); LD8P(bv, base + 128 + jb * 16);
            if (MODE == 0) { LD8P(kp, base + 192 + jb * 16); vr4 = *(const LAS f32x4*)(base + 320 + ib * 4); }
            float sa[4];
#pragma unroll
            for (int r = 0; r < 4; ++r) { f32x2 pp = S[r][0] * av[0];
#pragma unroll
                for (int q = 1; q < 8; ++q) pp += S[r][q] * av[q];
                sa[r] = red4(pp[0] + pp[1]); }
#pragma unroll
            for (int r = 0; r < 4; ++r) { const f32x2 sa2 = (f32x2){sa[r], sa[r]};
                if (MODE == 1) {
#pragma unroll
                    for (int q = 0; q < 8; ++q) S[r][q] = S[r][q] * dc[q] + sa2 * bv[q];
                } else { const f32x2 v2 = (f32x2){vr4[r], vr4[r]};
#pragma unroll
                    for (int q = 0; q < 8; ++q) S[r][q] = S[r][q] * dc[q] + (sa2 * bv[q] + v2 * kp[q]); } } }
        __syncthreads();
    }
#undef RW1_LOAD
    float* dst = (MODE == 0 ? Lc : Mc) + sidx;
#pragma unroll
    for (int r = 0; r < 4; ++r)
#pragma unroll
        for (int q = 0; q < 4; ++q) { f32x4 t; t[0] = S[r][2 * q][0]; t[1] = S[r][2 * q][1]; t[2] = S[r][2 * q + 1][0]; t[3] = S[r][2 * q + 1][1]; *(f32x4*)(dst + r * 64 + 4 * q) = t; }
}
#define LD4P(dst, ptr) do { const f32x4 _t0 = *(const LAS f32x4*)(ptr), _t1 = *(const LAS f32x4*)((ptr) + 4); dst[0] = (f32x2){_t0[0], _t0[1]}; dst[1] = (f32x2){_t0[2], _t0[3]}; dst[2] = (f32x2){_t1[0], _t1[1]}; dst[3] = (f32x2){_t1[2], _t1[3]}; } while (0)
constexpr int RW_PAIR = RW_WAVE + 1024;
__device__ __forceinline__ void rwkv_pass2_pair(CArgsP a, int e, int bh, int c, int hf, LAS float* pl) {
    const int lane = otid() & 63, b = bh >> 3, h = bh & 7, cj = h * 64 + lane, ib = lane >> 3, jb = lane & 7;
    const bf16_t* H = (const bf16_t*)(a->ws + WS_H); const bf16_t* LO = (const bf16_t*)(a->ws + WS_LO); bf16_t* CONCAT = (bf16_t*)(a->ws + WS_XB);
    const float* Ss = (const float*)(a->ws + WS_AP) + (size_t)2 * 16 * NCH * 4096;
    const size_t sidx = ((size_t)bh * NCH + c) * 4096 + (size_t)(hf * 32 + ib * 4) * 64 + jb * 8;
    const int tok0 = b * SEQ + c * TCH;
    const float* mu = a->in[21] + (size_t)e * 1792;
    const float mu_r = mu[cj], mu_k = mu[512 + cj], mu_v = mu[1024 + cj], kkc = a->in[27][e * 512 + cj], kac = a->in[28][e * 512 + cj], rkc = a->in[29][e * 512 + cj];
    const float gng = a->in[30][e * 512 + cj], gnb = a->in[31][e * 512 + cj];
    const float w0c = a->in[22][e * 512 + cj], a0c = a->in[24][e * 512 + cj];
    LAS float* yb = pl + RW_WAVE;
    f32x2 S[4][4];
#pragma unroll
    for (int r = 0; r < 4; ++r) { const f32x4 t0 = *(const f32x4*)(Ss + sidx + r * 64), t1 = *(const f32x4*)(Ss + sidx + r * 64 + 4);
        S[r][0] = (f32x2){t0[0], t0[1]}; S[r][1] = (f32x2){t0[2], t0[3]}; S[r][2] = (f32x2){t1[0], t1[1]}; S[r][3] = (f32x2){t1[2], t1[3]}; }
    unsigned short rw[5][6];
#define RW2_LOAD(T0) do { _Pragma("unroll") for (int s = 0; s < 5; ++s) { const int tk = tok0 + (T0) + hf * 4 + s - 1; const bool ok = ((tk & (SEQ - 1)) != SEQ - 1) || s > 0 || true; \
        const bf16_t* hp = H + (size_t)tk * 2816 + cj; const bf16_t* lp = LO + (size_t)tk * 1536 + cj; (void)ok; \
        if (s == 0) { const bool have = (c > 0) || ((T0) + hf * 4 > 0); rw[0][0] = have ? hp[0] : (unsigned short)0; rw[0][1] = have ? hp[512] : (unsigned short)0; rw[0][2] = have ? hp[1024] : (unsigned short)0; } \
        else { rw[s][0] = hp[0]; rw[s][1] = hp[512]; rw[s][2] = hp[1024]; rw[s][3] = lp[0]; rw[s][4] = lp[512]; rw[s][5] = lp[1024]; } } } while (0)
    RW2_LOAD(0);
    for (int t0 = 0; t0 < TCH; t0 += 8) {
        float pr = bf2f(rw[0][0]), pk = bf2f(rw[0][1]), pv = bf2f(rw[0][2]);
#pragma unroll
        for (int u = 0; u < 4; ++u) { const int s = hf * 4 + u;
            const float rr = bf2f(rw[u + 1][0]), kr = bf2f(rw[u + 1][1]), vr = bf2f(rw[u + 1][2]), ee = __expf(-softplusf_(-(w0c + bf2f(rw[u + 1][3]))) - 0.5f), aa = sigmoidf_(a0c + bf2f(rw[u + 1][4]));
            const float rl = rr + mu_r * (pr - rr), kl = kr + mu_k * (pk - kr), vl = vr + mu_v * (pv - vr); pr = rr; pk = kr; pv = vr;
            const float kkj = kl * kkc, ss = wsum_fast(kkj * kkj), kn = kkj * rsqrtf(fmaxf(ss, 1e-24f));
            const float kp = kl * (1.0f + (aa - 1.0f) * kac), dec = __expf(-ee);
            LAS float* base = pl + s * RW_STEP;
            base[lane] = -kn; base[64 + lane] = dec; base[128 + lane] = kn * aa; base[192 + lane] = kp; base[256 + lane] = rl; base[320 + lane] = vl; base[384 + lane] = bf2f(rw[u + 1][5]);
            const float bd = wsum_fast(rl * kp * rkc); if (lane == 0) pl[8 * RW_STEP + s] = bd; }
        if (t0 + 8 < TCH) RW2_LOAD(t0 + 8);
        __syncthreads();
#pragma unroll 2
        for (int s = 0; s < 8; ++s) { const LAS float* base = pl + s * RW_STEP;
            f32x2 av[4], dc[4], bv[4], kp[4], rv[4];
            LD4P(av, base + jb * 8); LD4P(dc, base + 64 + jb * 8); LD4P(bv, base + 128 + jb * 8); LD4P(kp, base + 192 + jb * 8); LD4P(rv, base + 256 + jb * 8);
            const f32x4 v4 = *(const LAS f32x4*)(base + 320 + hf * 32 + ib * 4);
            float sa[4];
#pragma unroll
            for (int r = 0; r < 4; ++r) { f32x2 pp = S[r][0] * av[0]; pp += S[r][1] * av[1]; pp += S[r][2] * av[2]; pp += S[r][3] * av[3]; sa[r] = red8(pp[0] + pp[1]); }
            float ysel = 0.f;
#pragma unroll
            for (int r = 0; r < 4; ++r) { const f32x2 sa2 = (f32x2){sa[r], sa[r]}, v2 = (f32x2){v4[r], v4[r]};
#pragma unroll
                for (int q = 0; q < 4; ++q) S[r][q] = S[r][q] * dc[q] + (sa2 * bv[q] + v2 * kp[q]);
                f32x2 pp = S[r][0] * rv[0]; pp += S[r][1] * rv[1]; pp += S[r][2] * rv[2]; pp += S[r][3] * rv[3]; const float yr = red8(pp[0] + pp[1]); ysel = (jb == r) ? yr : ysel; }
            if (jb < 4) yb[s * 64 + hf * 32 + ib * 4 + jb] = ysel; }
        __syncthreads();
#pragma unroll
        for (int u = 0; u < 4; ++u) { const int s = hf * 4 + u; const LAS float* base = pl + s * RW_STEP; const float y = yb[s * 64 + lane], vi = base[320 + lane];
            const float mean = wsum_fast(y) * (1.f / 64.f), ey2 = wsum_fast(y * y) * (1.f / 64.f), dl = y - mean, var = fmaxf(ey2 - mean * mean, 0.f);
            const float yn = dl * rsqrtf(var + 64e-5f) * gng + gnb;
            const float o = (yn + pl[8 * RW_STEP + s] * vi) * base[384 + lane];
            CONCAT[(size_t)(tok0 + t0 + s) * 1024 + cj] = f2bf(o); }
        __syncthreads();
    }
#undef RW2_LOAD
}
__device__ __forceinline__ void rwkv_combine(CArgsP a, int blk, unsigned char* shm) {
    float* Lc = (float*)(a->ws + WS_AP); float* Mc = Lc + (size_t)16 * NCH * 4096; float* Ss = Mc + (size_t)16 * NCH * 4096;
    LAS float* Sc = (LAS float*)shm; LAS float* Mb = Sc + 512;
    const int tid = otid(), bh = blk >> 3, rg = blk & 7, r = tid >> 6, j = tid & 63;
    const size_t mbase = (size_t)bh * NCH * 4096, rowoff = (size_t)(rg * 8 + r) * 64 + j;
    float cur = 0.f;
    f32x4 mn0 = *(const f32x4*)(Mc + mbase + tid * 8), mn1 = *(const f32x4*)(Mc + mbase + tid * 8 + 4); float ln = Lc[mbase + rowoff];
    for (int c = 0; c < NCH; ++c) {
        Ss[mbase + (size_t)c * 4096 + rowoff] = cur;
        Sc[r * 64 + j] = cur; *(LAS f32x4*)(Mb + tid * 8) = mn0; *(LAS f32x4*)(Mb + tid * 8 + 4) = mn1;
        float acc = ln;
        __syncthreads();
        if (c + 1 < NCH) { const size_t nb = mbase + (size_t)(c + 1) * 4096; mn0 = *(const f32x4*)(Mc + nb + tid * 8); mn1 = *(const f32x4*)(Mc + nb + tid * 8 + 4); ln = Lc[nb + rowoff]; }
#pragma unroll
        for (int k = 0; k < 64; k += 4) { const f32x4 s4 = *(const LAS f32x4*)(Sc + r * 64 + k);
            acc += s4[0] * Mb[k * 64 + j]; acc += s4[1] * Mb[(k + 1) * 64 + j]; acc += s4[2] * Mb[(k + 2) * 64 + j]; acc += s4[3] * Mb[(k + 3) * 64 + j]; }
        cur = acc;
        __syncthreads();
    }
}
__device__ __forceinline__ void lru_pass_a(CArgsP a, int gtid, int nth) {
    const bf16_t* LGA = (const bf16_t*)(a->ws + WS_LA); const bf16_t* BX = LGA + (size_t)NTOK * 512; float2* PE = (float2*)(a->ws + WS_MISC + 3 * MiB);
    for (int it = gtid; it < 2 * NLCH * 512; it += nth) { const int ch = it & 511, cc = (it >> 9) & (NLCH - 1), b = it >> 16; const size_t base = ((size_t)b * SEQ + (size_t)cc * LCH) * 512 + ch;
        float P = 1.f, E = 0.f;
#pragma unroll 32
        for (int t = 0; t < LCH; ++t) { const float av = __expf(bf2f(LGA[base + (size_t)t * 512])), bx = bf2f(BX[base + (size_t)t * 512]); P *= av; E = av * E + bx; }
        PE[it] = make_float2(P, E); }
}
__device__ __forceinline__ void lru_pass_c2(CArgsP a, int gtid, int nth) {
    const unsigned* LGA = (const unsigned*)(a->ws + WS_LA); const unsigned* BX = LGA + (size_t)NTOK * 256; const f32x4* PE = (const f32x4*)(a->ws + WS_MISC + 3 * MiB);
    const unsigned* H = (const unsigned*)(a->ws + WS_H); unsigned* CONCAT = (unsigned*)(a->ws + WS_XB);
    for (int it = gtid; it < 2 * NLCH * 256; it += nth) { const int chp = it & 255, cc = (it >> 8) & (NLCH - 1), b = it >> 15; const size_t tokb = (size_t)b * SEQ + (size_t)cc * LCH;
        float h0 = 0.f, h1 = 0.f;
#pragma unroll 8
        for (int c2 = 0; c2 < cc; ++c2) { const f32x4 pe = PE[(b << 15) + (c2 << 8) + chp]; h0 = pe[0] * h0 + pe[1]; h1 = pe[2] * h1 + pe[3]; }
#pragma unroll 8
        for (int t = 0; t < LCH; ++t) { const size_t tok = tokb + t; const unsigned la = LGA[tok * 256 + chp], bx = BX[tok * 256 + chp], gt = H[tok * 1408 + 896 + chp];
            h0 = __expf(__uint_as_float(la << 16)) * h0 + __uint_as_float(bx << 16); h1 = __expf(__uint_as_float(la & 0xffff0000u)) * h1 + __uint_as_float(bx & 0xffff0000u);
            CONCAT[tok * 512 + 256 + chp] = pk2(h0 * geluf_(__uint_as_float(gt << 16)), h1 * geluf_(__uint_as_float(gt & 0xffff0000u))); } }
}
__device__ __forceinline__ void lru_carry(CArgsP a, int gtid) {
    if (gtid >= 1024) return;
    const float2* PE = (const float2*)(a->ws + WS_MISC + 3 * MiB); float* CY = (float*)(a->ws + WS_MR + 512 * 1024);
    const int b = gtid >> 9, ch = gtid & 511; float hsv = 0.f;
#pragma unroll 16
    for (int cc = 0; cc < NLCH; ++cc) { const int idx = (b << 16) + (cc << 9) + ch; const float2 pe = PE[idx]; CY[idx] = hsv; hsv = pe.x * hsv + pe.y; }
}
__device__ __forceinline__ void lru_pass_c(CArgsP a, int gtid, int nth) {
    const bf16_t* LGA = (const bf16_t*)(a->ws + WS_LA); const bf16_t* BX = LGA + (size_t)NTOK * 512; const float2* PE = (const float2*)(a->ws + WS_MISC + 3 * MiB);
    const bf16_t* H = (const bf16_t*)(a->ws + WS_H); bf16_t* CONCAT = (bf16_t*)(a->ws + WS_XB);
    for (int it = gtid; it < 2 * NLCH * 512; it += nth) { const int ch = it & 511, cc = (it >> 9) & (NLCH - 1), b = it >> 16; const size_t tokb = (size_t)b * SEQ + (size_t)cc * LCH;
        float hsv = ((const float*)(a->ws + WS_MR + 512 * 1024))[it];
#pragma unroll 8
        for (int t = 0; t < LCH; ++t) { const size_t tok = tokb + t; const float av = __expf(bf2f(LGA[tok * 512 + ch])), bx = bf2f(BX[tok * 512 + ch]); hsv = av * hsv + bx;
            const float gt = bf2f(H[tok * 2816 + 1792 + ch]);
            CONCAT[tok * 1024 + 512 + ch] = f2bf(hsv * geluf_(gt)); } }
}
#ifndef REP_FFN
#define REP_FFN 1
#endif
#ifndef REP_P1
#define REP_P1 1
#endif
#ifndef REP_CB
#define REP_CB 1
#endif
#ifndef REP_P2
#define REP_P2 1
#endif
#ifndef REP_OPRE
#define REP_OPRE 1
#endif
#ifndef REP_AE
#define REP_AE 1
#endif
#ifndef REP_AT
#define REP_AT 1
#endif
#ifndef REP_LN
#define REP_LN 1
#endif
#ifndef REP_IN
#define REP_IN 1
#endif
#ifndef REP_CV
#define REP_CV 1
#endif
#ifndef REP_LC
#define REP_LC 1
#endif
#ifndef REP_R2
#define REP_R2 1
#endif
#ifndef REP_SYNC
#define REP_SYNC 0
#endif
#ifdef SKIP_E
#define SK_E(x)
#else
#define SK_E(x) x
#endif
#ifdef SKIP_O
#define SK_O(x)
#else
#define SK_O(x) x
#endif
#ifdef SKIP_S
#define SK_S(x)
#else
#define SK_S(x) x
#endif
#ifdef SKIP_A
#define SK_A(x)
#else
#define SK_A(x) x
#endif
__global__ __launch_bounds__(512, 2) void mega_fwd(Args a_unused) {
    extern __shared__ __attribute__((aligned(16))) unsigned char shm[];
    cg::grid_group grid = cg::this_grid();
#define a argp()
#define ws (a->ws)
#define P_W ((bf16_t*)(ws + WS_W))
#define P_XB ((bf16_t*)(ws + WS_XB))
#define P_H ((bf16_t*)(ws + WS_H))
#define P_LO ((bf16_t*)(ws + WS_LO))
#define P_AP ((bf16_t*)(ws + WS_AP))
#define P_XC ((bf16_t*)(ws + WS_XC))
#define P_LGA ((bf16_t*)(ws + WS_LA))
#define P_BX (P_LGA + (size_t)NTOK * 512)
#define P_Kb ((bf16_t*)(ws + WS_MISC))
#define P_VT ((bf16_t*)(ws + WS_MISC + MiB))
#define P_MEMB ((bf16_t*)(ws + WS_MISC + 2 * MiB))
#define P_Qb P_H
#define P_Ob (P_H + (size_t)NTOK * DM)
    volatile LAS unsigned* xst = (volatile LAS unsigned*)(shm + LDS_BYTES - 16);
    if (otid() == 0) { xst[0] = 0u; xst[1] = 0u; }
    __syncthreads();
    const XcdBarrier xb = xcd_barrier_post((unsigned*)(ws + WS_BAR), xst);
    prologue_cast(a); convert_layer(a, 0, shm); grid.sync();
#define GSYNC() xcd_barrier(xb)
    for (int ls = 0; ls < 16; ++ls) {
        const int l = ls >> 2, st = ls & 3, e = l >> 1, odd = l & 1;
        const bf16_t* A2; const bf16_t* W2; int K2; float scale2;
        if (st == 0 || st == 3) {
            EpiSwiGLU E; E.O = P_H;
            for (int rep = 0; rep < REP_FFN; ++rep) { run_gemm(shm, P_XB, P_W + (st == 0 ? W_FF1IN : W_FF2IN), NTOK, 5632, 1024, E); GSYNC(); }
            A2 = P_H; W2 = P_W + (st == 0 ? W_FF1OUT : W_FF2OUT); K2 = 2816; scale2 = 0.5f;
        } else {
            EpiBf16g E; int N; const bf16_t* Win; E.O = P_H;
            if (st == 1) { Win = P_W + W_MIXIN; E.scale = 1.0f; if (odd) { N = 2816; E.ldc = 2816; E.gelu_from = 1000; } else { N = 1536; E.ldc = 1536; E.gelu_from = 2; } }
            else { Win = P_W + W_Q; N = 1024; E.ldc = 1024; E.gelu_from = 1000; E.scale = 0.0625f; }
            for (int rep = 0; rep < REP_IN; ++rep) { run_gemm(shm, P_XB, Win, NTOK, N, 1024, E); if (rep + 1 < REP_IN) GSYNC(); }
            GSYNC();
            if (st == 1) {
                if (!odd) {
                    for (int rep = 0; rep < REP_AE; ++rep) { SK_E(even_core(a, e, shm);) GSYNC(); }
                    EpiPool EP; EP.O = P_XB; EP.scl = a->in[14] + (size_t)e * 512;
                    run_gemm(shm, P_LO, P_W + W_AUX1, NTOK, 512, 512, EP); GSYNC();
                } else {
                    for (int rep = 0; rep < REP_OPRE; ++rep) {
                        SK_O(odd_prep(a, e);) GSYNC();
                        { EpiBf16g EL; EL.O = P_LO; EL.ldc = 1536; EL.gelu_from = 1000; EL.scale = 1.0f; run_gemm(shm, P_AP, P_W + W_AUX1, NTOK, 1536, 256, EL); }
                        { EpiLru ER; ER.XC = P_XC; ER.b_a = a->in[35] + (size_t)e * 512; ER.b_x = a->in[37] + (size_t)e * 512; ER.lam = a->in[38] + (size_t)e * 512; ER.LGA = P_LGA; ER.BX = P_BX;
                          run_gemm(shm, P_XC, P_W + W_AUX2, NTOK, 1024, 512, ER); }
                        GSYNC();
                    }
                    for (int rep = 0; rep < REP_P1; ++rep) {
                        const int wave = otid() >> 6; LAS float* pl = (LAS float*)shm + (wave >> 1) * RW_PAIR;
                        for (int it0 = blockIdx.x * 4; it0 < 16 * NCH; it0 += gridDim.x * 4) { const int item = it0 + (wave >> 1);
                            if (wave & 1) rwkv_pass1_pair<1>(a, e, item / NCH, item % NCH, pl); else rwkv_pass1_pair<0>(a, e, item / NCH, item % NCH, pl); }
                        SK_O(lru_pass_a(a, blockIdx.x * 512 + otid(), gridDim.x * 512);)
                        GSYNC();
                    }
                    for (int rep = 0; rep < REP_CB; ++rep) {
                        if (blockIdx.x < 128) { SK_O(rwkv_combine(a, blockIdx.x, shm);) }
                        else { SK_O(lru_pass_c2(a, ((int)blockIdx.x - 128) * 512 + otid(), ((int)gridDim.x - 128) * 512);) }
                        GSYNC();
                    }
                    for (int rep = 0; rep < REP_P2; ++rep) {
                        const int wave = otid() >> 6; LAS float* pl = (LAS float*)shm + (wave >> 1) * RW_PAIR;
                        for (int it0 = blockIdx.x * 4; it0 < 16 * NCH; it0 += gridDim.x * 4) { const int item = it0 + (wave >> 1); rwkv_pass2_pair(a, e, item / NCH, item % NCH, wave & 1, pl); }
                        GSYNC();
                    }
                }
                A2 = P_XB; W2 = P_W + W_MIXOUT; K2 = 1024; scale2 = 1.0f;
            } else {
                for (int rep = 0; rep < REP_AT; ++rep) { SK_A(attn_phase(P_Qb, P_Kb, P_VT, P_Ob, shm);) GSYNC(); }
                A2 = P_Ob; W2 = P_W + W_O; K2 = 1024; scale2 = 1.0f;
            }
        }
        {
            EpiResid ER; ER.res = (const h16*)a->out; ER.out = (h16*)a->out; ER.MR = (const float*)(ws + WS_MR); ER.first = (ls == 0);
            ER.g = a->in[6] + (size_t)(ls > 0 ? ls - 1 : 0) * DM; ER.b = a->in[7] + (size_t)(ls > 0 ? ls - 1 : 0) * DM; ER.scale = scale2; run_gemm(shm, A2, W2, NTOK, 1024, K2, ER); }
        GSYNC();
        for (int rep = 0; rep < REP_SYNC; ++rep) GSYNC();
        if (st == 1) {
            if (blockIdx.x < 16) { EpiKV EK; EK.Kb = P_Kb; EK.VT = P_VT; run_gemm(shm, P_MEMB, P_W + W_KV, 512, 2048, 1024, EK, 16, (int)blockIdx.x); }
            else ln_phase(a->out, nullptr, P_XB, (float*)(ws + WS_MR), a->in[6] + (size_t)ls * DM, a->in[7] + (size_t)ls * DM, 16, (int)gridDim.x - 16);
        } else if (ls < 15) { for (int rep = 0; rep < REP_LN; ++rep) { ln_phase(a->out, nullptr, P_XB, (float*)(ws + WS_MR), a->in[6] + (size_t)ls * DM, a->in[7] + (size_t)ls * DM, 0, (int)gridDim.x); if (rep + 1 < REP_LN) GSYNC(); }
            if (st == 3) for (int rep = 0; rep < REP_CV; ++rep) { convert_layer(a, l + 1, shm); if (rep + 1 < REP_CV) GSYNC(); } }
        else { h16x8 zr[16][2]; ln_final_load((const h16*)a->out, zr); GSYNC(); ln_final_store(zr, a->out, a->in[6] + (size_t)ls * DM, a->in[7] + (size_t)ls * DM); }
        GSYNC();
    }
}

#undef a
#undef ws
#undef P_W
#undef P_XB
#undef P_H
#undef P_LO
#undef P_AP
#undef P_XC
#undef P_LGA
#undef P_BX
#undef P_Kb
#undef P_VT
#undef P_MEMB
#undef P_Qb
#undef P_Ob
extern "C" void kernel_launch(void* const* d_in, const int* in_sizes, int n_in, void* d_out, int out_size, void* d_ws, size_t ws_size, hipStream_t stream) {
    static int grid = 0;
    if (grid == 0) {
        if (n_in != 39 || out_size != NTOK * DM || ws_size < WS_END) { fprintf(stderr, "kernel_launch: unexpected shapes (n_in %d out %d ws %zu need %zu)\n", n_in, out_size, ws_size, (size_t)WS_END); grid = -1; return; }
        int dev = 0, cus = 0, per_cu = 0;
        hipGetDevice(&dev); hipDeviceGetAttribute(&cus, hipDeviceAttributeMultiprocessorCount, dev);
        if (hipFuncSetAttribute((const void*)mega_fwd, hipFuncAttributeMaxDynamicSharedMemorySize, LDS_BYTES) != hipSuccess) { fprintf(stderr, "kernel_launch: hipFuncSetAttribute failed\n"); }
        if (hipOccupancyMaxActiveBlocksPerMultiprocessor(&per_cu, (const void*)mega_fwd, 512, LDS_BYTES) != hipSuccess || per_cu < 1) { fprintf(stderr, "kernel_launch: occupancy query says %d\n", per_cu); per_cu = 1; }
        (void)hipGetLastError();
        grid = cus > 0 ? cus : 256;
    }
    if (grid < 0) return;
    if (hipMemsetAsync((char*)d_ws + WS_BAR, 0, 16384, stream) != hipSuccess) { fprintf(stderr, "kernel_launch: memset failed\n"); return; }
    Args a{};
    for (int i = 0; i < 39; ++i) a.in[i] = (const float*)d_in[i];
    a.out = (float*)d_out; a.ws = (unsigned char*)d_ws;
    void* args[] = {&a};
    hipError_t e = hipLaunchCooperativeKernel((const void*)mega_fwd, dim3(grid), dim3(512), args, LDS_BYTES, stream);
    if (e != hipSuccess) fprintf(stderr, "cooperative launch failed: %s (grid %d)\n", hipGetErrorString(e), grid);
}
```

```cpp
#include <hip/hip_runtime.h>
#include <hip/hip_cooperative_groups.h>
#include <cstdio>
namespace cg = cooperative_groups;
namespace pg8 {
#define PG8_LAS __attribute__((address_space(3)))
typedef unsigned short bf16_t;
typedef short bf16x8 __attribute__((ext_vector_type(8)));
typedef float f32x4 __attribute__((ext_vector_type(4)));
typedef unsigned u32x4 __attribute__((ext_vector_type(4)));
typedef unsigned u32x2 __attribute__((ext_vector_type(2)));
constexpr int BM = 256, BK = 64, HALF = 128, HTB = HALF * BK * 2  , STAGE_BYTES = 8 * HTB, NXCD = 8, WGM = 8;

__host__ __device__ __forceinline__ int lds_byte(int r, int c) { const int st = (r >> 4) * 2 + (c >> 5), rr = r & 15, cc = c & 31, ob = rr * 64 + cc * 2; return st * 1024 + (ob ^ (((ob >> 9) & 1) << 5)); }
__host__ __device__ __forceinline__ void stage_rc(int b, int& R, int& C) { const int st = b / 1024, sb = b % 1024, swz = sb ^ (((sb >> 9) & 1) << 5); R = (st >> 1) * 16 + swz / 64; C = (st & 1) * 32 + (swz % 64) / 2; }
__host__ __device__ __forceinline__ int perm32(int rho) { const int n = rho >> 4, i = rho & 15; return 8 * (i >> 2) + 4 * n + (i & 3); }

struct Unit { int pm, pn; };
struct Gemm { const bf16_t* A; const bf16_t* Bt; int M, N, K; };

struct StaticOrder {
    int nM, nN, nwg, G, c;
    __host__ __device__ void init(int M, int N, int G_, int c_) { nM = M / BM; nN = N / BM; nwg = nM * nN; G = G_; c = c_; }
    __host__ __device__ bool next(int i, Unit& u) const {
        const long L = (long)i * G + c; if (L >= nwg) return false;
        int wgid = (int)L; { const int q = nwg / NXCD, r = nwg % NXCD, xcd = wgid % NXCD, off = wgid / NXCD; wgid = (xcd < r ? xcd * (q + 1) : r * (q + 1) + (xcd - r) * q) + off; }
        const int nig = WGM * nN, gid = wgid / nig, fm = gid * WGM, gsz = (nM - fm) < WGM ? (nM - fm) : WGM;
        u.pm = fm + ((wgid % nig) % gsz); u.pn = (wgid % nig) / gsz; return true;
    }
    __device__ __forceinline__ void a_ready(const Unit&) const {}
    __device__ __forceinline__ void done(const Unit&) const {}
};
__device__ __forceinline__ unsigned cvt_pk_bf16(float lo, float hi) { unsigned r; asm volatile("v_cvt_pk_bf16_f32 %0, %1, %2" : "=v"(r) : "v"(lo), "v"(hi)); return r; }

template <class Epi, class Sched>
__device__ __forceinline__ void gemm_phase(PG8_LAS unsigned char* lds, const Gemm g, const Sched& S, const Epi& E) {
    int tid_ = threadIdx.x; asm volatile("" : "+v"(tid_));
    const int tid = tid_, wid = __builtin_amdgcn_readfirstlane(tid >> 6), lane = tid & 63, wr = wid >> 2, wc = wid & 3, fr = lane & 15, fq = lane >> 4;
    const int K = g.K, nt = K / BK;
    unsigned voffA[2], voffB[2];
#pragma unroll
    for (int i = 0; i < 2; ++i) { int R, C; stage_rc(tid * 16 + i * 8192, R, C); const int Rb = Epi::PERM ? ((R & ~31) + perm32(R & 31)) : R;
        voffA[i] = (unsigned)(R * K + C) * 2u; voffB[i] = (unsigned)(Rb * K + C) * 2u; }
    const size_t kstep = (size_t)(BK * 2);
    const size_t hstep = (size_t)HALF * K * 2;
    const size_t tstep = 2 * hstep;
    const unsigned ldsw = (unsigned)wid * 1024u;
    const int aoff = lds_byte(wr * 64 + fr, fq * 8), boff = lds_byte(wc * 32 + fr, fq * 8);
#define PG8_SA(b, h) (((b) * 2 + (h)) * HTB)
#define PG8_SB(b, h) ((4 + (b) * 2 + (h)) * HTB)
#define PG8_STAGE(bufoff, gbase, voff) do { _Pragma("unroll") for (int _i = 0; _i < 2; ++_i) \
        __builtin_amdgcn_global_load_lds((const unsigned*)((const char*)(gbase) + (voff)[_i]), (PG8_LAS unsigned*)(lds + (bufoff) + ldsw + _i * 8192), 16, 0, 0); } while (0)
#define PG8_LDA(dst, b, h) do { _Pragma("unroll") for (int m = 0; m < 4; ++m) _Pragma("unroll") for (int k = 0; k < 2; ++k) dst[m][k] = *(const PG8_LAS bf16x8*)(lds + PG8_SA(b, h) + aoff + m * 2048 + k * 1024); } while (0)
#define PG8_LDB(dst, b, h) do { _Pragma("unroll") for (int n = 0; n < 2; ++n) _Pragma("unroll") for (int k = 0; k < 2; ++k) dst[n][k] = *(const PG8_LAS bf16x8*)(lds + PG8_SB(b, h) + boff + n * 2048 + k * 1024); } while (0)
#define PG8_MMA(ai, bj, At, Bt) do { __builtin_amdgcn_s_setprio(1); _Pragma("unroll") for (int m = 0; m < 4; ++m) _Pragma("unroll") for (int n = 0; n < 2; ++n) _Pragma("unroll") for (int k = 0; k < 2; ++k) \
        acc[ai][bj][m][n] = __builtin_amdgcn_mfma_f32_16x16x32_bf16(Bt[n][k], At[m][k], acc[ai][bj][m][n], 0, 0, 0); __builtin_amdgcn_s_setprio(0); } while (0)
#define PG8_WAIT_V(n) asm volatile("s_waitcnt vmcnt(" #n ")" ::: "memory")
#define PG8_WAIT_L(n) asm volatile("s_waitcnt lgkmcnt(" #n ")" ::: "memory")
#define PG8_BAR __builtin_amdgcn_s_barrier()
#define PG8_SCHED __builtin_amdgcn_sched_barrier(0)
    Unit cur, nxt; int ui = 0;
    if (!S.next(0, cur)) return;
    f32x4 acc[2][2][4][2];
#pragma unroll
    for (int a = 0; a < 2; ++a)
#pragma unroll
        for (int b = 0; b < 2; ++b)
#pragma unroll
            for (int m = 0; m < 4; ++m)
#pragma unroll
                for (int n = 0; n < 2; ++n) acc[a][b][m][n] = (f32x4){0.f, 0.f, 0.f, 0.f};
    bf16x8 At[4][2], B0[2][2], B1[2][2];
    const char* cA = (const char*)g.A + (size_t)cur.pm * tstep; const char* cB = (const char*)g.Bt + (size_t)cur.pn * tstep;
    S.a_ready(cur);
    PG8_STAGE(PG8_SB(0, 0), cB, voffB); PG8_STAGE(PG8_SA(0, 0), cA, voffA); PG8_STAGE(PG8_SB(0, 1), cB + hstep, voffB); PG8_STAGE(PG8_SA(0, 1), cA + hstep, voffA);
    if (wr == 1) PG8_BAR;
    PG8_WAIT_V(4); PG8_BAR;
    PG8_STAGE(PG8_SB(1, 0), cB + kstep, voffB); PG8_STAGE(PG8_SA(1, 0), cA + kstep, voffA); PG8_STAGE(PG8_SB(1, 1), cB + hstep + kstep, voffB);
    PG8_WAIT_V(6); PG8_BAR;
    for (;;) {
        const bool has_next = S.next(ui + 1, nxt);
        const char* nA = has_next ? (const char*)g.A + (size_t)nxt.pm * tstep : cA; const char* nB = has_next ? (const char*)g.Bt + (size_t)nxt.pn * tstep : cB;
        for (int t = 0; t < nt; t += 2) {
            const bool last = (t == nt - 2);
            const char* a1 = cA + (size_t)(t + 1) * kstep;
            const char* a2 = last ? nA : cA + (size_t)(t + 2) * kstep; const char* b2 = last ? nB : cB + (size_t)(t + 2) * kstep;
            const char* a3 = a2 + kstep; const char* b3 = b2 + kstep;
            if (last && has_next) S.a_ready(nxt);
            PG8_LDB(B0, 0, 0); PG8_SCHED; PG8_LDA(At, 0, 0); PG8_STAGE(PG8_SA(1, 1), a1 + hstep, voffA);
            PG8_WAIT_L(8); PG8_BAR; PG8_WAIT_L(0); PG8_MMA(0, 0, At, B0); PG8_BAR; PG8_SCHED;
            PG8_LDB(B1, 0, 1); PG8_STAGE(PG8_SB(0, 0), b2, voffB);
            PG8_BAR; PG8_WAIT_L(0); PG8_MMA(0, 1, At, B1); PG8_BAR;
            PG8_LDA(At, 0, 1); PG8_STAGE(PG8_SA(0, 0), a2, voffA);
            PG8_BAR; PG8_WAIT_L(0); PG8_MMA(1, 0, At, B0); PG8_BAR; PG8_SCHED;
            PG8_STAGE(PG8_SB(0, 1), b2 + hstep, voffB);
            PG8_WAIT_V(6); PG8_BAR; PG8_MMA(1, 1, At, B1); PG8_BAR;
            PG8_LDB(B0, 1, 0); PG8_SCHED; PG8_LDA(At, 1, 0); PG8_STAGE(PG8_SA(0, 1), a2 + hstep, voffA);
            PG8_WAIT_L(8); PG8_BAR; PG8_WAIT_L(0); PG8_MMA(0, 0, At, B0); PG8_BAR; PG8_SCHED;
            PG8_LDB(B1, 1, 1); PG8_STAGE(PG8_SB(1, 0), b3, voffB);
            PG8_BAR; PG8_WAIT_L(0); PG8_MMA(0, 1, At, B1); PG8_BAR;
            PG8_LDA(At, 1, 1); PG8_STAGE(PG8_SA(1, 0), a3, voffA);
            PG8_BAR; PG8_WAIT_L(0); PG8_MMA(1, 0, At, B0); PG8_BAR; PG8_SCHED;
            PG8_STAGE(PG8_SB(1, 1), b3 + hstep, voffB);
            PG8_WAIT_V(6); PG8_BAR; PG8_MMA(1, 1, At, B1); PG8_BAR;
        }
        if constexpr (!Epi::AFTER_DRAIN) { E(acc, cur, wr, wc, fr, fq); S.done(cur); }
        if (!has_next) break;
#pragma unroll
        for (int a = 0; a < 2; ++a)
#pragma unroll
            for (int b = 0; b < 2; ++b)
#pragma unroll
                for (int m = 0; m < 4; ++m)
#pragma unroll
                    for (int n = 0; n < 2; ++n) acc[a][b][m][n] = (f32x4){0.f, 0.f, 0.f, 0.f};
        cur = nxt; cA = nA; cB = nB; ++ui;
    }
    PG8_WAIT_V(0);
    if (wr == 0) PG8_BAR;
    PG8_BAR;
    if constexpr (Epi::AFTER_DRAIN) { E.fused(acc, cur, wr, wc, fr, fq, lds, wid, lane); S.done(cur); }
#undef PG8_SA
#undef PG8_SB
#undef PG8_STAGE
#undef PG8_LDA
#undef PG8_LDB
#undef PG8_MMA
#undef PG8_WAIT_V
#undef PG8_WAIT_L
#undef PG8_BAR
#undef PG8_SCHED
}
}

using pg8::bf16_t; using pg8::bf16x8; using pg8::f32x4; using pg8::u32x4; using pg8::u32x2;
#define LAS __attribute__((address_space(3)))
constexpr int NTOK = 32768, SEQ = 16384, DM = 1024, FF = 2816;
constexpr int NCH = 64;
constexpr int TCH = SEQ / NCH;
constexpr int LCH = 128;
constexpr int NLCH = SEQ / LCH;
constexpr float ALPHA = 1.681792830507429f;
constexpr int LDS_BYTES = 136 * 1024;

constexpr size_t MiB = 1024 * 1024;
constexpr size_t E_FFIN = (size_t)5632 * 1024, E_FFOUT = (size_t)1024 * 2816, E_SQ = (size_t)1024 * 1024, E_KV = (size_t)2048 * 1024, E_MIXIN = (size_t)2816 * 1024;
constexpr size_t W_FF1IN = 0, W_FF1OUT = W_FF1IN + E_FFIN, W_FF2IN = W_FF1OUT + E_FFOUT, W_FF2OUT = W_FF2IN + E_FFIN, W_Q = W_FF2OUT + E_FFOUT, W_KV = W_Q + E_SQ, W_O = W_KV + E_KV,
                 W_MIXIN = W_O + E_SQ, W_MIXOUT = W_MIXIN + E_MIXIN, W_AUX1 = W_MIXOUT + E_SQ, W_AUX2 = W_AUX1 + (size_t)1536 * 256, W_END = W_AUX2 + (size_t)1024 * 512;
constexpr size_t WS_W = 0;
constexpr size_t WS_XB = 52 * MiB;
constexpr size_t WS_H = WS_XB + 64 * MiB;
constexpr size_t WS_LO = WS_H + 176 * MiB;
constexpr size_t WS_AP = WS_LO + 96 * MiB;
constexpr size_t WS_XC = WS_AP + 16 * MiB;
constexpr size_t WS_LA = WS_XC + 32 * MiB;
constexpr size_t WS_MISC = WS_LA + 64 * MiB;
constexpr size_t WS_BAR = WS_MISC + 4 * MiB;
constexpr size_t WS_MR = WS_BAR + 1 * MiB;
constexpr size_t WS_END = WS_MR + 1 * MiB;
static_assert(W_END * 2 <= 52 * MiB, "weights");
static_assert(WS_END <= 512 * MiB, "workspace");

struct Args { const float* in[39]; float* out; unsigned char* ws; };
typedef const __attribute__((address_space(4))) Args* CArgsP;
__device__ __forceinline__ CArgsP argp() { CArgsP p = (CArgsP)__builtin_amdgcn_kernarg_segment_ptr(); asm volatile("" : "+s"(p)); return p; }

__device__ __forceinline__ float bf2f(unsigned short b) { return __uint_as_float(((unsigned)b) << 16); }
__device__ __forceinline__ float bfs2f(short b) { return __uint_as_float(((unsigned)(unsigned short)b) << 16); }
__device__ __forceinline__ unsigned short f2bf(float f) { unsigned u = __float_as_uint(f); u += 0x7FFFu + ((u >> 16) & 1u); return (unsigned short)(u >> 16); }
__device__ __forceinline__ unsigned pk2(float lo, float hi) { return pg8::cvt_pk_bf16(lo, hi); }
__device__ __forceinline__ float sigmoidf_(float x) { return __builtin_amdgcn_rcpf(1.0f + __expf(-x)); }
__device__ __forceinline__ float siluf_(float x) { return x * sigmoidf_(x); }
__device__ __forceinline__ float tanhf_(float y) { return 1.0f - 2.0f * __builtin_amdgcn_rcpf(1.0f + __expf(2.0f * y)); }
__device__ __forceinline__ float geluf_(float x) { return 0.5f * x * (1.0f + tanhf_(0.7978845608028654f * (x + 0.044715f * x * x * x))); }
__device__ __forceinline__ float softplusf_(float x) { return fmaxf(x, 0.0f) + __logf(1.0f + __expf(-fabsf(x))); }
__device__ __forceinline__ float wave_sum(float v) {
#pragma unroll
    for (int o = 1; o < 64; o <<= 1) v += __shfl_xor(v, o);
    return v;
}
__device__ __forceinline__ int otid() { int t = threadIdx.x; asm volatile("" : "+v"(t)); return t; }
#define LDS_SYNC_WAVE() asm volatile("s_waitcnt lgkmcnt(0)" ::: "memory")

typedef const f32x4 (&AccRef)[2][2][4][2];
struct EpiSwiGLU { static constexpr bool PERM = true, AFTER_DRAIN = false; bf16_t* O;
    __device__ __forceinline__ void operator()(AccRef acc, const pg8::Unit& u, int wr, int wc, int fr, int fq) const {
        const int row0 = u.pm * 256 + wr * 64 + fr, col0 = u.pn * 128 + wc * 32 + 8 * fq;
#pragma unroll
        for (int ai = 0; ai < 2; ++ai)
#pragma unroll
            for (int m = 0; m < 4; ++m) { bf16_t* rowp = O + (size_t)(row0 + ai * 128 + m * 16) * FF + col0;
                const f32x4 g0 = acc[ai][0][m][0], g1 = acc[ai][0][m][1], u0 = acc[ai][1][m][0], u1 = acc[ai][1][m][1];
                u32x4 o; o.x = pk2(siluf_(g0[0]) * u0[0], siluf_(g0[1]) * u0[1]); o.y = pk2(siluf_(g0[2]) * u0[2], siluf_(g0[3]) * u0[3]);
                o.z = pk2(siluf_(g1[0]) * u1[0], siluf_(g1[1]) * u1[1]); o.w = pk2(siluf_(g1[2]) * u1[2], siluf_(g1[3]) * u1[3]);
                *(u32x4*)rowp = o; __builtin_amdgcn_sched_barrier(0); }
    } };
typedef _Float16 h16; typedef h16 h16x4 __attribute__((ext_vector_type(4))); typedef h16 h16x8 __attribute__((ext_vector_type(8)));
struct EpiResid { static constexpr bool PERM = false, AFTER_DRAIN = false; const h16* res; h16* out; const float* MR; const float* g; const float* b; float scale; int first;
    __device__ __forceinline__ void operator()(AccRef acc, const pg8::Unit& u, int wr, int wc, int fr, int fq) const {
        const int row0 = u.pm * 256 + wr * 64 + fr, col0 = u.pn * 256 + wc * 32 + 4 * fq;
        f32x4 g4[2][2], b4[2][2];
#pragma unroll
        for (int bj = 0; bj < 2; ++bj)
#pragma unroll
            for (int n = 0; n < 2; ++n) { if (first) { g4[bj][n] = (f32x4){1.f, 1.f, 1.f, 1.f}; b4[bj][n] = (f32x4){0.f, 0.f, 0.f, 0.f}; } else { g4[bj][n] = *(const f32x4*)(g + col0 + bj * 128 + n * 16); b4[bj][n] = *(const f32x4*)(b + col0 + bj * 128 + n * 16); } }
#pragma unroll
        for (int ai = 0; ai < 2; ++ai)
#pragma unroll
        for (int mh = 0; mh < 4; mh += 2) {
            float mean[2], rstd[2]; h16x4 rr[2][2][2];
#pragma unroll
            for (int mm = 0; mm < 2; ++mm) { const int row = row0 + ai * 128 + (mh + mm) * 16; const size_t off = (size_t)row * DM + col0; mean[mm] = MR[2 * row]; rstd[mm] = MR[2 * row + 1];
#pragma unroll
                for (int bj = 0; bj < 2; ++bj)
#pragma unroll
                    for (int n = 0; n < 2; ++n) rr[mm][bj][n] = *(const h16x4*)(res + off + bj * 128 + n * 16); }
#pragma unroll
            for (int mm = 0; mm < 2; ++mm) { const int m = mh + mm, row = row0 + ai * 128 + m * 16; const size_t off = (size_t)row * DM + col0;
#pragma unroll
                for (int bj = 0; bj < 2; ++bj)
#pragma unroll
                    for (int n = 0; n < 2; ++n) { const f32x4 r = __builtin_convertvector(rr[mm][bj][n], f32x4);
                        const f32x4 x = (r - mean[mm]) * rstd[mm] * g4[bj][n] + b4[bj][n], z = x * ALPHA + acc[ai][bj][m][n] * scale;
                        *(h16x4*)(out + off + bj * 128 + n * 16) = __builtin_convertvector(z, h16x4); } } }
    } };
struct EpiBf16g { static constexpr bool PERM = true, AFTER_DRAIN = false; bf16_t* O; int ldc; int gelu_from; float scale;
    __device__ __forceinline__ void operator()(AccRef acc, const pg8::Unit& u, int wr, int wc, int fr, int fq) const {
        const int row0 = u.pm * 256 + wr * 64 + fr, col0 = u.pn * 256 + wc * 32 + 8 * fq; const bool dog = u.pn >= gelu_from;
#pragma unroll
        for (int ai = 0; ai < 2; ++ai)
#pragma unroll
            for (int m = 0; m < 4; ++m) { bf16_t* rowp = O + (size_t)(row0 + ai * 128 + m * 16) * ldc + col0;
#pragma unroll
                for (int bj = 0; bj < 2; ++bj) { f32x4 v0 = acc[ai][bj][m][0] * scale, v1 = acc[ai][bj][m][1] * scale;
                    if (dog) {
#pragma unroll
                        for (int e = 0; e < 4; ++e) { v0[e] = geluf_(v0[e]); v1[e] = geluf_(v1[e]); } }
                    u32x4 o; o.x = pk2(v0[0], v0[1]); o.y = pk2(v0[2], v0[3]); o.z = pk2(v1[0], v1[1]); o.w = pk2(v1[2], v1[3]);
                    *(u32x4*)(rowp + bj * 128) = o; } }
    } };
struct EpiKV { static constexpr bool PERM = false, AFTER_DRAIN = false; bf16_t* Kb; bf16_t* VT;
    __device__ __forceinline__ void operator()(AccRef acc, const pg8::Unit& u, int wr, int wc, int fr, int fq) const {
        const int row0 = u.pm * 256 + wr * 64 + fr, col0 = u.pn * 256 + wc * 32 + 4 * fq;
#pragma unroll
        for (int ai = 0; ai < 2; ++ai)
#pragma unroll
            for (int m = 0; m < 4; ++m) { const int row = row0 + ai * 128 + m * 16;
#pragma unroll
                for (int bj = 0; bj < 2; ++bj)
#pragma unroll
                    for (int n = 0; n < 2; ++n) { const int col = col0 + bj * 128 + n * 16; const f32x4 v = acc[ai][bj][m][n];
                        if (u.pn < 4) { u32x2 o; o.x = pk2(v[0], v[1]); o.y = pk2(v[2], v[3]); *(u32x2*)(Kb + (size_t)row * 1024 + col) = o; }
                        else { const int cc = col - 1024, hh = cc >> 8, d = cc & 255, b = row >> 8, mm = row & 255;
#pragma unroll
                            for (int e = 0; e < 4; ++e) VT[(size_t)((b * 4 + hh) * 256 + d + e) * 256 + mm] = f2bf(v[e]); } } }
    } };
struct EpiLru { static constexpr bool PERM = true, AFTER_DRAIN = false; const bf16_t* XC; const float* b_a; const float* b_x; const float* lam; bf16_t* LGA; bf16_t* BX;
    __device__ __forceinline__ void operator()(AccRef acc, const pg8::Unit& u, int wr, int wc, int fr, int fq) const {
        const int row0 = u.pm * 256 + wr * 64 + fr, ch0 = u.pn * 128 + wc * 32 + 8 * fq;
#pragma unroll
        for (int n = 0; n < 2; ++n) { float sp[4]; const f32x4 lm = *(const f32x4*)(lam + ch0 + 4 * n), ba = *(const f32x4*)(b_a + ch0 + 4 * n), bx_ = *(const f32x4*)(b_x + ch0 + 4 * n);
#pragma unroll
            for (int e = 0; e < 4; ++e) sp[e] = -8.0f * softplusf_(-lm[e]);
            u32x2 xrr[2][4];
#pragma unroll
            for (int ai = 0; ai < 2; ++ai)
#pragma unroll
                for (int m = 0; m < 4; ++m) xrr[ai][m] = *(const u32x2*)(XC + (size_t)(row0 + ai * 128 + m * 16) * 512 + ch0 + 4 * n);
#pragma unroll
            for (int ai = 0; ai < 2; ++ai)
#pragma unroll
                for (int m = 0; m < 4; ++m) { const size_t off = (size_t)(row0 + ai * 128 + m * 16) * 512 + ch0 + 4 * n;
                    const u32x2 xr = xrr[ai][m]; float xc[4] = {__uint_as_float(xr.x << 16), __uint_as_float(xr.x & 0xffff0000u), __uint_as_float(xr.y << 16), __uint_as_float(xr.y & 0xffff0000u)};
                    float la[4], bb[4];
#pragma unroll
                    for (int e = 0; e < 4; ++e) { const float rec = sigmoidf_(acc[ai][0][m][n][e] + ba[e]), inp = sigmoidf_(acc[ai][1][m][n][e] + bx_[e]);
                        const float lg = sp[e] * rec; la[e] = lg; bb[e] = sqrtf(fmaxf(1.0f - __expf(2.0f * lg), 0.0f)) * (inp * xc[e]); }
                    u32x2 o; o.x = pk2(la[0], la[1]); o.y = pk2(la[2], la[3]); *(u32x2*)(LGA + off) = o;
                    o.x = pk2(bb[0], bb[1]); o.y = pk2(bb[2], bb[3]); *(u32x2*)(BX + off) = o; } }
    } };
struct EpiPool { static constexpr bool PERM = true, AFTER_DRAIN = false; bf16_t* O; const float* scl;
    __device__ __forceinline__ void operator()(AccRef acc, const pg8::Unit& u, int wr, int wc, int fr, int fq) const {
        const int row0 = u.pm * 256 + wr * 64 + fr, col0 = u.pn * 256 + wc * 32 + 8 * fq;
        float sc[2][8];
#pragma unroll
        for (int bj = 0; bj < 2; ++bj)
#pragma unroll
            for (int e = 0; e < 8; ++e) sc[bj][e] = scl[col0 + bj * 128 + e];
#pragma unroll
        for (int ai = 0; ai < 2; ++ai)
#pragma unroll
            for (int m = 0; m < 4; ++m) { bf16_t* rowp = O + (size_t)(row0 + ai * 128 + m * 16) * 1024 + col0;
#pragma unroll
                for (int bj = 0; bj < 2; ++bj) { float v[8];
#pragma unroll
                    for (int e = 0; e < 8; ++e) v[e] = acc[ai][bj][m][e >> 2][e & 3] * sc[bj][e];
                    u32x4 o; o.x = pk2(v[0], v[1]); o.y = pk2(v[2], v[3]); o.z = pk2(v[4], v[5]); o.w = pk2(v[6], v[7]);
                    *(u32x4*)(rowp + bj * 128) = o; } }
    } };

template <class Epi> __device__ __forceinline__ void run_gemm(unsigned char* shm, const bf16_t* A, const bf16_t* Bt, int M, int N, int K, const Epi& E, int G = 0, int c = -1) {
    pg8::Gemm g; g.A = A; g.Bt = Bt; g.M = M; g.N = N; g.K = K;
    pg8::StaticOrder S; S.init(M, N, G > 0 ? G : (int)gridDim.x, c >= 0 ? c : (int)blockIdx.x);
    pg8::gemm_phase<Epi, pg8::StaticOrder>((PG8_LAS unsigned char*)shm, g, S, E);
}

template <int MODE> __device__ __forceinline__ int rowmap(int n) {
    if (MODE == 0) return n;
    const int up = n >= FF, i = up ? n - FF : n; return (i >> 7) * 256 + up * 128 + (i & 127);
}
template <int MODE> __device__ __forceinline__ void conv_tile(const float* src, int K, int N, bf16_t* dst, int tile, float* tb) {
    const int tid = otid(), ntn = N >> 6, k0 = (tile / ntn) << 6, n0 = (tile % ntn) << 6;
#pragma unroll
    for (int i = 0; i < 8; ++i) { const int kk = i * 8 + (tid >> 6), nn = tid & 63; tb[kk * 65 + nn] = src[(size_t)(k0 + kk) * N + n0 + nn]; }
    __syncthreads();
#pragma unroll
    for (int i = 0; i < 4; ++i) { const int nn = i * 16 + (tid >> 5), kk = 2 * (tid & 31);
        *(unsigned*)(dst + (size_t)rowmap<MODE>(n0 + nn) * K + k0 + kk) = pk2(tb[kk * 65 + nn], tb[(kk + 1) * 65 + nn]); }
    __syncthreads();
}

#define XB_TMO      128
#define XB_XCNT(j)  (256  + 64 * (j))
#define XB_XSUB(j)  (1280 + 64 * (j))
#define XB_XGEN(j)  (2304 + 64 * (j))
#define XB_TOP      3328
#define XB_TOPGEN   3392
#define XCD_BAR_WORDS 3456
#define XB_SPIN_CAP (1u << 18)

__device__ __forceinline__ unsigned xb_ld(unsigned* p)              { return __hip_atomic_load(p, __ATOMIC_RELAXED, __HIP_MEMORY_SCOPE_AGENT); }
__device__ __forceinline__ unsigned xb_add(unsigned* p, unsigned v) { return __hip_atomic_fetch_add(p, v, __ATOMIC_RELAXED, __HIP_MEMORY_SCOPE_AGENT); }
__device__ __forceinline__ unsigned xb_xcc_id() { return (unsigned)__builtin_amdgcn_s_getreg((3 << 11) | 20) & 0xFu; }
#define XB_SPIN(cond, bar) do { unsigned _sp = 0; while (cond) { __builtin_amdgcn_s_sleep(1); \
    if ((++_sp & 255u) == 0u) { if (xb_ld(&(bar)[XB_TMO])) break; if (_sp > XB_SPIN_CAP) { atomicAdd(&(bar)[XB_TMO], 1u); break; } } } } while (0)

struct XcdBarrier {
    unsigned* bar; unsigned x;
    volatile LAS unsigned* st;
};

__device__ __forceinline__ XcdBarrier xcd_barrier_post(unsigned* bar, volatile LAS unsigned* st) {
    XcdBarrier b; b.bar = bar; b.x = xb_xcc_id(); b.st = st;
    if (otid() == 0) (void)xb_add(&bar[XB_XCNT(b.x)], 1u);
    return b;
}
__device__ __forceinline__ void xcd_barrier_complete(unsigned* bar, unsigned x, unsigned& nloc, unsigned& nx) {
    const unsigned G = gridDim.x * gridDim.y * gridDim.z;
    unsigned sum, cnt, mine, sp = 0u;
    for (;;) {
        sum = 0u; cnt = 0u; mine = 0u;
#pragma unroll
        for (unsigned j = 0; j < 16; ++j) { const unsigned c = xb_ld(&bar[XB_XCNT(j)]); sum += c; cnt += (c > 0u) ? 1u : 0u; mine = (j == x) ? c : mine; }
        if (sum == G) break;
        __builtin_amdgcn_s_sleep(1);
        if ((++sp & 255u) == 0u) { if (xb_ld(&bar[XB_TMO])) break; if (sp > XB_SPIN_CAP) { atomicAdd(&bar[XB_TMO], 1u); break; } }
    }
    nloc = mine > 0u ? mine : 1u; nx = cnt > 0u ? cnt : 1u;
}

__device__ __forceinline__ void xcd_barrier(const XcdBarrier& b) {
    asm volatile("s_waitcnt vmcnt(0)" ::: "memory");
    __syncthreads();
    if (otid() == 0) {
        unsigned* bar = b.bar;
        __builtin_amdgcn_s_waitcnt(0);
        unsigned nloc = b.st[0], nx = b.st[1];
        if (nloc == 0u) { xcd_barrier_complete(bar, b.x, nloc, nx); b.st[0] = nloc; b.st[1] = nx; }
        const unsigned old = xb_add(&bar[XB_XSUB(b.x)], 1u);
        const unsigned gen = old / nloc;
        if (old + 1u == (gen + 1u) * nloc) {
            __builtin_amdgcn_fence(__ATOMIC_RELEASE, "agent");
            asm volatile("s_waitcnt vmcnt(0)" ::: "memory");
            const unsigned og = xb_add(&bar[XB_TOP], 1u);
            const unsigned tg = og / nx;
            if (og + 1u == (tg + 1u) * nx) xb_add(&bar[XB_TOPGEN], 1u);
            else XB_SPIN(xb_ld(&bar[XB_TOPGEN]) == tg, bar);
            __builtin_amdgcn_fence(__ATOMIC_ACQUIRE, "agent");
            xb_add(&bar[XB_XGEN(b.x)], 1u);
            asm volatile("s_waitcnt vmcnt(0)" ::: "memory");
        } else {
            XB_SPIN(xb_ld(&bar[XB_XGEN(b.x)]) == gen, bar);
            __builtin_amdgcn_fence(__ATOMIC_ACQUIRE, "agent");
            asm volatile("s_waitcnt vmcnt(0)" ::: "memory");
        }
    }
    __syncthreads();
}

struct CvDesc { const float* src; bf16_t* dst; int K, N, mode, tile; };
__device__ __forceinline__ bool cv_decode(CArgsP a, int l, int it, CvDesc& d) {
    bf16_t* W = (bf16_t*)(a->ws + WS_W); const int e = l >> 1, odd = l & 1;
    constexpr int T_FFIN = 8 * 88, T_FFOUT = 22 * 16, T_SQ = 128, T_KV = 8 * 32;
    const int T_MIXIN = odd ? 8 * 44 : 8 * 24;
    int r = it; d.mode = 0;
    if (r < T_FFIN) { d.src = a->in[2] + (size_t)l * 1024 * 5632; d.K = 1024; d.N = 5632; d.dst = W + W_FF1IN; d.mode = 1; d.tile = r; return true; } r -= T_FFIN;
    if (r < T_FFIN) { d.src = a->in[4] + (size_t)l * 1024 * 5632; d.K = 1024; d.N = 5632; d.dst = W + W_FF2IN; d.mode = 1; d.tile = r; return true; } r -= T_FFIN;
    if (r < T_FFOUT) { d.src = a->in[3] + (size_t)l * 2816 * 1024; d.K = 2816; d.N = 1024; d.dst = W + W_FF1OUT; d.tile = r; return true; } r -= T_FFOUT;
    if (r < T_FFOUT) { d.src = a->in[5] + (size_t)l * 2816 * 1024; d.K = 2816; d.N = 1024; d.dst = W + W_FF2OUT; d.tile = r; return true; } r -= T_FFOUT;
    if (r < T_SQ) { d.src = a->in[8] + (size_t)l * 1024 * 1024; d.K = 1024; d.N = 1024; d.dst = W + W_Q; d.tile = r; return true; } r -= T_SQ;
    if (r < T_KV) { d.src = a->in[9] + (size_t)l * 1024 * 2048; d.K = 1024; d.N = 2048; d.dst = W + W_KV; d.tile = r; return true; } r -= T_KV;
    if (r < T_SQ) { d.src = a->in[10] + (size_t)l * 1024 * 1024; d.K = 1024; d.N = 1024; d.dst = W + W_O; d.tile = r; return true; } r -= T_SQ;
    if (r < T_SQ) { d.src = (odd ? a->in[20] : a->in[12]) + (size_t)e * 1024 * 1024; d.K = 1024; d.N = 1024; d.dst = W + W_MIXOUT; d.tile = r; return true; } r -= T_SQ;
    if (r < T_MIXIN) { d.K = 1024; d.dst = W + W_MIXIN; d.tile = r; if (odd) { d.src = a->in[19] + (size_t)e * 1024 * 2816; d.N = 2816; } else { d.src = a->in[11] + (size_t)e * 1024 * 1536; d.N = 1536; } return true; }
    return false;
}
__device__ __forceinline__ void cv_load(const CvDesc& d, int tid, float (&v)[16]) {
    const int ntn = d.N >> 6, k0 = (d.tile / ntn) << 7, n0 = (d.tile % ntn) << 6;
#pragma unroll
    for (int i = 0; i < 16; ++i) v[i] = d.src[(size_t)(k0 + i * 8 + (tid >> 6)) * d.N + n0 + (tid & 63)];
}
__device__ __forceinline__ void convert_layer(CArgsP a, int l, unsigned char* shm) {
    float* tb = (float*)shm; bf16_t* W = (bf16_t*)(a->ws + WS_W);
    const int e = l >> 1, odd = l & 1, tid = otid();
    {
        CvDesc d, nx; float v[16]; int it = blockIdx.x; bool have = cv_decode(a, l, it, d);
        if (have) cv_load(d, tid, v);
        while (have) {
#pragma unroll
            for (int i = 0; i < 16; ++i) tb[(i * 8 + (tid >> 6)) * 65 + (tid & 63)] = v[i];
            __syncthreads();
            it += gridDim.x; const bool hn = cv_decode(a, l, it, nx);
            if (hn) cv_load(nx, tid, v);
            const int ntn = d.N >> 6, k0 = (d.tile / ntn) << 7, n0 = (d.tile % ntn) << 6;
#pragma unroll
            for (int i = 0; i < 8; ++i) { const int nn = i * 8 + (tid >> 6), kk = 2 * (tid & 63), n = n0 + nn; const int row = d.mode ? rowmap<1>(n) : n;
                *(unsigned*)(d.dst + (size_t)row * d.K + k0 + kk) = pk2(tb[kk * 65 + nn], tb[(kk + 1) * 65 + nn]); }
            __syncthreads();
            d = nx; have = hn;
        }
    }
    const int gtid = blockIdx.x * 512 + otid(), nth = gridDim.x * 512;
    if (!odd) {
        const float* pw = a->in[13] + (size_t)e * 4 * 128 * 128;
        for (int idx = gtid; idx < 512 * 512; idx += nth) { const int n = idx >> 9, k = idx & 511, g = n >> 7, d = n & 127, g2 = k >> 7, c = k & 127;
            W[W_AUX1 + idx] = (g == g2) ? f2bf(pw[(g * 128 + c) * 128 + d]) : (bf16_t)0; }
    } else {
        const float* wup = a->in[23] + (size_t)e * 64 * 512; const float* aup = a->in[25] + (size_t)e * 64 * 512; const float* gup = a->in[26] + (size_t)e * 128 * 512;
        for (int idx = gtid; idx < 1536 * 256; idx += nth) { const int n = idx >> 8, k = idx & 255, kind = n >> 9, j = n & 511; float v = 0.f;
            if (kind == 0) { if (k < 64) v = wup[k * 512 + j]; } else if (kind == 1) { if (k >= 64 && k < 128) v = aup[(k - 64) * 512 + j]; } else { if (k >= 128) v = gup[(k - 128) * 512 + j]; }
            W[W_AUX1 + idx] = f2bf(v); }
        const float* wa = a->in[34] + (size_t)e * 8 * 64 * 64; const float* wx = a->in[36] + (size_t)e * 8 * 64 * 64;
        for (int idx = gtid; idx < 1024 * 512; idx += nth) { const int n = idx >> 9, k = idx & 511, pn = n >> 8, bj = (n >> 7) & 1, cc = n & 127, ch = pn * 128 + cc, hb = ch >> 6, jj = ch & 63; float v = 0.f;
            if ((k >> 6) == hb) v = (bj ? wx : wa)[(hb * 64 + (k & 63)) * 64 + jj];
            W[W_AUX2 + idx] = f2bf(v); }
    }
}
__device__ __forceinline__ void prologue_cast(CArgsP a) {
    const int gtid = blockIdx.x * 512 + otid(), nth = gridDim.x * 512;
    const f32x4* x4 = (const f32x4*)a->in[0]; u32x2* xb = (u32x2*)(a->ws + WS_XB);
    for (int i0 = gtid; i0 < NTOK * DM / 4; i0 += nth * 8) { f32x4 v[8];
#pragma unroll
        for (int u = 0; u < 8; ++u) { const int i = i0 + u * nth; v[u] = (i < NTOK * DM / 4) ? x4[i] : (f32x4){0.f, 0.f, 0.f, 0.f}; }
#pragma unroll
        for (int u = 0; u < 8; ++u) { const int i = i0 + u * nth; if (i < NTOK * DM / 4) { u32x2 o; o.x = pk2(v[u][0], v[u][1]); o.y = pk2(v[u][2], v[u][3]); xb[i] = o; ((h16x4*)a->out)[i] = __builtin_convertvector(v[u], h16x4); } } }
    { float* MR = (float*)(a->ws + WS_MR); for (int i = gtid; i < NTOK; i += nth) { MR[2 * i] = 0.f; MR[2 * i + 1] = 1.f; } }
    const f32x4* m4 = (const f32x4*)a->in[1]; u32x2* mb = (u32x2*)(a->ws + WS_MISC + 2 * MiB);
    for (int i = gtid; i < 512 * DM / 4; i += nth) { const f32x4 v = m4[i]; u32x2 o; o.x = pk2(v[0], v[1]); o.y = pk2(v[2], v[3]); mb[i] = o; }
}
#define DPP_F(v, ctrl) __builtin_bit_cast(float, __builtin_amdgcn_update_dpp(0, __builtin_bit_cast(int, (v)), (ctrl), 0xF, 0xF, false))
__device__ __forceinline__ float wsum_fast(float v) {
    v += DPP_F(v, 0xB1); v += DPP_F(v, 0x4E); v += DPP_F(v, 0x141); v += DPP_F(v, 0x140);
    const int iv = __builtin_bit_cast(int, v);
    const float s0 = __builtin_bit_cast(float, __builtin_amdgcn_readlane(iv, 0)), s1 = __builtin_bit_cast(float, __builtin_amdgcn_readlane(iv, 16));
    const float s2 = __builtin_bit_cast(float, __builtin_amdgcn_readlane(iv, 32)), s3 = __builtin_bit_cast(float, __builtin_amdgcn_readlane(iv, 48));
    return (s0 + s1) + (s2 + s3);
}
__device__ __forceinline__ void ln_phase(const void* zin, float* xo, bf16_t* XB, float* MR, const float* g, const float* b, int bofs, int nblk) {
    const int lane = otid() & 63, wave = otid() >> 6;
    int row = ((int)blockIdx.x - bofs) * 8 + wave; const int rstep = nblk * 8;
    {
        f32x4 g4[2][2], b4[2][2];
#pragma unroll
        for (int j = 0; j < 2; ++j)
#pragma unroll
            for (int q = 0; q < 2; ++q) { g4[j][q] = *(const f32x4*)(g + 8 * lane + 512 * j + 4 * q); b4[j][q] = *(const f32x4*)(b + 8 * lane + 512 * j + 4 * q); }
        h16x8 nx[2];
        if (row < NTOK) {
#pragma unroll
            for (int j = 0; j < 2; ++j) nx[j] = *(const h16x8*)((const h16*)zin + (size_t)row * DM + 8 * lane + 512 * j);
        }
        for (; row < NTOK; row += rstep) {
            float v[2][8]; float s = 0.f;
#pragma unroll
            for (int j = 0; j < 2; ++j)
#pragma unroll
                for (int q = 0; q < 8; ++q) { v[j][q] = (float)nx[j][q]; s += v[j][q]; }
            if (row + rstep < NTOK) {
#pragma unroll
                for (int j = 0; j < 2; ++j) nx[j] = *(const h16x8*)((const h16*)zin + (size_t)(row + rstep) * DM + 8 * lane + 512 * j);
            }
            const float mean = wsum_fast(s) * (1.f / DM); float s2 = 0.f;
#pragma unroll
            for (int j = 0; j < 2; ++j)
#pragma unroll
                for (int q = 0; q < 8; ++q) { v[j][q] -= mean; s2 += v[j][q] * v[j][q]; }
            const float rstd = rsqrtf(wsum_fast(s2) * (1.f / DM) + 1e-5f);
            if (lane == 0) { MR[2 * row] = mean; MR[2 * row + 1] = rstd; }
#pragma unroll
            for (int j = 0; j < 2; ++j) { float y[8];
#pragma unroll
                for (int q = 0; q < 8; ++q) y[q] = v[j][q] * rstd * g4[j][q >> 2][q & 3] + b4[j][q >> 2][q & 3];
                u32x4 o; o.x = pk2(y[0], y[1]); o.y = pk2(y[2], y[3]); o.z = pk2(y[4], y[5]); o.w = pk2(y[6], y[7]);
                *(u32x4*)(XB + (size_t)row * DM + 8 * lane + 512 * j) = o; }
        }
    }
}
__device__ __forceinline__ void ln_final_load(const h16* zin, h16x8 (&zr)[16][2]) {
    const int lane = otid() & 63, wave = otid() >> 6;
#pragma unroll
    for (int i = 0; i < 16; ++i) { const int row = (int)blockIdx.x * 8 + wave + i * (int)gridDim.x * 8;
#pragma unroll
        for (int j = 0; j < 2; ++j) zr[i][j] = (row < NTOK) ? *(const h16x8*)(zin + (size_t)row * DM + 8 * lane + 512 * j) : (h16x8)(h16)0; }
}
__device__ __forceinline__ void ln_final_store(const h16x8 (&zr)[16][2], float* xo, const float* g, const float* b) {
    const int lane = otid() & 63, wave = otid() >> 6;
    f32x4 g4[2][2], b4[2][2];
#pragma unroll
    for (int j = 0; j < 2; ++j)
#pragma unroll
        for (int q = 0; q < 2; ++q) { g4[j][q] = *(const f32x4*)(g + 8 * lane + 512 * j + 4 * q); b4[j][q] = *(const f32x4*)(b + 8 * lane + 512 * j + 4 * q); }
#pragma unroll
    for (int i = 0; i < 16; ++i) { const int row = (int)blockIdx.x * 8 + wave + i * (int)gridDim.x * 8; float v[2][8]; float s = 0.f;
#pragma unroll
        for (int j = 0; j < 2; ++j)
#pragma unroll
            for (int q = 0; q < 8; ++q) { v[j][q] = (float)zr[i][j][q]; s += v[j][q]; }
        const float mean = wsum_fast(s) * (1.f / DM); float s2 = 0.f;
#pragma unroll
        for (int j = 0; j < 2; ++j)
#pragma unroll
            for (int q = 0; q < 8; ++q) { v[j][q] -= mean; s2 += v[j][q] * v[j][q]; }
        const float rstd = rsqrtf(wsum_fast(s2) * (1.f / DM) + 1e-5f);
        if (row < NTOK) {
#pragma unroll
            for (int j = 0; j < 2; ++j)
#pragma unroll
                for (int q = 0; q < 2; ++q) { f32x4 y;
#pragma unroll
                    for (int t = 0; t < 4; ++t) y[t] = v[j][4 * q + t] * rstd * g4[j][q][t] + b4[j][q][t];
                    *(f32x4*)(xo + (size_t)row * DM + 8 * lane + 512 * j + 4 * q) = y; } } }
}
constexpr int AT_LD = 528;
__device__ __forceinline__ void attn_fill(LAS unsigned char* lds, const bf16_t* src, int ld_src, int tid) {
#pragma unroll 1
    for (int hb = 0; hb < 16; hb += 8) { u32x4 t[8];
#pragma unroll
        for (int i = 0; i < 8; ++i) { const int id = (hb + i) * 512 + tid, row = id >> 5, c = id & 31; t[i] = *(const u32x4*)(src + (size_t)row * ld_src + c * 8); }
#pragma unroll
        for (int i = 0; i < 8; ++i) { const int id = (hb + i) * 512 + tid, row = id >> 5, c = id & 31; *(LAS u32x4*)(lds + row * AT_LD + c * 16) = t[i]; } }
}
__device__ __forceinline__ void attn_phase(const bf16_t* Q, const bf16_t* Kb, const bf16_t* VT, bf16_t* O, unsigned char* shm) {
    const int tid = otid(), lane = tid & 63, wave = tid >> 6, fr = lane & 15, fq = lane >> 4;
    LAS unsigned char* lds = (LAS unsigned char*)shm;
    for (int item = blockIdx.x; item < 512; item += gridDim.x) {
        const int bh = item & 7, b = bh >> 2, h = bh & 3, row0 = b * SEQ + (item >> 3) * 256 + wave * 32;
        bf16x8 qf[2][8];
#pragma unroll
        for (int t = 0; t < 2; ++t)
#pragma unroll
            for (int ks = 0; ks < 8; ++ks) qf[t][ks] = *(const bf16x8*)(Q + (size_t)(row0 + t * 16 + fr) * DM + h * 256 + ks * 32 + fq * 8);
        attn_fill(lds, Kb + (size_t)(b * 256) * DM + h * 256, DM, tid);
        __syncthreads();
        f32x4 s[2][16];
        {
            bf16x8 kf[3][2]; f32x4 a0 = {0.f, 0.f, 0.f, 0.f}, a1 = {0.f, 0.f, 0.f, 0.f};
            const LAS unsigned char* kb = lds + fr * AT_LD + fq * 16;
#pragma unroll
            for (int pg = 0; pg < 2; ++pg)
#pragma unroll
                for (int ks = 0; ks < 2; ++ks) kf[pg][ks] = *(const LAS bf16x8*)(kb + pg * 128 + ks * 64);
#pragma unroll
            for (int g = 0; g < 64; ++g) { const int mt = g >> 2, qd = g & 3;
                if (g + 2 < 64) { const int ng = g + 2; const LAS unsigned char* np = kb + (ng >> 2) * 16 * AT_LD + (ng & 3) * 128;
#pragma unroll
                    for (int ks = 0; ks < 2; ++ks) kf[ng % 3][ks] = *(const LAS bf16x8*)(np + ks * 64); }
                __builtin_amdgcn_sched_barrier(0);
#pragma unroll
                for (int ks = 0; ks < 2; ++ks) { const bf16x8 kv = kf[g % 3][ks];
                    a0 = __builtin_amdgcn_mfma_f32_16x16x32_bf16(kv, qf[0][qd * 2 + ks], a0, 0, 0, 0); a1 = __builtin_amdgcn_mfma_f32_16x16x32_bf16(kv, qf[1][qd * 2 + ks], a1, 0, 0, 0); }
                if (qd == 3) { s[0][mt] = a0; s[1][mt] = a1; a0 = (f32x4){0.f, 0.f, 0.f, 0.f}; a1 = (f32x4){0.f, 0.f, 0.f, 0.f}; }
                __builtin_amdgcn_sched_barrier(0); }
        }
        bf16x8 pb[2][8]; float inv[2];
#pragma unroll
        for (int t = 0; t < 2; ++t) { float mx = -3.0e38f;
#pragma unroll
            for (int mt = 0; mt < 16; ++mt)
#pragma unroll
                for (int q = 0; q < 4; ++q) mx = fmaxf(mx, s[t][mt][q]);
            mx = fmaxf(mx, __shfl_xor(mx, 16)); mx = fmaxf(mx, __shfl_xor(mx, 32));
            float sum = 0.f;
#pragma unroll
            for (int mt = 0; mt < 16; ++mt)
#pragma unroll
                for (int q = 0; q < 4; ++q) { const float pv = __expf(s[t][mt][q] - mx); s[t][mt][q] = pv; sum += pv; }
            sum += __shfl_xor(sum, 16); sum += __shfl_xor(sum, 32); inv[t] = 1.0f / sum;
#pragma unroll
            for (int kp = 0; kp < 8; ++kp) { u32x4 tt; tt.x = pk2(s[t][2 * kp][0], s[t][2 * kp][1]); tt.y = pk2(s[t][2 * kp][2], s[t][2 * kp][3]); tt.z = pk2(s[t][2 * kp + 1][0], s[t][2 * kp + 1][1]); tt.w = pk2(s[t][2 * kp + 1][2], s[t][2 * kp + 1][3]);
                pb[t][kp] = __builtin_bit_cast(bf16x8, tt); } }
        __syncthreads();
        attn_fill(lds, VT + (size_t)((b * 4 + h) * 256) * 256, 256, tid);
        __syncthreads();
        {
            u32x2 vA[8], vB[8]; f32x4 a0 = {0.f, 0.f, 0.f, 0.f}, a1 = {0.f, 0.f, 0.f, 0.f};
            const LAS unsigned char* vb = lds + fr * AT_LD + fq * 8;
#pragma unroll
            for (int q = 0; q < 8; ++q) vA[q] = *(const LAS u32x2*)(vb + q * 32);
#pragma unroll
            for (int g = 0; g < 32; ++g) { const int dt = g >> 1, hf = g & 1;
                if (g + 1 < 32) { const int ndt = (g + 1) >> 1, nhf = (g + 1) & 1; const LAS unsigned char* np = vb + ndt * 16 * AT_LD + nhf * 256;
#pragma unroll
                    for (int q = 0; q < 8; ++q) { if (g & 1) vA[q] = *(const LAS u32x2*)(np + q * 32); else vB[q] = *(const LAS u32x2*)(np + q * 32); } }
                __builtin_amdgcn_sched_barrier(0);
#pragma unroll
                for (int kq = 0; kq < 4; ++kq) { const u32x2 lo = (g & 1) ? vB[2 * kq] : vA[2 * kq], hi = (g & 1) ? vB[2 * kq + 1] : vA[2 * kq + 1]; u32x4 tt; tt.x = lo.x; tt.y = lo.y; tt.z = hi.x; tt.w = hi.y;
                    const bf16x8 vf = __builtin_bit_cast(bf16x8, tt);
                    a0 = __builtin_amdgcn_mfma_f32_16x16x32_bf16(vf, pb[0][hf * 4 + kq], a0, 0, 0, 0); a1 = __builtin_amdgcn_mfma_f32_16x16x32_bf16(vf, pb[1][hf * 4 + kq], a1, 0, 0, 0); }
                if (hf) { u32x2 o; o.x = pk2(a0[0] * inv[0], a0[1] * inv[0]); o.y = pk2(a0[2] * inv[0], a0[3] * inv[0]);
                    *(u32x2*)(O + (size_t)(row0 + fr) * DM + h * 256 + dt * 16 + fq * 4) = o;
                    o.x = pk2(a1[0] * inv[1], a1[1] * inv[1]); o.y = pk2(a1[2] * inv[1], a1[3] * inv[1]);
                    *(u32x2*)(O + (size_t)(row0 + 16 + fr) * DM + h * 256 + dt * 16 + fq * 4) = o;
                    a0 = (f32x4){0.f, 0.f, 0.f, 0.f}; a1 = (f32x4){0.f, 0.f, 0.f, 0.f}; }
                __builtin_amdgcn_sched_barrier(0); }
        }
        __syncthreads();
    }
}
__device__ __forceinline__ void even_core(CArgsP a, int e, unsigned char* shm) {
    const bf16_t* H = (const bf16_t*)(a->ws + WS_H); bf16_t* POOLED = (bf16_t*)(a->ws + WS_LO); bf16_t* CONCAT = (bf16_t*)(a->ws + WS_XB);
    const int tid = otid(), lane = tid & 63, wave = tid >> 6;
    LAS float* Wl = (LAS float*)shm; LAS float* Vl = Wl + 128 * 129; LAS float* st = Vl + 128 * 128;
    const float* sgw = a->in[17] + (size_t)e * 4 * 128 * 128; const float* sgb = a->in[18] + (size_t)e * 4 * 128;
    const float* lng = a->in[15] + (size_t)e * 512; const float* lnb = a->in[16] + (size_t)e * 512;
    for (int chunk = blockIdx.x; chunk < NTOK / 128; chunk += gridDim.x) {
        const int tok0 = chunk * 128, tseq0 = tok0 & (SEQ - 1);
        {
            const int c = tid, grp = c >> 7; float hist[16]; hist[0] = 0.f;
#pragma unroll
            for (int u = 1; u < 16; ++u) { const int p = u - 16; hist[u] = (tseq0 + p >= 0) ? bf2f(H[(size_t)(tok0 + p) * 1536 + c]) : 0.f; }
            for (int tb = 0; tb < 128; tb += 16) { unsigned short xs[16];
#pragma unroll
                for (int u = 0; u < 16; ++u) xs[u] = H[(size_t)(tok0 + tb + u) * 1536 + c];
#pragma unroll
                for (int u = 0; u < 16; ++u) { const int t = tb + u; const float x = bf2f(xs[u]); hist[u] = x;
                    const float s2 = x + hist[(u + 15) & 15];
                    const float s4 = s2 + hist[(u + 14) & 15] + hist[(u + 13) & 15];
                    const float s8 = s4 + (hist[(u + 12) & 15] + hist[(u + 11) & 15]) + (hist[(u + 10) & 15] + hist[(u + 9) & 15]);
                    const float s16 = s8 + ((hist[(u + 8) & 15] + hist[(u + 7) & 15]) + (hist[(u + 6) & 15] + hist[(u + 5) & 15])) + ((hist[(u + 4) & 15] + hist[(u + 3) & 15]) + (hist[(u + 2) & 15] + hist[(u + 1) & 15]));
                    const float sum = grp == 0 ? s2 : grp == 1 ? s4 : grp == 2 ? s8 : s16; const int win = 2 << grp, pos = tseq0 + t + 1;
                    const float dv = (float)(pos < win ? pos : win);
                    POOLED[(size_t)(tok0 + t) * 512 + c] = f2bf(sum / dv - x); }
            }
        }
#pragma unroll 8
        for (int i = 0; i < 16; ++i) { const int t = wave + 8 * i; const bf16x8 v8 = *(const bf16x8*)(H + (size_t)(tok0 + t) * 1536 + 1024 + lane * 8); float f[8], s = 0.f;
#pragma unroll
            for (int q = 0; q < 8; ++q) { f[q] = bfs2f(v8[q]); s += f[q]; }
            const float mean = wsum_fast(s) * (1.f / 512.f); float s2 = 0.f;
#pragma unroll
            for (int q = 0; q < 8; ++q) { const float d = f[q] - mean; s2 += d * d; }
            const float var = wsum_fast(s2) * (1.f / 512.f);
            if (lane == 0) { st[2 * t] = mean; st[2 * t + 1] = rsqrtf(var + 1e-5f); } }
        __syncthreads();
        for (int h = 0; h < 4; ++h) {
#pragma unroll
            for (int it = 0; it < 8; ++it) { const int idx = it * 512 + tid, t = idx >> 5, s0 = (idx & 31) * 4; const f32x4 w4 = *(const f32x4*)(sgw + (size_t)(h * 128 + t) * 128 + s0);
#pragma unroll
                for (int q = 0; q < 4; ++q) Wl[t * 129 + s0 + q] = (s0 + q <= t) ? w4[q] : 0.f; }
#pragma unroll
            for (int it = 0; it < 4; ++it) { const int idx = it * 512 + tid, s = idx >> 4, d0 = (idx & 15) * 8; const bf16x8 v8 = *(const bf16x8*)(H + (size_t)(tok0 + s) * 1536 + 1024 + h * 128 + d0);
                const float mean = st[2 * s], rstd = st[2 * s + 1];
#pragma unroll
                for (int q = 0; q < 8; ++q) Vl[s * 128 + d0 + q] = (bfs2f(v8[q]) - mean) * rstd * lng[h * 128 + d0 + q] + lnb[h * 128 + d0 + q]; }
            __syncthreads();
            const int d0 = (tid & 15) * 8, t0 = (tid >> 4) * 4;
            float acc[4][8];
#pragma unroll
            for (int i = 0; i < 4; ++i)
#pragma unroll
                for (int q = 0; q < 8; ++q) acc[i][q] = 0.f;
            for (int s = 0; s <= t0 + 3; ++s) { const f32x4 va = *(const LAS f32x4*)(Vl + s * 128 + d0), vb = *(const LAS f32x4*)(Vl + s * 128 + d0 + 4);
#pragma unroll
                for (int i = 0; i < 4; ++i) { const float w = Wl[(t0 + i) * 129 + s];
#pragma unroll
                    for (int q = 0; q < 4; ++q) { acc[i][q] += w * va[q]; acc[i][4 + q] += w * vb[q]; } } }
            bf16x8 u8a[4]; float biasa[4];
#pragma unroll
            for (int i = 0; i < 4; ++i) { u8a[i] = *(const bf16x8*)(H + (size_t)(tok0 + t0 + i) * 1536 + 512 + h * 128 + d0); biasa[i] = sgb[h * 128 + t0 + i]; }
#pragma unroll
            for (int i = 0; i < 4; ++i) { const int t = t0 + i; const float bias = biasa[i]; const bf16x8 u8 = u8a[i];
                float o[8];
#pragma unroll
                for (int q = 0; q < 8; ++q) o[q] = bfs2f(u8[q]) * (acc[i][q] + bias);
                u32x4 ov; ov.x = pk2(o[0], o[1]); ov.y = pk2(o[2], o[3]); ov.z = pk2(o[4], o[5]); ov.w = pk2(o[6], o[7]);
                *(u32x4*)(CONCAT + (size_t)(tok0 + t) * 1024 + 512 + h * 128 + d0) = ov; }
            __syncthreads();
        }
    }
}
__device__ __forceinline__ void odd_prep(CArgsP a, int e) {
    const bf16_t* H = (const bf16_t*)(a->ws + WS_H); bf16_t* AP = (bf16_t*)(a->ws + WS_AP); bf16_t* XC = (bf16_t*)(a->ws + WS_XC);
    const float* mu = a->in[21] + (size_t)e * 1792; const float* cw = a->in[32] + (size_t)e * 4 * 512; const float* cb = a->in[33] + (size_t)e * 512;
    const int gtid = blockIdx.x * 512 + otid(), nth = gridDim.x * 512;
    const bf16x8 z8 = {0, 0, 0, 0, 0, 0, 0, 0};
    float muA[8], cbX[8], cwX[4][8];
    { const int cA = (gtid & 31) * 8, cX = (gtid & 63) * 8;
#pragma unroll
      for (int q = 0; q < 8; ++q) { muA[q] = mu[1536 + cA + q]; cbX[q] = cb[cX + q];
#pragma unroll
          for (int i = 0; i < 4; ++i) cwX[i][q] = cw[i * 512 + cX + q]; } }
    for (int it0 = gtid; it0 < NTOK * 32; it0 += nth * 4) { bf16x8 cur[4], prv[4];
#pragma unroll
        for (int u = 0; u < 4; ++u) { const int it = it0 + u * nth, tok = it >> 5, c0 = (it & 31) * 8; const bool ok = it < NTOK * 32;
            cur[u] = ok ? *(const bf16x8*)(H + (size_t)tok * 2816 + 1536 + c0) : z8;
            prv[u] = (ok && (tok & (SEQ - 1))) ? *(const bf16x8*)(H + (size_t)(tok - 1) * 2816 + 1536 + c0) : z8; }
#pragma unroll
        for (int u = 0; u < 4; ++u) { const int it = it0 + u * nth, tok = it >> 5, c0 = (it & 31) * 8; if (it < NTOK * 32) { float v[8];
#pragma unroll
            for (int q = 0; q < 8; ++q) { const float c = bfs2f(cur[u][q]), z = c + muA[q] * (bfs2f(prv[u][q]) - c); v[q] = c0 < 64 ? tanhf_(z) : (c0 < 128 ? z : sigmoidf_(z)); }
            u32x4 o; o.x = pk2(v[0], v[1]); o.y = pk2(v[2], v[3]); o.z = pk2(v[4], v[5]); o.w = pk2(v[6], v[7]); *(u32x4*)(AP + (size_t)tok * 256 + c0) = o; } } }
    for (int it0 = gtid; it0 < NTOK * 64; it0 += nth * 4) { bf16x8 x8[4][4];
#pragma unroll
        for (int u = 0; u < 4; ++u) { const int it = it0 + u * nth, tok = it >> 6, c0 = (it & 63) * 8, tseq = tok & (SEQ - 1); const bool ok = it < NTOK * 64;
#pragma unroll
            for (int i = 0; i < 4; ++i) x8[u][i] = (ok && tseq - 3 + i >= 0) ? *(const bf16x8*)(H + (size_t)(tok - 3 + i) * 2816 + 2304 + c0) : z8; }
#pragma unroll
        for (int u = 0; u < 4; ++u) { const int it = it0 + u * nth, tok = it >> 6, c0 = (it & 63) * 8; if (it < NTOK * 64) { float v[8];
#pragma unroll
            for (int q = 0; q < 8; ++q) v[q] = cbX[q];
#pragma unroll
            for (int i = 0; i < 4; ++i)
#pragma unroll
                for (int q = 0; q < 8; ++q) v[q] += cwX[i][q] * bfs2f(x8[u][i][q]);
            u32x4 o; o.x = pk2(v[0], v[1]); o.y = pk2(v[2], v[3]); o.z = pk2(v[4], v[5]); o.w = pk2(v[6], v[7]); *(u32x4*)(XC + (size_t)tok * 512 + c0) = o; } } }
}
constexpr int RW_STEP = 448, RW_WAVE = 8 * RW_STEP + 8;
typedef float f32x2 __attribute__((ext_vector_type(2)));
__device__ __forceinline__ float red8(float v) {
    v += __builtin_bit_cast(float, __builtin_amdgcn_update_dpp(0, __builtin_bit_cast(int, v), 0xB1, 0xF, 0xF, false));
    v += __builtin_bit_cast(float, __builtin_amdgcn_update_dpp(0, __builtin_bit_cast(int, v), 0x4E, 0xF, 0xF, false));
    v += __builtin_bit_cast(float, __builtin_amdgcn_update_dpp(0, __builtin_bit_cast(int, v), 0x141, 0xF, 0xF, false));
    return v;
}
__device__ __forceinline__ float red4(float v) { v += DPP_F(v, 0xB1); v += DPP_F(v, 0x4E); return v; }
#define LD8P(dst, ptr) do { _Pragma("unroll") for (int _q = 0; _q < 4; ++_q) { const f32x4 _t = *(const LAS f32x4*)((ptr) + 4 * _q); dst[2 * _q] = (f32x2){_t[0], _t[1]}; dst[2 * _q + 1] = (f32x2){_t[2], _t[3]}; } } while (0)
template <int MODE> __device__ __forceinline__ void rwkv_scan(CArgsP a, int e, int bh, int c, LAS float* wl) {
    const int lane = otid() & 63, b = bh >> 3, h = bh & 7, cj = h * 64 + lane, ib = lane >> 2, jb = lane & 3;
    const bf16_t* H = (const bf16_t*)(a->ws + WS_H); const bf16_t* LO = (const bf16_t*)(a->ws + WS_LO); bf16_t* CONCAT = (bf16_t*)(a->ws + WS_XB);
    float* Lc = (float*)(a->ws + WS_AP); float* Mc = Lc + (size_t)16 * NCH * 4096; float* Ss = Mc + (size_t)16 * NCH * 4096;
    const size_t sidx = ((size_t)bh * NCH + c) * 4096 + (size_t)(ib * 4) * 64 + jb * 16;
    const int tok0 = b * SEQ + c * TCH;
    const float* mu = a->in[21] + (size_t)e * 1792;
    const float mu_r = mu[cj], mu_k = mu[512 + cj], mu_v = mu[1024 + cj], kkc = a->in[27][e * 512 + cj], kac = a->in[28][e * 512 + cj], rkc = a->in[29][e * 512 + cj];
    const float gng = a->in[30][e * 512 + cj], gnb = a->in[31][e * 512 + cj];
    const float w0c = a->in[22][e * 512 + cj], a0c = a->in[24][e * 512 + cj];
    f32x2 S[4][8];
    if (MODE == 2) {
#pragma unroll
        for (int r = 0; r < 4; ++r)
#pragma unroll
            for (int q = 0; q < 4; ++q) { const f32x4 t = *(const f32x4*)(Ss + sidx + r * 64 + 4 * q); S[r][2 * q] = (f32x2){t[0], t[1]}; S[r][2 * q + 1] = (f32x2){t[2], t[3]}; }
    } else {
#pragma unroll
        for (int r = 0; r < 4; ++r)
#pragma unroll
            for (int q = 0; q < 8; ++q) { const int row = ib * 4 + r, col = jb * 16 + 2 * q; S[r][q][0] = (MODE == 1 && row == col) ? 1.f : 0.f; S[r][q][1] = (MODE == 1 && row == col + 1) ? 1.f : 0.f; }
    }
    float pr = 0.f, pk = 0.f, pv = 0.f;
    if (c > 0) { const bf16_t* hp = H + (size_t)(tok0 - 1) * 2816 + cj; pr = bf2f(hp[0]); pk = bf2f(hp[512]); pv = bf2f(hp[1024]); }
    unsigned short rw[8][6];
#define RW_LOAD(T0) do { _Pragma("unroll") for (int s = 0; s < 8; ++s) { const size_t tok = (size_t)(tok0 + (T0) + s); const bf16_t* hp = H + tok * 2816 + cj; const bf16_t* lp = LO + tok * 1536 + cj; \
        rw[s][0] = hp[0]; rw[s][1] = hp[512]; rw[s][2] = hp[1024]; rw[s][3] = lp[0]; rw[s][4] = lp[512]; if (MODE == 2) rw[s][5] = lp[1024]; } } while (0)
    RW_LOAD(0);
    for (int t0 = 0; t0 < TCH; t0 += 8) {
#pragma unroll
        for (int s = 0; s < 8; ++s) {
            const float rr = bf2f(rw[s][0]), kr = bf2f(rw[s][1]), vr = bf2f(rw[s][2]), ee = __expf(-softplusf_(-(w0c + bf2f(rw[s][3]))) - 0.5f), aa = sigmoidf_(a0c + bf2f(rw[s][4]));
            const float rl = rr + mu_r * (pr - rr), kl = kr + mu_k * (pk - kr), vl = vr + mu_v * (pv - vr); pr = rr; pk = kr; pv = vr;
            const float kkj = kl * kkc, ss = wsum_fast(kkj * kkj), kn = kkj * rsqrtf(fmaxf(ss, 1e-24f));
            const float kp = kl * (1.0f + (aa - 1.0f) * kac), dec = __expf(-ee);
            LAS float* base = wl + s * RW_STEP;
            base[lane] = -kn; base[64 + lane] = dec; base[128 + lane] = kn * aa; base[192 + lane] = kp; base[320 + lane] = vl;
            if (MODE == 2) { base[256 + lane] = rl; base[384 + lane] = bf2f(rw[s][5]); const float bd = wsum_fast(rl * kp * rkc); if (lane == 0) wl[8 * RW_STEP + s] = bd; } }
        if (t0 + 8 < TCH) RW_LOAD(t0 + 8);
        LDS_SYNC_WAVE();
#pragma unroll 2
        for (int s = 0; s < 8; ++s) { const LAS float* base = wl + s * RW_STEP;
            f32x2 av[8], dc[8], bv[8], kp[8]; f32x4 vr4 = {0.f, 0.f, 0.f, 0.f};
            LD8P(av, base + jb * 16); LD8P(dc, base + 64 + jb * 16); LD8P(bv, base + 128 + jb * 16);
            if (MODE != 1) { LD8P(kp, base + 192 + jb * 16); vr4 = *(const LAS f32x4*)(base + 320 + ib * 4); }
            float sa[4];
#pragma unroll
            for (int r = 0; r < 4; ++r) { f32x2 p = S[r][0] * av[0];
#pragma unroll
                for (int q = 1; q < 8; ++q) p += S[r][q] * av[q];
                sa[r] = red4(p[0] + p[1]); }
#pragma unroll
            for (int r = 0; r < 4; ++r) { const f32x2 sa2 = (f32x2){sa[r], sa[r]};
                if (MODE == 1) {
#pragma unroll
                    for (int q = 0; q < 8; ++q) S[r][q] = S[r][q] * dc[q] + sa2 * bv[q];
                } else { const f32x2 v2 = (f32x2){vr4[r], vr4[r]};
#pragma unroll
                    for (int q = 0; q < 8; ++q) S[r][q] = S[r][q] * dc[q] + (sa2 * bv[q] + v2 * kp[q]); } }
            if (MODE == 2) { f32x2 rv[8]; LD8P(rv, base + 256 + jb * 16);
                float y = 0.f;
#pragma unroll
                for (int r = 0; r < 4; ++r) { f32x2 p = S[r][0] * rv[0];
#pragma unroll
                    for (int q = 1; q < 8; ++q) p += S[r][q] * rv[q];
                    const float yr = red4(p[0] + p[1]); y = (jb == r) ? yr : y; }
                const float vi = base[320 + lane];
                const float mean = wsum_fast(y) * (1.f / 64.f), ey2 = wsum_fast(y * y) * (1.f / 64.f), dl = y - mean, var = fmaxf(ey2 - mean * mean, 0.f);
                const float yn = dl * rsqrtf(var + 64e-5f) * gng + gnb;
                const float o = (yn + wl[8 * RW_STEP + s] * vi) * base[384 + lane];
                CONCAT[(size_t)(tok0 + t0 + s) * 1024 + cj] = f2bf(o); } }
        LDS_SYNC_WAVE();
    }
#undef RW_LOAD
    if (MODE != 2) { float* dst = (MODE == 0 ? Lc : Mc) + sidx;
#pragma unroll
        for (int r = 0; r < 4; ++r)
#pragma unroll
            for (int q = 0; q < 4; ++q) { f32x4 t; t[0] = S[r][2 * q][0]; t[1] = S[r][2 * q][1]; t[2] = S[r][2 * q + 1][0]; t[3] = S[r][2 * q + 1][1]; *(f32x4*)(dst + r * 64 + 4 * q) = t; } }
}
template <int MODE> __device__ __forceinline__ void rwkv_pass1_pair(CArgsP a, int e, int bh, int c, LAS float* pl) {
    const int lane = otid() & 63, b = bh >> 3, h = bh & 7, cj = h * 64 + lane, ib = lane >> 2, jb = lane & 3;
    const bf16_t* H = (const bf16_t*)(a->ws + WS_H); const bf16_t* LO = (const bf16_t*)(a->ws + WS_LO);
    float* Lc = (float*)(a->ws + WS_AP); float* Mc = Lc + (size_t)16 * NCH * 4096;
    const size_t sidx = ((size_t)bh * NCH + c) * 4096 + (size_t)(ib * 4) * 64 + jb * 16;
    const int tok0 = b * SEQ + c * TCH;
    const float* mu = a->in[21] + (size_t)e * 1792;
    const float mu_k = mu[512 + cj], mu_v = mu[1024 + cj], kkc = a->in[27][e * 512 + cj], kac = a->in[28][e * 512 + cj];
    const float w0c = a->in[22][e * 512 + cj], a0c = a->in[24][e * 512 + cj];
    f32x2 S[4][8];
#pragma unroll
    for (int r = 0; r < 4; ++r)
#pragma unroll
        for (int q = 0; q < 8; ++q) { const int row = ib * 4 + r, col = jb * 16 + 2 * q; S[r][q][0] = (MODE == 1 && row == col) ? 1.f : 0.f; S[r][q][1] = (MODE == 1 && row == col + 1) ? 1.f : 0.f; }
    unsigned short rw[5][4];
#define RW1_LOAD(T0) do { _Pragma("unroll") for (int s = 0; s < 5; ++s) { const int tk = tok0 + (T0) + MODE * 4 + s - 1; const bf16_t* hp = H + (size_t)tk * 2816 + cj; const bf16_t* lp = LO + (size_t)tk * 1536 + cj; \
        if (s == 0) { const bool have = (c > 0) || ((T0) + MODE * 4 > 0); rw[0][0] = have ? hp[512] : (unsigned short)0; rw[0][1] = have ? hp[1024] : (unsigned short)0; } \
        else { rw[s][0] = hp[512]; rw[s][1] = hp[1024]; rw[s][2] = lp[0]; rw[s][3] = lp[512]; } } } while (0)
    RW1_LOAD(0);
    for (int t0 = 0; t0 < TCH; t0 += 8) {
        float pk = bf2f(rw[0][0]), pv = bf2f(rw[0][1]);
#pragma unroll
        for (int u = 0; u < 4; ++u) { const int s = MODE * 4 + u;
            const float kr = bf2f(rw[u + 1][0]), vr = bf2f(rw[u + 1][1]), ee = __expf(-softplusf_(-(w0c + bf2f(rw[u + 1][2]))) - 0.5f), aa = sigmoidf_(a0c + bf2f(rw[u + 1][3]));
            const float kl = kr + mu_k * (pk - kr), vl = vr + mu_v * (pv - vr); pk = kr; pv = vr;
            const float kkj = kl * kkc, ss = wsum_fast(kkj * kkj), kn = kkj * rsqrtf(fmaxf(ss, 1e-24f));
            const float kp = kl * (1.0f + (aa - 1.0f) * kac), dec = __expf(-ee);
            LAS float* base = pl + s * RW_STEP;
            base[lane] = -kn; base[64 + lane] = dec; base[128 + lane] = kn * aa; base[192 + lane] = kp; base[320 + lane] = vl; }
        if (t0 + 8 < TCH) RW1_LOAD(t0 + 8);
        __syncthreads();
#pragma unroll 2
        for (int s = 0; s < 8; ++s) { const LAS float* base = pl + s * RW_STEP;
            f32x2 av[8], dc[8], bv[8], kp[8]; f32x4 vr4 = {0.f, 0.f, 0.f, 0.f};
            LD8P(av, base + jb * 16); LD8P(dc, base + 64 + jb * 16); LD8P(bv, base + 128 + jb * 16);
            if (MODE == 0) { LD8P(kp, base + 192 + jb * 16); vr4 = *(const LAS f32x4*)(base + 320 + ib * 4); }
            float sa[4];
#pragma unroll
            for (int r = 0; r < 4; ++r) { f32x2 pp = S[r][0] * av[0];
#pragma unroll
                for (int q = 1; q < 8; ++q) pp += S[r][q] * av[q];
                sa[r] = red4(pp[0] + pp[1]); }
#pragma unroll
            for (int r = 0; r < 4; ++r) { const f32x2 sa2 = (f32x2){sa[r], sa[r]};
                if (MODE == 1) {
#pragma unroll
                    for (int q = 0; q < 8; ++q) S[r][q] = S[r][q] * dc[q] + sa2 * bv[q];
                } else { const f32x2 v2 = (f32x2){vr4[r], vr4[r]};
#pragma unroll
                    for (int q = 0; q < 8; ++q) S[r][q] = S[r][q] * dc[q] + (sa2 * bv[q] + v2 * kp[q]); } } }
        __syncthreads();
    }
#undef RW1_LOAD
    float* dst = (MODE == 0 ? Lc : Mc) + sidx;
#pragma unroll
    for (int r = 0; r < 4; ++r)
#pragma unroll
        for (int q = 0; q < 4; ++q) { f32x4 t; t[0] = S[r][2 * q][0]; t[1] = S[r][2 * q][1]; t[2] = S[r][2 * q + 1][0]; t[3] = S[r][2 * q + 1][1]; *(f32x4*)(dst + r * 64 + 4 * q) = t; }
}
#define LD4P(dst, ptr) do { const f32x4 _t0 = *(const LAS f32x4*)(ptr), _t1 = *(const LAS f32x4*)((ptr) + 4); dst[0] = (f32x2){_t0[0], _t0[1]}; dst[1] = (f32x2){_t0[2], _t0[3]}; dst[2] = (f32x2){_t1[0], _t1[1]}; dst[3] = (f32x2){_t1[2], _t1[3]}; } while (0)
constexpr int RW_PAIR = RW_WAVE + 1024;
__device__ __forceinline__ void rwkv_pass2_pair(CArgsP a, int e, int bh, int c, int hf, LAS float* pl) {
    const int lane = otid() & 63, b = bh >> 3, h = bh & 7, cj = h * 64 + lane, ib = lane >> 3, jb = lane & 7;
    const bf16_t* H = (const bf16_t*)(a->ws + WS_H); const bf16_t* LO = (const bf16_t*)(a->ws + WS_LO); bf16_t* CONCAT = (bf16_t*)(a->ws + WS_XB);
    const float* Ss = (const float*)(a->ws + WS_AP) + (size_t)2 * 16 * NCH * 4096;
    const size_t sidx = ((size_t)bh * NCH + c) * 4096 + (size_t)(hf * 32 + ib * 4) * 64 + jb * 8;
    const int tok0 = b * SEQ + c * TCH;
    const float* mu = a->in[21] + (size_t)e * 1792;
    const float mu_r = mu[cj], mu_k = mu[512 + cj], mu_v = mu[1024 + cj], kkc = a->in[27][e * 512 + cj], kac = a->in[28][e * 512 + cj], rkc = a->in[29][e * 512 + cj];
    const float gng = a->in[30][e * 512 + cj], gnb = a->in[31][e * 512 + cj];
    const float w0c = a->in[22][e * 512 + cj], a0c = a->in[24][e * 512 + cj];
    LAS float* yb = pl + RW_WAVE;
    f32x2 S[4][4];
#pragma unroll
    for (int r = 0; r < 4; ++r) { const f32x4 t0 = *(const f32x4*)(Ss + sidx + r * 64), t1 = *(const f32x4*)(Ss + sidx + r * 64 + 4);
        S[r][0] = (f32x2){t0[0], t0[1]}; S[r][1] = (f32x2){t0[2], t0[3]}; S[r][2] = (f32x2){t1[0], t1[1]}; S[r][3] = (f32x2){t1[2], t1[3]}; }
    unsigned short rw[5][6];
#define RW2_LOAD(T0) do { _Pragma("unroll") for (int s = 0; s < 5; ++s) { const int tk = tok0 + (T0) + hf * 4 + s - 1; const bool ok = ((tk & (SEQ - 1)) != SEQ - 1) || s > 0 || true; \
        const bf16_t* hp = H + (size_t)tk * 2816 + cj; const bf16_t* lp = LO + (size_t)tk * 1536 + cj; (void)ok; \
        if (s == 0) { const bool have = (c > 0) || ((T0) + hf * 4 > 0); rw[0][0] = have ? hp[0] : (unsigned short)0; rw[0][1] = have ? hp[512] : (unsigned short)0; rw[0][2] = have ? hp[1024] : (unsigned short)0; } \
        else { rw[s][0] = hp[0]; rw[s][1] = hp[512]; rw[s][2] = hp[1024]; rw[s][3] = lp[0]; rw[s][4] = lp[512]; rw[s][5] = lp[1024]; } } } while (0)
    RW2_LOAD(0);
    for (int t0 = 0; t0 < TCH; t0 += 8) {
        float pr = bf2f(rw[0][0]), pk = bf2f(rw[0][1]), pv = bf2f(rw[0][2]);
#pragma unroll
        for (int u = 0; u < 4; ++u) { const int s = hf * 4 + u;
            const float rr = bf2f(rw[u + 1][0]), kr = bf2f(rw[u + 1][1]), vr = bf2f(rw[u + 1][2]), ee = __expf(-softplusf_(-(w0c + bf2f(rw[u + 1][3]))) - 0.5f), aa = sigmoidf_(a0c + bf2f(rw[u + 1][4]));
            const float rl = rr + mu_r * (pr - rr), kl = kr + mu_k * (pk - kr), vl = vr + mu_v * (pv - vr); pr = rr; pk = kr; pv = vr;
            const float kkj = kl * kkc, ss = wsum_fast(kkj * kkj), kn = kkj * rsqrtf(fmaxf(ss, 1e-24f));
            const float kp = kl * (1.0f + (aa - 1.0f) * kac), dec = __expf(-ee);
            LAS float* base = pl + s * RW_STEP;
            base[lane] = -kn; base[64 + lane] = dec; base[128 + lane] = kn * aa; base[192 + lane] = kp; base[256 + lane] = rl; base[320 + lane] = vl; base[384 + lane] = bf2f(rw[u + 1][5]);
            const float bd = wsum_fast(rl * kp * rkc); if (lane == 0) pl[8 * RW_STEP + s] = bd; }
        if (t0 + 8 < TCH) RW2_LOAD(t0 + 8);
        __syncthreads();
#pragma unroll 2
        for (int s = 0; s < 8; ++s) { const LAS float* base = pl + s * RW_STEP;
            f32x2 av[4], dc[4], bv[4], kp[4], rv[4];
            LD4P(av, base + jb * 8); LD4P(dc, base + 64 + jb * 8); LD4P(bv, base + 128 + jb * 8); LD4P(kp, base + 192 + jb * 8); LD4P(rv, base + 256 + jb * 8);
            const f32x4 v4 = *(const LAS f32x4*)(base + 320 + hf * 32 + ib * 4);
            float sa[4];
#pragma unroll
            for (int r = 0; r < 4; ++r) { f32x2 pp = S[r][0] * av[0]; pp += S[r][1] * av[1]; pp += S[r][2] * av[2]; pp += S[r][3] * av[3]; sa[r] = red8(pp[0] + pp[1]); }
            float ysel = 0.f;
#pragma unroll
            for (int r = 0; r < 4; ++r) { const f32x2 sa2 = (f32x2){sa[r], sa[r]}, v2 = (f32x2){v4[r], v4[r]};
#pragma unroll
                for (int q = 0; q < 4; ++q) S[r][q] = S[r][q] * dc[q] + (sa2 * bv[q] + v2 * kp[q]);
                f32x2 pp = S[r][0] * rv[0]; pp += S[r][1] * rv[1]; pp += S[r][2] * rv[2]; pp += S[r][3] * rv[3]; const float yr = red8(pp[0] + pp[1]); ysel = (jb == r) ? yr : ysel; }
            if (jb < 4) yb[s * 64 + hf * 32 + ib * 4 + jb] = ysel; }
        __syncthreads();
#pragma unroll
        for (int u = 0; u < 4; ++u) { const int s = hf * 4 + u; const LAS float* base = pl + s * RW_STEP; const float y = yb[s * 64 + lane], vi = base[320 + lane];
            const float mean = wsum_fast(y) * (1.f / 64.f), ey2 = wsum_fast(y * y) * (1.f / 64.f), dl = y - mean, var = fmaxf(ey2 - mean * mean, 0.f);
            const float yn = dl * rsqrtf(var + 64e-5f) * gng + gnb;
            const float o = (yn + pl[8 * RW_STEP + s] * vi) * base[384 + lane];
            CONCAT[(size_t)(tok0 + t0 + s) * 1024 + cj] = f2bf(o); }
        __syncthreads();
    }
#undef RW2_LOAD
}
__device__ __forceinline__ void rwkv_combine(CArgsP a, int blk, unsigned char* shm) {
    float* Lc = (float*)(a->ws + WS_AP); float* Mc = Lc + (size_t)16 * NCH * 4096; float* Ss = Mc + (size_t)16 * NCH * 4096;
    LAS float* Sc = (LAS float*)shm; LAS float* Mb = Sc + 512;
    const int tid = otid(), bh = blk >> 3, rg = blk & 7, r = tid >> 6, j = tid & 63;
    const size_t mbase = (size_t)bh * NCH * 4096, rowoff = (size_t)(rg * 8 + r) * 64 + j;
    float cur = 0.f;
    f32x4 mn0 = *(const f32x4*)(Mc + mbase + tid * 8), mn1 = *(const f32x4*)(Mc + mbase + tid * 8 + 4); float ln = Lc[mbase + rowoff];
    for (int c = 0; c < NCH; ++c) {
        Ss[mbase + (size_t)c * 4096 + rowoff] = cur;
        Sc[r * 64 + j] = cur; *(LAS f32x4*)(Mb + tid * 8) = mn0; *(LAS f32x4*)(Mb + tid * 8 + 4) = mn1;
        float acc = ln;
        __syncthreads();
        if (c + 1 < NCH) { const size_t nb = mbase + (size_t)(c + 1) * 4096; mn0 = *(const f32x4*)(Mc + nb + tid * 8); mn1 = *(const f32x4*)(Mc + nb + tid * 8 + 4); ln = Lc[nb + rowoff]; }
#pragma unroll
        for (int k = 0; k < 64; k += 4) { const f32x4 s4 = *(const LAS f32x4*)(Sc + r * 64 + k);
            acc += s4[0] * Mb[k * 64 + j]; acc += s4[1] * Mb[(k + 1) * 64 + j]; acc += s4[2] * Mb[(k + 2) * 64 + j]; acc += s4[3] * Mb[(k + 3) * 64 + j]; }
        cur = acc;
        __syncthreads();
    }
}
__device__ __forceinline__ void lru_pass_a(CArgsP a, int gtid, int nth) {
    const bf16_t* LGA = (const bf16_t*)(a->ws + WS_LA); const bf16_t* BX = LGA + (size_t)NTOK * 512; float2* PE = (float2*)(a->ws + WS_MISC + 3 * MiB);
    for (int it = gtid; it < 2 * NLCH * 512; it += nth) { const int ch = it & 511, cc = (it >> 9) & (NLCH - 1), b = it >> 16; const size_t base = ((size_t)b * SEQ + (size_t)cc * LCH) * 512 + ch;
        float P = 1.f, E = 0.f;
#pragma unroll 32
        for (int t = 0; t < LCH; ++t) { const float av = __expf(bf2f(LGA[base + (size_t)t * 512])), bx = bf2f(BX[base + (size_t)t * 512]); P *= av; E = av * E + bx; }
        PE[it] = make_float2(P, E); }
}
__device__ __forceinline__ void lru_pass_c2(CArgsP a, int gtid, int nth) {
    const unsigned* LGA = (const unsigned*)(a->ws + WS_LA); const unsigned* BX = LGA + (size_t)NTOK * 256; const f32x4* PE = (const f32x4*)(a->ws + WS_MISC + 3 * MiB);
    const unsigned* H = (const unsigned*)(a->ws + WS_H); unsigned* CONCAT = (unsigned*)(a->ws + WS_XB);
    for (int it = gtid; it < 2 * NLCH * 256; it += nth) { const int chp = it & 255, cc = (it >> 8) & (NLCH - 1), b = it >> 15; const size_t tokb = (size_t)b * SEQ + (size_t)cc * LCH;
        float h0 = 0.f, h1 = 0.f;
#pragma unroll 8
        for (int c2 = 0; c2 < cc; ++c2) { const f32x4 pe = PE[(b << 15) + (c2 << 8) + chp]; h0 = pe[0] * h0 + pe[1]; h1 = pe[2] * h1 + pe[3]; }
        const unsigned* lp = LGA + tokb * 256 + chp; const unsigned* bp = BX + tokb * 256 + chp; const unsigned* gp = H + tokb * 1408 + 896 + chp; unsigned* op = CONCAT + tokb * 512 + 256 + chp;
#pragma unroll 1
        for (int tb = 0; tb < LCH; tb += 8) { unsigned la[8], bx[8], gt[8];
#pragma unroll
            for (int u = 0; u < 8; ++u) { la[u] = lp[(tb + u) * 256]; bx[u] = bp[(tb + u) * 256]; gt[u] = gp[(size_t)(tb + u) * 1408]; }
#pragma unroll
            for (int u = 0; u < 8; ++u) {
                h0 = __expf(__uint_as_float(la[u] << 16)) * h0 + __uint_as_float(bx[u] << 16); h1 = __expf(__uint_as_float(la[u] & 0xffff0000u)) * h1 + __uint_as_float(bx[u] & 0xffff0000u);
                op[(tb + u) * 512] = pk2(h0 * geluf_(__uint_as_float(gt[u] << 16)), h1 * geluf_(__uint_as_float(gt[u] & 0xffff0000u))); } } }
}
__device__ __forceinline__ void lru_carry(CArgsP a, int gtid) {
    if (gtid >= 1024) return;
    const float2* PE = (const float2*)(a->ws + WS_MISC + 3 * MiB); float* CY = (float*)(a->ws + WS_MR + 512 * 1024);
    const int b = gtid >> 9, ch = gtid & 511; float hsv = 0.f;
#pragma unroll 16
    for (int cc = 0; cc < NLCH; ++cc) { const int idx = (b << 16) + (cc << 9) + ch; const float2 pe = PE[idx]; CY[idx] = hsv; hsv = pe.x * hsv + pe.y; }
}
__device__ __forceinline__ void lru_pass_c(CArgsP a, int gtid, int nth) {
    const bf16_t* LGA = (const bf16_t*)(a->ws + WS_LA); const bf16_t* BX = LGA + (size_t)NTOK * 512; const float2* PE = (const float2*)(a->ws + WS_MISC + 3 * MiB);
    const bf16_t* H = (const bf16_t*)(a->ws + WS_H); bf16_t* CONCAT = (bf16_t*)(a->ws + WS_XB);
    for (int it = gtid; it < 2 * NLCH * 512; it += nth) { const int ch = it & 511, cc = (it >> 9) & (NLCH - 1), b = it >> 16; const size_t tokb = (size_t)b * SEQ + (size_t)cc * LCH;
        float hsv = ((const float*)(a->ws + WS_MR + 512 * 1024))[it];
#pragma unroll 8
        for (int t = 0; t < LCH; ++t) { const size_t tok = tokb + t; const float av = __expf(bf2f(LGA[tok * 512 + ch])), bx = bf2f(BX[tok * 512 + ch]); hsv = av * hsv + bx;
            const float gt = bf2f(H[tok * 2816 + 1792 + ch]);
            CONCAT[tok * 1024 + 512 + ch] = f2bf(hsv * geluf_(gt)); } }
}
#ifndef REP_FFN
#define REP_FFN 1
#endif
#ifndef REP_P1
#define REP_P1 1
#endif
#ifndef REP_CB
#define REP_CB 1
#endif
#ifndef REP_P2
#define REP_P2 1
#endif
#ifndef REP_OPRE
#define REP_OPRE 1
#endif
#ifndef REP_AE
#define REP_AE 1
#endif
#ifndef REP_AT
#define REP_AT 1
#endif
#ifndef REP_LN
#define REP_LN 1
#endif
#ifndef REP_IN
#define REP_IN 1
#endif
#ifndef REP_CV
#define REP_CV 1
#endif
#ifndef REP_LC
#define REP_LC 1
#endif
#ifndef REP_R2
#define REP_R2 1
#endif
#ifndef REP_SYNC
#define REP_SYNC 0
#endif
#ifdef SKIP_E
#define SK_E(x)
#else
#define SK_E(x) x
#endif
#ifdef SKIP_O
#define SK_O(x)
#else
#define SK_O(x) x
#endif
#ifdef SKIP_S
#define SK_S(x)
#else
#define SK_S(x) x
#endif
#ifdef SKIP_A
#define SK_A(x)
#else
#define SK_A(x) x
#endif
__global__ __launch_bounds__(512, 2) void mega_fwd(Args a_unused) {
    extern __shared__ __attribute__((aligned(16))) unsigned char shm[];
    cg::grid_group grid = cg::this_grid();
#define a argp()
#define ws (a->ws)
#define P_W ((bf16_t*)(ws + WS_W))
#define P_XB ((bf16_t*)(ws + WS_XB))
#define P_H ((bf16_t*)(ws + WS_H))
#define P_LO ((bf16_t*)(ws + WS_LO))
#define P_AP ((bf16_t*)(ws + WS_AP))
#define P_XC ((bf16_t*)(ws + WS_XC))
#define P_LGA ((bf16_t*)(ws + WS_LA))
#define P_BX (P_LGA + (size_t)NTOK * 512)
#define P_Kb ((bf16_t*)(ws + WS_MISC))
#define P_VT ((bf16_t*)(ws + WS_MISC + MiB))
#define P_MEMB ((bf16_t*)(ws + WS_MISC + 2 * MiB))
#define P_Qb P_H
#define P_Ob (P_H + (size_t)NTOK * DM)
    volatile LAS unsigned* xst = (volatile LAS unsigned*)(shm + LDS_BYTES - 16);
    if (otid() == 0) { xst[0] = 0u; xst[1] = 0u; }
    __syncthreads();
    const XcdBarrier xb = xcd_barrier_post((unsigned*)(ws + WS_BAR), xst);
    prologue_cast(a); convert_layer(a, 0, shm); grid.sync();
#define GSYNC() xcd_barrier(xb)
    for (int ls = 0; ls < 16; ++ls) {
        const int l = ls >> 2, st = ls & 3, e = l >> 1, odd = l & 1;
        const bf16_t* A2; const bf16_t* W2; int K2; float scale2;
        if (st == 0 || st == 3) {
            EpiSwiGLU E; E.O = P_H;
            for (int rep = 0; rep < REP_FFN; ++rep) { run_gemm(shm, P_XB, P_W + (st == 0 ? W_FF1IN : W_FF2IN), NTOK, 5632, 1024, E); GSYNC(); }
            A2 = P_H; W2 = P_W + (st == 0 ? W_FF1OUT : W_FF2OUT); K2 = 2816; scale2 = 0.5f;
        } else {
            EpiBf16g E; int N; const bf16_t* Win; E.O = P_H;
            if (st == 1) { Win = P_W + W_MIXIN; E.scale = 1.0f; if (odd) { N = 2816; E.ldc = 2816; E.gelu_from = 1000; } else { N = 1536; E.ldc = 1536; E.gelu_from = 2; } }
            else { Win = P_W + W_Q; N = 1024; E.ldc = 1024; E.gelu_from = 1000; E.scale = 0.0625f; }
            for (int rep = 0; rep < REP_IN; ++rep) { run_gemm(shm, P_XB, Win, NTOK, N, 1024, E); if (rep + 1 < REP_IN) GSYNC(); }
            GSYNC();
            if (st == 1) {
                if (!odd) {
                    for (int rep = 0; rep < REP_AE; ++rep) { SK_E(even_core(a, e, shm);) GSYNC(); }
                    EpiPool EP; EP.O = P_XB; EP.scl = a->in[14] + (size_t)e * 512;
                    run_gemm(shm, P_LO, P_W + W_AUX1, NTOK, 512, 512, EP); GSYNC();
                } else {
                    for (int rep = 0; rep < REP_OPRE; ++rep) {
                        SK_O(odd_prep(a, e);) GSYNC();
                        { EpiBf16g EL; EL.O = P_LO; EL.ldc = 1536; EL.gelu_from = 1000; EL.scale = 1.0f; run_gemm(shm, P_AP, P_W + W_AUX1, NTOK, 1536, 256, EL); }
                        { EpiLru ER; ER.XC = P_XC; ER.b_a = a->in[35] + (size_t)e * 512; ER.b_x = a->in[37] + (size_t)e * 512; ER.lam = a->in[38] + (size_t)e * 512; ER.LGA = P_LGA; ER.BX = P_BX;
                          run_gemm(shm, P_XC, P_W + W_AUX2, NTOK, 1024, 512, ER); }
                        GSYNC();
                    }
                    for (int rep = 0; rep < REP_P1; ++rep) {
                        const int wave = otid() >> 6; LAS float* pl = (LAS float*)shm + (wave >> 1) * RW_PAIR;
                        for (int it0 = blockIdx.x * 4; it0 < 16 * NCH; it0 += gridDim.x * 4) { const int item = it0 + (wave >> 1);
                            if (wave & 1) rwkv_pass1_pair<1>(a, e, item / NCH, item % NCH, pl); else rwkv_pass1_pair<0>(a, e, item / NCH, item % NCH, pl); }
                        SK_O(lru_pass_a(a, blockIdx.x * 512 + otid(), gridDim.x * 512);)
                        GSYNC();
                    }
                    for (int rep = 0; rep < REP_CB; ++rep) {
                        if (blockIdx.x < 128) { SK_O(rwkv_combine(a, blockIdx.x, shm);) }
                        else { SK_O(lru_pass_c2(a, ((int)blockIdx.x - 128) * 512 + otid(), ((int)gridDim.x - 128) * 512);) }
                        GSYNC();
                    }
                    for (int rep = 0; rep < REP_P2; ++rep) {
                        const int wave = otid() >> 6; LAS float* pl = (LAS float*)shm + (wave >> 1) * RW_PAIR;
                        for (int it0 = blockIdx.x * 4; it0 < 16 * NCH; it0 += gridDim.x * 4) { const int item = it0 + (wave >> 1); rwkv_pass2_pair(a, e, item / NCH, item % NCH, wave & 1, pl); }
                        GSYNC();
                    }
                }
                A2 = P_XB; W2 = P_W + W_MIXOUT; K2 = 1024; scale2 = 1.0f;
            } else {
                for (int rep = 0; rep < REP_AT; ++rep) { SK_A(attn_phase(P_Qb, P_Kb, P_VT, P_Ob, shm);) GSYNC(); }
                A2 = P_Ob; W2 = P_W + W_O; K2 = 1024; scale2 = 1.0f;
            }
        }
        {
            EpiResid ER; ER.res = (const h16*)a->out; ER.out = (h16*)a->out; ER.MR = (const float*)(ws + WS_MR); ER.first = (ls == 0);
            ER.g = a->in[6] + (size_t)(ls > 0 ? ls - 1 : 0) * DM; ER.b = a->in[7] + (size_t)(ls > 0 ? ls - 1 : 0) * DM; ER.scale = scale2; run_gemm(shm, A2, W2, NTOK, 1024, K2, ER); }
        GSYNC();
        for (int rep = 0; rep < REP_SYNC; ++rep) GSYNC();
        if (st == 1) {
            if (blockIdx.x < 16) { EpiKV EK; EK.Kb = P_Kb; EK.VT = P_VT; run_gemm(shm, P_MEMB, P_W + W_KV, 512, 2048, 1024, EK, 16, (int)blockIdx.x); }
            else ln_phase(a->out, nullptr, P_XB, (float*)(ws + WS_MR), a->in[6] + (size_t)ls * DM, a->in[7] + (size_t)ls * DM, 16, (int)gridDim.x - 16);
        } else if (ls < 15) { for (int rep = 0; rep < REP_LN; ++rep) { ln_phase(a->out, nullptr, P_XB, (float*)(ws + WS_MR), a->in[6] + (size_t)ls * DM, a->in[7] + (size_t)ls * DM, 0, (int)gridDim.x); if (rep + 1 < REP_LN) GSYNC(); }
            if (st == 3) for (int rep = 0; rep < REP_CV; ++rep) { convert_layer(a, l + 1, shm); if (rep + 1 < REP_CV) GSYNC(); } }
        else { h16x8 zr[16][2]; ln_final_load((const h16*)a->out, zr); GSYNC(); ln_final_store(zr, a->out, a->in[6] + (size_t)ls * DM, a->in[7] + (size_t)ls * DM); }
        GSYNC();
    }
}

#undef a
#undef ws
#undef P_W
#undef P_XB
#undef P_H
#undef P_LO
#undef P_AP
#undef P_XC
#undef P_LGA
#undef P_BX
#undef P_Kb
#undef P_VT
#undef P_MEMB
#undef P_Qb
#undef P_Ob
extern "C" void kernel_launch(void* const* d_in, const int* in_sizes, int n_in, void* d_out, int out_size, void* d_ws, size_t ws_size, hipStream_t stream) {
    static int grid = 0;
    if (grid == 0) {
        if (n_in != 39 || out_size != NTOK * DM || ws_size < WS_END) { fprintf(stderr, "kernel_launch: unexpected shapes (n_in %d out %d ws %zu need %zu)\n", n_in, out_size, ws_size, (size_t)WS_END); grid = -1; return; }
        int dev = 0, cus = 0, per_cu = 0;
        hipGetDevice(&dev); hipDeviceGetAttribute(&cus, hipDeviceAttributeMultiprocessorCount, dev);
        if (hipFuncSetAttribute((const void*)mega_fwd, hipFuncAttributeMaxDynamicSharedMemorySize, LDS_BYTES) != hipSuccess) { fprintf(stderr, "kernel_launch: hipFuncSetAttribute failed\n"); }
        if (hipOccupancyMaxActiveBlocksPerMultiprocessor(&per_cu, (const void*)mega_fwd, 512, LDS_BYTES) != hipSuccess || per_cu < 1) { fprintf(stderr, "kernel_launch: occupancy query says %d\n", per_cu); per_cu = 1; }
        (void)hipGetLastError();
        grid = cus > 0 ? cus : 256;
    }
    if (grid < 0) return;
    if (hipMemsetAsync((char*)d_ws + WS_BAR, 0, 16384, stream) != hipSuccess) { fprintf(stderr, "kernel_launch: memset failed\n"); return; }
    Args a{};
    for (int i = 0; i < 39; ++i) a.in[i] = (const float*)d_in[i];
    a.out = (float*)d_out; a.ws = (unsigned char*)d_ws;
    void* args[] = {&a};
    hipError_t e = hipLaunchCooperativeKernel((const void*)mega_fwd, dim3(grid), dim3(512), args, LDS_BYTES, stream);
    if (e != hipSuccess) fprintf(stderr, "cooperative launch failed: %s (grid %d)\n", hipGetErrorString(e), grid);
}
```

```cpp
#include <hip/hip_runtime.h>
#include <hip/hip_cooperative_groups.h>
#include <cstdio>
namespace cg = cooperative_groups;
namespace pg8 {
#define PG8_LAS __attribute__((address_space(3)))
typedef unsigned short bf16_t;
typedef short bf16x8 __attribute__((ext_vector_type(8)));
typedef float f32x4 __attribute__((ext_vector_type(4)));
typedef unsigned u32x4 __attribute__((ext_vector_type(4)));
typedef unsigned u32x2 __attribute__((ext_vector_type(2)));
constexpr int BM = 256, BK = 64, HALF = 128, HTB = HALF * BK * 2  , STAGE_BYTES = 8 * HTB, NXCD = 8, WGM = 8;

__host__ __device__ __forceinline__ int lds_byte(int r, int c) { const int st = (r >> 4) * 2 + (c >> 5), rr = r & 15, cc = c & 31, ob = rr * 64 + cc * 2; return st * 1024 + (ob ^ (((ob >> 9) & 1) << 5)); }
__host__ __device__ __forceinline__ void stage_rc(int b, int& R, int& C) { const int st = b / 1024, sb = b % 1024, swz = sb ^ (((sb >> 9) & 1) << 5); R = (st >> 1) * 16 + swz / 64; C = (st & 1) * 32 + (swz % 64) / 2; }
__host__ __device__ __forceinline__ int perm32(int rho) { const int n = rho >> 4, i = rho & 15; return 8 * (i >> 2) + 4 * n + (i & 3); }

struct Unit { int pm, pn; };
struct Gemm { const bf16_t* A; const bf16_t* Bt; int M, N, K; };

struct StaticOrder {
    int nM, nN, nwg, G, c;
    __host__ __device__ void init(int M, int N, int G_, int c_) { nM = M / BM; nN = N / BM; nwg = nM * nN; G = G_; c = c_; }
    __host__ __device__ bool next(int i, Unit& u) const {
        const long L = (long)i * G + c; if (L >= nwg) return false;
        int wgid = (int)L; { const int q = nwg / NXCD, r = nwg % NXCD, xcd = wgid % NXCD, off = wgid / NXCD; wgid = (xcd < r ? xcd * (q + 1) : r * (q + 1) + (xcd - r) * q) + off; }
        const int nig = WGM * nN, gid = wgid / nig, fm = gid * WGM, gsz = (nM - fm) < WGM ? (nM - fm) : WGM;
        u.pm = fm + ((wgid % nig) % gsz); u.pn = (wgid % nig) / gsz; return true;
    }
    __device__ __forceinline__ void a_ready(const Unit&) const {}
    __device__ __forceinline__ void done(const Unit&) const {}
};
__device__ __forceinline__ unsigned cvt_pk_bf16(float lo, float hi) { unsigned r; asm volatile("v_cvt_pk_bf16_f32 %0, %1, %2" : "=v"(r) : "v"(lo), "v"(hi)); return r; }

template <class Epi, class Sched>
__device__ __forceinline__ void gemm_phase(PG8_LAS unsigned char* lds, const Gemm g, const Sched& S, const Epi& E) {
    int tid_ = threadIdx.x; asm volatile("" : "+v"(tid_));
    const int tid = tid_, wid = __builtin_amdgcn_readfirstlane(tid >> 6), lane = tid & 63, wr = wid >> 2, wc = wid & 3, fr = lane & 15, fq = lane >> 4;
    const int K = g.K, nt = K / BK;
    unsigned voffA[2], voffB[2];
#pragma unroll
    for (int i = 0; i < 2; ++i) { int R, C; stage_rc(tid * 16 + i * 8192, R, C); const int Rb = Epi::PERM ? ((R & ~31) + perm32(R & 31)) : R;
        voffA[i] = (unsigned)(R * K + C) * 2u; voffB[i] = (unsigned)(Rb * K + C) * 2u; }
    const size_t kstep = (size_t)(BK * 2);
    const size_t hstep = (size_t)HALF * K * 2;
    const size_t tstep = 2 * hstep;
    const unsigned ldsw = (unsigned)wid * 1024u;
    const int aoff = lds_byte(wr * 64 + fr, fq * 8), boff = lds_byte(wc * 32 + fr, fq * 8);
#define PG8_SA(b, h) (((b) * 2 + (h)) * HTB)
#define PG8_SB(b, h) ((4 + (b) * 2 + (h)) * HTB)
#define PG8_STAGE(bufoff, gbase, voff) do { _Pragma("unroll") for (int _i = 0; _i < 2; ++_i) \
        __builtin_amdgcn_global_load_lds((const unsigned*)((const char*)(gbase) + (voff)[_i]), (PG8_LAS unsigned*)(lds + (bufoff) + ldsw + _i * 8192), 16, 0, 0); } while (0)
#define PG8_LDA(dst, b, h) do { _Pragma("unroll") for (int m = 0; m < 4; ++m) _Pragma("unroll") for (int k = 0; k < 2; ++k) dst[m][k] = *(const PG8_LAS bf16x8*)(lds + PG8_SA(b, h) + aoff + m * 2048 + k * 1024); } while (0)
#define PG8_LDB(dst, b, h) do { _Pragma("unroll") for (int n = 0; n < 2; ++n) _Pragma("unroll") for (int k = 0; k < 2; ++k) dst[n][k] = *(const PG8_LAS bf16x8*)(lds + PG8_SB(b, h) + boff + n * 2048 + k * 1024); } while (0)
#define PG8_MMA(ai, bj, At, Bt) do { __builtin_amdgcn_s_setprio(1); _Pragma("unroll") for (int m = 0; m < 4; ++m) _Pragma("unroll") for (int n = 0; n < 2; ++n) _Pragma("unroll") for (int k = 0; k < 2; ++k) \
        acc[ai][bj][m][n] = __builtin_amdgcn_mfma_f32_16x16x32_bf16(Bt[n][k], At[m][k], acc[ai][bj][m][n], 0, 0, 0); __builtin_amdgcn_s_setprio(0); } while (0)
#define PG8_WAIT_V(n) asm volatile("s_waitcnt vmcnt(" #n ")" ::: "memory")
#define PG8_WAIT_L(n) asm volatile("s_waitcnt lgkmcnt(" #n ")" ::: "memory")
#define PG8_BAR __builtin_amdgcn_s_barrier()
#define PG8_SCHED __builtin_amdgcn_sched_barrier(0)
    Unit cur, nxt; int ui = 0;
    if (!S.next(0, cur)) return;
    f32x4 acc[2][2][4][2];
#pragma unroll
    for (int a = 0; a < 2; ++a)
#pragma unroll
        for (int b = 0; b < 2; ++b)
#pragma unroll
            for (int m = 0; m < 4; ++m)
#pragma unroll
                for (int n = 0; n < 2; ++n) acc[a][b][m][n] = (f32x4){0.f, 0.f, 0.f, 0.f};
    bf16x8 At[4][2], B0[2][2], B1[2][2];
    const char* cA = (const char*)g.A + (size_t)cur.pm * tstep; const char* cB = (const char*)g.Bt + (size_t)cur.pn * tstep;
    S.a_ready(cur);
    PG8_STAGE(PG8_SB(0, 0), cB, voffB); PG8_STAGE(PG8_SA(0, 0), cA, voffA); PG8_STAGE(PG8_SB(0, 1), cB + hstep, voffB); PG8_STAGE(PG8_SA(0, 1), cA + hstep, voffA);
    if (wr == 1) PG8_BAR;
    PG8_WAIT_V(4); PG8_BAR;
    PG8_STAGE(PG8_SB(1, 0), cB + kstep, voffB); PG8_STAGE(PG8_SA(1, 0), cA + kstep, voffA); PG8_STAGE(PG8_SB(1, 1), cB + hstep + kstep, voffB);
    PG8_WAIT_V(6); PG8_BAR;
    for (;;) {
        const bool has_next = S.next(ui + 1, nxt);
        const char* nA = has_next ? (const char*)g.A + (size_t)nxt.pm * tstep : cA; const char* nB = has_next ? (const char*)g.Bt + (size_t)nxt.pn * tstep : cB;
        for (int t = 0; t < nt; t += 2) {
            const bool last = (t == nt - 2);
            const char* a1 = cA + (size_t)(t + 1) * kstep;
            const char* a2 = last ? nA : cA + (size_t)(t + 2) * kstep; const char* b2 = last ? nB : cB + (size_t)(t + 2) * kstep;
            const char* a3 = a2 + kstep; const char* b3 = b2 + kstep;
            if (last && has_next) S.a_ready(nxt);
            PG8_LDB(B0, 0, 0); PG8_SCHED; PG8_LDA(At, 0, 0); PG8_STAGE(PG8_SA(1, 1), a1 + hstep, voffA);
            PG8_WAIT_L(8); PG8_BAR; PG8_WAIT_L(0); PG8_MMA(0, 0, At, B0); PG8_BAR; PG8_SCHED;
            PG8_LDB(B1, 0, 1); PG8_STAGE(PG8_SB(0, 0), b2, voffB);
            PG8_BAR; PG8_WAIT_L(0); PG8_MMA(0, 1, At, B1); PG8_BAR;
            PG8_LDA(At, 0, 1); PG8_STAGE(PG8_SA(0, 0), a2, voffA);
            PG8_BAR; PG8_WAIT_L(0); PG8_MMA(1, 0, At, B0); PG8_BAR; PG8_SCHED;
            PG8_STAGE(PG8_SB(0, 1), b2 + hstep, voffB);
            PG8_WAIT_V(6); PG8_BAR; PG8_MMA(1, 1, At, B1); PG8_BAR;
            PG8_LDB(B0, 1, 0); PG8_SCHED; PG8_LDA(At, 1, 0); PG8_STAGE(PG8_SA(0, 1), a2 + hstep, voffA);
            PG8_WAIT_L(8); PG8_BAR; PG8_WAIT_L(0); PG8_MMA(0, 0, At, B0); PG8_BAR; PG8_SCHED;
            PG8_LDB(B1, 1, 1); PG8_STAGE(PG8_SB(1, 0), b3, voffB);
            PG8_BAR; PG8_WAIT_L(0); PG8_MMA(0, 1, At, B1); PG8_BAR;
            PG8_LDA(At, 1, 1); PG8_STAGE(PG8_SA(1, 0), a3, voffA);
            PG8_BAR; PG8_WAIT_L(0); PG8_MMA(1, 0, At, B0); PG8_BAR; PG8_SCHED;
            PG8_STAGE(PG8_SB(1, 1), b3 + hstep, voffB);
            PG8_WAIT_V(6); PG8_BAR; PG8_MMA(1, 1, At, B1); PG8_BAR;
        }
        if constexpr (!Epi::AFTER_DRAIN) { E(acc, cur, wr, wc, fr, fq); S.done(cur); }
        if (!has_next) break;
#pragma unroll
        for (int a = 0; a < 2; ++a)
#pragma unroll
            for (int b = 0; b < 2; ++b)
#pragma unroll
                for (int m = 0; m < 4; ++m)
#pragma unroll
                    for (int n = 0; n < 2; ++n) acc[a][b][m][n] = (f32x4){0.f, 0.f, 0.f, 0.f};
        cur = nxt; cA = nA; cB = nB; ++ui;
    }
    PG8_WAIT_V(0);
    if (wr == 0) PG8_BAR;
    PG8_BAR;
    if constexpr (Epi::AFTER_DRAIN) { E.fused(acc, cur, wr, wc, fr, fq, lds, wid, lane); S.done(cur); }
#undef PG8_SA
#undef PG8_SB
#undef PG8_STAGE
#undef PG8_LDA
#undef PG8_LDB
#undef PG8_MMA
#undef PG8_WAIT_V
#undef PG8_WAIT_L
#undef PG8_BAR
#undef PG8_SCHED
}
}

using pg8::bf16_t; using pg8::bf16x8; using pg8::f32x4; using pg8::u32x4; using pg8::u32x2;
#define LAS __attribute__((address_space(3)))
constexpr int NTOK = 32768, SEQ = 16384, DM = 1024, FF = 2816;
constexpr int NCH = 64;
constexpr int TCH = SEQ / NCH;
constexpr int LCH = 128;
constexpr int NLCH = SEQ / LCH;
constexpr float ALPHA = 1.681792830507429f;
constexpr int LDS_BYTES = 136 * 1024;

constexpr size_t MiB = 1024 * 1024;
constexpr size_t E_FFIN = (size_t)5632 * 1024, E_FFOUT = (size_t)1024 * 2816, E_SQ = (size_t)1024 * 1024, E_KV = (size_t)2048 * 1024, E_MIXIN = (size_t)2816 * 1024;
constexpr size_t W_FF1IN = 0, W_FF1OUT = W_FF1IN + E_FFIN, W_FF2IN = W_FF1OUT + E_FFOUT, W_FF2OUT = W_FF2IN + E_FFIN, W_Q = W_FF2OUT + E_FFOUT, W_KV = W_Q + E_SQ, W_O = W_KV + E_KV,
                 W_MIXIN = W_O + E_SQ, W_MIXOUT = W_MIXIN + E_MIXIN, W_AUX1 = W_MIXOUT + E_SQ, W_AUX2 = W_AUX1 + (size_t)1536 * 256, W_END = W_AUX2 + (size_t)1024 * 512;
constexpr size_t WS_W = 0;
constexpr size_t WS_XB = 52 * MiB;
constexpr size_t WS_H = WS_XB + 64 * MiB;
constexpr size_t WS_LO = WS_H + 176 * MiB;
constexpr size_t WS_AP = WS_LO + 96 * MiB;
constexpr size_t WS_XC = WS_AP + 16 * MiB;
constexpr size_t WS_LA = WS_XC + 32 * MiB;
constexpr size_t WS_MISC = WS_LA + 64 * MiB;
constexpr size_t WS_BAR = WS_MISC + 4 * MiB;
constexpr size_t WS_MR = WS_BAR + 1 * MiB;
constexpr size_t WS_END = WS_MR + 1 * MiB;
static_assert(W_END * 2 <= 52 * MiB, "weights");
static_assert(WS_END <= 512 * MiB, "workspace");

struct Args { const float* in[39]; float* out; unsigned char* ws; };
typedef const __attribute__((address_space(4))) Args* CArgsP;
__device__ __forceinline__ CArgsP argp() { CArgsP p = (CArgsP)__builtin_amdgcn_kernarg_segment_ptr(); asm volatile("" : "+s"(p)); return p; }

__device__ __forceinline__ float bf2f(unsigned short b) { return __uint_as_float(((unsigned)b) << 16); }
__device__ __forceinline__ float bfs2f(short b) { return __uint_as_float(((unsigned)(unsigned short)b) << 16); }
__device__ __forceinline__ unsigned short f2bf(float f) { unsigned u = __float_as_uint(f); u += 0x7FFFu + ((u >> 16) & 1u); return (unsigned short)(u >> 16); }
__device__ __forceinline__ unsigned pk2(float lo, float hi) { return pg8::cvt_pk_bf16(lo, hi); }
__device__ __forceinline__ float sigmoidf_(float x) { return __builtin_amdgcn_rcpf(1.0f + __expf(-x)); }
__device__ __forceinline__ float siluf_(float x) { return x * sigmoidf_(x); }
__device__ __forceinline__ float tanhf_(float y) { return 1.0f - 2.0f * __builtin_amdgcn_rcpf(1.0f + __expf(2.0f * y)); }
__device__ __forceinline__ float geluf_(float x) { return 0.5f * x * (1.0f + tanhf_(0.7978845608028654f * (x + 0.044715f * x * x * x))); }
__device__ __forceinline__ float softplusf_(float x) { return fmaxf(x, 0.0f) + __logf(1.0f + __expf(-fabsf(x))); }
__device__ __forceinline__ float wave_sum(float v) {
#pragma unroll
    for (int o = 1; o < 64; o <<= 1) v += __shfl_xor(v, o);
    return v;
}
__device__ __forceinline__ int otid() { int t = threadIdx.x; asm volatile("" : "+v"(t)); return t; }
#define LDS_SYNC_WAVE() asm volatile("s_waitcnt lgkmcnt(0)" ::: "memory")

typedef const f32x4 (&AccRef)[2][2][4][2];
struct EpiSwiGLU { static constexpr bool PERM = true, AFTER_DRAIN = false; bf16_t* O;
    __device__ __forceinline__ void operator()(AccRef acc, const pg8::Unit& u, int wr, int wc, int fr, int fq) const {
        const int row0 = u.pm * 256 + wr * 64 + fr, col0 = u.pn * 128 + wc * 32 + 8 * fq;
#pragma unroll
        for (int ai = 0; ai < 2; ++ai)
#pragma unroll
            for (int m = 0; m < 4; ++m) { bf16_t* rowp = O + (size_t)(row0 + ai * 128 + m * 16) * FF + col0;
                const f32x4 g0 = acc[ai][0][m][0], g1 = acc[ai][0][m][1], u0 = acc[ai][1][m][0], u1 = acc[ai][1][m][1];
                u32x4 o; o.x = pk2(siluf_(g0[0]) * u0[0], siluf_(g0[1]) * u0[1]); o.y = pk2(siluf_(g0[2]) * u0[2], siluf_(g0[3]) * u0[3]);
                o.z = pk2(siluf_(g1[0]) * u1[0], siluf_(g1[1]) * u1[1]); o.w = pk2(siluf_(g1[2]) * u1[2], siluf_(g1[3]) * u1[3]);
                *(u32x4*)rowp = o; __builtin_amdgcn_sched_barrier(0); }
    } };
typedef _Float16 h16; typedef h16 h16x4 __attribute__((ext_vector_type(4))); typedef h16 h16x8 __attribute__((ext_vector_type(8)));
struct EpiResid { static constexpr bool PERM = false, AFTER_DRAIN = false; const h16* res; h16* out; const float* MR; const float* g; const float* b; float scale; int first;
    __device__ __forceinline__ void operator()(AccRef acc, const pg8::Unit& u, int wr, int wc, int fr, int fq) const {
        const int row0 = u.pm * 256 + wr * 64 + fr, col0 = u.pn * 256 + wc * 32 + 4 * fq;
        f32x4 g4[2][2], b4[2][2];
#pragma unroll
        for (int bj = 0; bj < 2; ++bj)
#pragma unroll
            for (int n = 0; n < 2; ++n) { if (first) { g4[bj][n] = (f32x4){1.f, 1.f, 1.f, 1.f}; b4[bj][n] = (f32x4){0.f, 0.f, 0.f, 0.f}; } else { g4[bj][n] = *(const f32x4*)(g + col0 + bj * 128 + n * 16); b4[bj][n] = *(const f32x4*)(b + col0 + bj * 128 + n * 16); } }
#pragma unroll
        for (int ai = 0; ai < 2; ++ai)
#pragma unroll
        for (int mh = 0; mh < 4; mh += 2) {
            float mean[2], rstd[2]; h16x4 rr[2][2][2];
#pragma unroll
            for (int mm = 0; mm < 2; ++mm) { const int row = row0 + ai * 128 + (mh + mm) * 16; const size_t off = (size_t)row * DM + col0; mean[mm] = MR[2 * row]; rstd[mm] = MR[2 * row + 1];
#pragma unroll
                for (int bj = 0; bj < 2; ++bj)
#pragma unroll
                    for (int n = 0; n < 2; ++n) rr[mm][bj][n] = *(const h16x4*)(res + off + bj * 128 + n * 16); }
#pragma unroll
            for (int mm = 0; mm < 2; ++mm) { const int m = mh + mm, row = row0 + ai * 128 + m * 16; const size_t off = (size_t)row * DM + col0;
#pragma unroll
                for (int bj = 0; bj < 2; ++bj)
#pragma unroll
                    for (int n = 0; n < 2; ++n) { const f32x4 r = __builtin_convertvector(rr[mm][bj][n], f32x4);
                        const f32x4 x = (r - mean[mm]) * rstd[mm] * g4[bj][n] + b4[bj][n], z = x * ALPHA + acc[ai][bj][m][n] * scale;
                        *(h16x4*)(out + off + bj * 128 + n * 16) = __builtin_convertvector(z, h16x4); } } }
    } };
struct EpiBf16g { static constexpr bool PERM = true, AFTER_DRAIN = false; bf16_t* O; int ldc; int gelu_from; float scale;
    __device__ __forceinline__ void operator()(AccRef acc, const pg8::Unit& u, int wr, int wc, int fr, int fq) const {
        const int row0 = u.pm * 256 + wr * 64 + fr, col0 = u.pn * 256 + wc * 32 + 8 * fq; const bool dog = u.pn >= gelu_from;
#pragma unroll
        for (int ai = 0; ai < 2; ++ai)
#pragma unroll
            for (int m = 0; m < 4; ++m) { bf16_t* rowp = O + (size_t)(row0 + ai * 128 + m * 16) * ldc + col0;
#pragma unroll
                for (int bj = 0; bj < 2; ++bj) { f32x4 v0 = acc[ai][bj][m][0] * scale, v1 = acc[ai][bj][m][1] * scale;
                    if (dog) {
#pragma unroll
                        for (int e = 0; e < 4; ++e) { v0[e] = geluf_(v0[e]); v1[e] = geluf_(v1[e]); } }
                    u32x4 o; o.x = pk2(v0[0], v0[1]); o.y = pk2(v0[2], v0[3]); o.z = pk2(v1[0], v1[1]); o.w = pk2(v1[2], v1[3]);
                    *(u32x4*)(rowp + bj * 128) = o; } }
    } };
struct EpiKV { static constexpr bool PERM = false, AFTER_DRAIN = false; bf16_t* Kb; bf16_t* VT;
    __device__ __forceinline__ void operator()(AccRef acc, const pg8::Unit& u, int wr, int wc, int fr, int fq) const {
        const int row0 = u.pm * 256 + wr * 64 + fr, col0 = u.pn * 256 + wc * 32 + 4 * fq;
#pragma unroll
        for (int ai = 0; ai < 2; ++ai)
#pragma unroll
            for (int m = 0; m < 4; ++m) { const int row = row0 + ai * 128 + m * 16;
#pragma unroll
                for (int bj = 0; bj < 2; ++bj)
#pragma unroll
                    for (int n = 0; n < 2; ++n) { const int col = col0 + bj * 128 + n * 16; const f32x4 v = acc[ai][bj][m][n];
                        if (u.pn < 4) { u32x2 o; o.x = pk2(v[0], v[1]); o.y = pk2(v[2], v[3]); *(u32x2*)(Kb + (size_t)row * 1024 + col) = o; }
                        else { const int cc = col - 1024, hh = cc >> 8, d = cc & 255, b = row >> 8, mm = row & 255;
#pragma unroll
                            for (int e = 0; e < 4; ++e) VT[(size_t)((b * 4 + hh) * 256 + d + e) * 256 + mm] = f2bf(v[e]); } } }
    } };
struct EpiLru { static constexpr bool PERM = true, AFTER_DRAIN = false; const bf16_t* XC; const float* b_a; const float* b_x; const float* lam; bf16_t* LGA; bf16_t* BX;
    __device__ __forceinline__ void operator()(AccRef acc, const pg8::Unit& u, int wr, int wc, int fr, int fq) const {
        const int row0 = u.pm * 256 + wr * 64 + fr, ch0 = u.pn * 128 + wc * 32 + 8 * fq;
#pragma unroll
        for (int n = 0; n < 2; ++n) { float sp[4]; const f32x4 lm = *(const f32x4*)(lam + ch0 + 4 * n), ba = *(const f32x4*)(b_a + ch0 + 4 * n), bx_ = *(const f32x4*)(b_x + ch0 + 4 * n);
#pragma unroll
            for (int e = 0; e < 4; ++e) sp[e] = -8.0f * softplusf_(-lm[e]);
            u32x2 xrr[2][4];
#pragma unroll
            for (int ai = 0; ai < 2; ++ai)
#pragma unroll
                for (int m = 0; m < 4; ++m) xrr[ai][m] = *(const u32x2*)(XC + (size_t)(row0 + ai * 128 + m * 16) * 512 + ch0 + 4 * n);
#pragma unroll
            for (int ai = 0; ai < 2; ++ai)
#pragma unroll
                for (int m = 0; m < 4; ++m) { const size_t off = (size_t)(row0 + ai * 128 + m * 16) * 512 + ch0 + 4 * n;
                    const u32x2 xr = xrr[ai][m]; float xc[4] = {__uint_as_float(xr.x << 16), __uint_as_float(xr.x & 0xffff0000u), __uint_as_float(xr.y << 16), __uint_as_float(xr.y & 0xffff0000u)};
                    float la[4], bb[4];
#pragma unroll
                    for (int e = 0; e < 4; ++e) { const float rec = sigmoidf_(acc[ai][0][m][n][e] + ba[e]), inp = sigmoidf_(acc[ai][1][m][n][e] + bx_[e]);
                        const float lg = sp[e] * rec; la[e] = lg; bb[e] = sqrtf(fmaxf(1.0f - __expf(2.0f * lg), 0.0f)) * (inp * xc[e]); }
                    u32x2 o; o.x = pk2(la[0], la[1]); o.y = pk2(la[2], la[3]); *(u32x2*)(LGA + off) = o;
                    o.x = pk2(bb[0], bb[1]); o.y = pk2(bb[2], bb[3]); *(u32x2*)(BX + off) = o; } }
    } };
struct EpiPool { static constexpr bool PERM = true, AFTER_DRAIN = false; bf16_t* O; const float* scl;
    __device__ __forceinline__ void operator()(AccRef acc, const pg8::Unit& u, int wr, int wc, int fr, int fq) const {
        const int row0 = u.pm * 256 + wr * 64 + fr, col0 = u.pn * 256 + wc * 32 + 8 * fq;
        float sc[2][8];
#pragma unroll
        for (int bj = 0; bj < 2; ++bj)
#pragma unroll
            for (int e = 0; e < 8; ++e) sc[bj][e] = scl[col0 + bj * 128 + e];
#pragma unroll
        for (int ai = 0; ai < 2; ++ai)
#pragma unroll
            for (int m = 0; m < 4; ++m) { bf16_t* rowp = O + (size_t)(row0 + ai * 128 + m * 16) * 1024 + col0;
#pragma unroll
                for (int bj = 0; bj < 2; ++bj) { float v[8];
#pragma unroll
                    for (int e = 0; e < 8; ++e) v[e] = acc[ai][bj][m][e >> 2][e & 3] * sc[bj][e];
                    u32x4 o; o.x = pk2(v[0], v[1]); o.y = pk2(v[2], v[3]); o.z = pk2(v[4], v[5]); o.w = pk2(v[6], v[7]);
                    *(u32x4*)(rowp + bj * 128) = o; } }
    } };

template <class Epi> __device__ __forceinline__ void run_gemm(unsigned char* shm, const bf16_t* A, const bf16_t* Bt, int M, int N, int K, const Epi& E, int G = 0, int c = -1) {
    pg8::Gemm g; g.A = A; g.Bt = Bt; g.M = M; g.N = N; g.K = K;
    pg8::StaticOrder S; S.init(M, N, G > 0 ? G : (int)gridDim.x, c >= 0 ? c : (int)blockIdx.x);
    pg8::gemm_phase<Epi, pg8::StaticOrder>((PG8_LAS unsigned char*)shm, g, S, E);
}

template <int MODE> __device__ __forceinline__ int rowmap(int n) {
    if (MODE == 0) return n;
    const int up = n >= FF, i = up ? n - FF : n; return (i >> 7) * 256 + up * 128 + (i & 127);
}
template <int MODE> __device__ __forceinline__ void conv_tile(const float* src, int K, int N, bf16_t* dst, int tile, float* tb) {
    const int tid = otid(), ntn = N >> 6, k0 = (tile / ntn) << 6, n0 = (tile % ntn) << 6;
#pragma unroll
    for (int i = 0; i < 8; ++i) { const int kk = i * 8 + (tid >> 6), nn = tid & 63; tb[kk * 65 + nn] = src[(size_t)(k0 + kk) * N + n0 + nn]; }
    __syncthreads();
#pragma unroll
    for (int i = 0; i < 4; ++i) { const int nn = i * 16 + (tid >> 5), kk = 2 * (tid & 31);
        *(unsigned*)(dst + (size_t)rowmap<MODE>(n0 + nn) * K + k0 + kk) = pk2(tb[kk * 65 + nn], tb[(kk + 1) * 65 + nn]); }
    __syncthreads();
}

#define XB_TMO      128
#define XB_XCNT(j)  (256  + 64 * (j))
#define XB_XSUB(j)  (1280 + 64 * (j))
#define XB_XGEN(j)  (2304 + 64 * (j))
#define XB_TOP      3328
#define XB_TOPGEN   3392
#define XCD_BAR_WORDS 3456
#define XB_SPIN_CAP (1u << 18)

__device__ __forceinline__ unsigned xb_ld(unsigned* p)              { return __hip_atomic_load(p, __ATOMIC_RELAXED, __HIP_MEMORY_SCOPE_AGENT); }
__device__ __forceinline__ unsigned xb_add(unsigned* p, unsigned v) { return __hip_atomic_fetch_add(p, v, __ATOMIC_RELAXED, __HIP_MEMORY_SCOPE_AGENT); }
__device__ __forceinline__ unsigned xb_xcc_id() { return (unsigned)__builtin_amdgcn_s_getreg((3 << 11) | 20) & 0xFu; }
#define XB_SPIN(cond, bar) do { unsigned _sp = 0; while (cond) { __builtin_amdgcn_s_sleep(1); \
    if ((++_sp & 255u) == 0u) { if (xb_ld(&(bar)[XB_TMO])) break; if (_sp > XB_SPIN_CAP) { atomicAdd(&(bar)[XB_TMO], 1u); break; } } } } while (0)

struct XcdBarrier {
    unsigned* bar; unsigned x;
    volatile LAS unsigned* st;
};

__device__ __forceinline__ XcdBarrier xcd_barrier_post(unsigned* bar, volatile LAS unsigned* st) {
    XcdBarrier b; b.bar = bar; b.x = xb_xcc_id(); b.st = st;
    if (otid() == 0) (void)xb_add(&bar[XB_XCNT(b.x)], 1u);
    return b;
}
__device__ __forceinline__ void xcd_barrier_complete(unsigned* bar, unsigned x, unsigned& nloc, unsigned& nx) {
    const unsigned G = gridDim.x * gridDim.y * gridDim.z;
    unsigned sum, cnt, mine, sp = 0u;
    for (;;) {
        sum = 0u; cnt = 0u; mine = 0u;
#pragma unroll
        for (unsigned j = 0; j < 16; ++j) { const unsigned c = xb_ld(&bar[XB_XCNT(j)]); sum += c; cnt += (c > 0u) ? 1u : 0u; mine = (j == x) ? c : mine; }
        if (sum == G) break;
        __builtin_amdgcn_s_sleep(1);
        if ((++sp & 255u) == 0u) { if (xb_ld(&bar[XB_TMO])) break; if (sp > XB_SPIN_CAP) { atomicAdd(&bar[XB_TMO], 1u); break; } }
    }
    nloc = mine > 0u ? mine : 1u; nx = cnt > 0u ? cnt : 1u;
}

__device__ __forceinline__ void xcd_barrier(const XcdBarrier& b) {
    asm volatile("s_waitcnt vmcnt(0)" ::: "memory");
    __syncthreads();
    if (otid() == 0) {
        unsigned* bar = b.bar;
        __builtin_amdgcn_s_waitcnt(0);
        unsigned nloc = b.st[0], nx = b.st[1];
        if (nloc == 0u) { xcd_barrier_complete(bar, b.x, nloc, nx); b.st[0] = nloc; b.st[1] = nx; }
        const unsigned old = xb_add(&bar[XB_XSUB(b.x)], 1u);
        const unsigned gen = old / nloc;
        if (old + 1u == (gen + 1u) * nloc) {
            __builtin_amdgcn_fence(__ATOMIC_RELEASE, "agent");
            asm volatile("s_waitcnt vmcnt(0)" ::: "memory");
            const unsigned og = xb_add(&bar[XB_TOP], 1u);
            const unsigned tg = og / nx;
            if (og + 1u == (tg + 1u) * nx) xb_add(&bar[XB_TOPGEN], 1u);
            else XB_SPIN(xb_ld(&bar[XB_TOPGEN]) == tg, bar);
            __builtin_amdgcn_fence(__ATOMIC_ACQUIRE, "agent");
            xb_add(&bar[XB_XGEN(b.x)], 1u);
            asm volatile("s_waitcnt vmcnt(0)" ::: "memory");
        } else {
            XB_SPIN(xb_ld(&bar[XB_XGEN(b.x)]) == gen, bar);
            __builtin_amdgcn_fence(__ATOMIC_ACQUIRE, "agent");
            asm volatile("s_waitcnt vmcnt(0)" ::: "memory");
        }
    }
    __syncthreads();
}

struct CvDesc { const float* src; bf16_t* dst; int K, N, mode, tile; };
__device__ __forceinline__ bool cv_decode(CArgsP a, int l, int it, CvDesc& d) {
    bf16_t* W = (bf16_t*)(a->ws + WS_W); const int e = l >> 1, odd = l & 1;
    constexpr int T_FFIN = 8 * 88, T_FFOUT = 22 * 16, T_SQ = 128, T_KV = 8 * 32;
    const int T_MIXIN = odd ? 8 * 44 : 8 * 24;
    int r = it; d.mode = 0;
    if (r < T_FFIN) { d.src = a->in[2] + (size_t)l * 1024 * 5632; d.K = 1024; d.N = 5632; d.dst = W + W_FF1IN; d.mode = 1; d.tile = r; return true; } r -= T_FFIN;
    if (r < T_FFIN) { d.src = a->in[4] + (size_t)l * 1024 * 5632; d.K = 1024; d.N = 5632; d.dst = W + W_FF2IN; d.mode = 1; d.tile = r; return true; } r -= T_FFIN;
    if (r < T_FFOUT) { d.src = a->in[3] + (size_t)l * 2816 * 1024; d.K = 2816; d.N = 1024; d.dst = W + W_FF1OUT; d.tile = r; return true; } r -= T_FFOUT;
    if (r < T_FFOUT) { d.src = a->in[5] + (size_t)l * 2816 * 1024; d.K = 2816; d.N = 1024; d.dst = W + W_FF2OUT; d.tile = r; return true; } r -= T_FFOUT;
    if (r < T_SQ) { d.src = a->in[8] + (size_t)l * 1024 * 1024; d.K = 1024; d.N = 1024; d.dst = W + W_Q; d.tile = r; return true; } r -= T_SQ;
    if (r < T_KV) { d.src = a->in[9] + (size_t)l * 1024 * 2048; d.K = 1024; d.N = 2048; d.dst = W + W_KV; d.tile = r; return true; } r -= T_KV;
    if (r < T_SQ) { d.src = a->in[10] + (size_t)l * 1024 * 1024; d.K = 1024; d.N = 1024; d.dst = W + W_O; d.tile = r; return true; } r -= T_SQ;
    if (r < T_SQ) { d.src = (odd ? a->in[20] : a->in[12]) + (size_t)e * 1024 * 1024; d.K = 1024; d.N = 1024; d.dst = W + W_MIXOUT; d.tile = r; return true; } r -= T_SQ;
    if (r < T_MIXIN) { d.K = 1024; d.dst = W + W_MIXIN; d.tile = r; if (odd) { d.src = a->in[19] + (size_t)e * 1024 * 2816; d.N = 2816; } else { d.src = a->in[11] + (size_t)e * 1024 * 1536; d.N = 1536; } return true; }
    return false;
}
__device__ __forceinline__ void cv_load(const CvDesc& d, int tid, float (&v)[16]) {
    const int ntn = d.N >> 6, k0 = (d.tile / ntn) << 7, n0 = (d.tile % ntn) << 6;
#pragma unroll
    for (int i = 0; i < 16; ++i) v[i] = d.src[(size_t)(k0 + i * 8 + (tid >> 6)) * d.N + n0 + (tid & 63)];
}
__device__ __forceinline__ void convert_layer(CArgsP a, int l, unsigned char* shm) {
    float* tb = (float*)shm; bf16_t* W = (bf16_t*)(a->ws + WS_W);
    const int e = l >> 1, odd = l & 1, tid = otid();
    {
        CvDesc d, nx; float v[16]; int it = blockIdx.x; bool have = cv_decode(a, l, it, d);
        if (have) cv_load(d, tid, v);
        while (have) {
#pragma unroll
            for (int i = 0; i < 16; ++i) tb[(i * 8 + (tid >> 6)) * 65 + (tid & 63)] = v[i];
            __syncthreads();
            it += gridDim.x; const bool hn = cv_decode(a, l, it, nx);
            if (hn) cv_load(nx, tid, v);
            const int ntn = d.N >> 6, k0 = (d.tile / ntn) << 7, n0 = (d.tile % ntn) << 6;
#pragma unroll
            for (int i = 0; i < 8; ++i) { const int nn = i * 8 + (tid >> 6), kk = 2 * (tid & 63), n = n0 + nn; const int row = d.mode ? rowmap<1>(n) : n;
                *(unsigned*)(d.dst + (size_t)row * d.K + k0 + kk) = pk2(tb[kk * 65 + nn], tb[(kk + 1) * 65 + nn]); }
            __syncthreads();
            d = nx; have = hn;
        }
    }
    const int gtid = blockIdx.x * 512 + otid(), nth = gridDim.x * 512;
    if (!odd) {
        const float* pw = a->in[13] + (size_t)e * 4 * 128 * 128;
        for (int idx = gtid; idx < 512 * 512; idx += nth) { const int n = idx >> 9, k = idx & 511, g = n >> 7, d = n & 127, g2 = k >> 7, c = k & 127;
            W[W_AUX1 + idx] = (g == g2) ? f2bf(pw[(g * 128 + c) * 128 + d]) : (bf16_t)0; }
    } else {
        const float* wup = a->in[23] + (size_t)e * 64 * 512; const float* aup = a->in[25] + (size_t)e * 64 * 512; const float* gup = a->in[26] + (size_t)e * 128 * 512;
        for (int idx = gtid; idx < 1536 * 256; idx += nth) { const int n = idx >> 8, k = idx & 255, kind = n >> 9, j = n & 511; float v = 0.f;
            if (kind == 0) { if (k < 64) v = wup[k * 512 + j]; } else if (kind == 1) { if (k >= 64 && k < 128) v = aup[(k - 64) * 512 + j]; } else { if (k >= 128) v = gup[(k - 128) * 512 + j]; }
            W[W_AUX1 + idx] = f2bf(v); }
        const float* wa = a->in[34] + (size_t)e * 8 * 64 * 64; const float* wx = a->in[36] + (size_t)e * 8 * 64 * 64;
        for (int idx = gtid; idx < 1024 * 512; idx += nth) { const int n = idx >> 9, k = idx & 511, pn = n >> 8, bj = (n >> 7) & 1, cc = n & 127, ch = pn * 128 + cc, hb = ch >> 6, jj = ch & 63; float v = 0.f;
            if ((k >> 6) == hb) v = (bj ? wx : wa)[(hb * 64 + (k & 63)) * 64 + jj];
            W[W_AUX2 + idx] = f2bf(v); }
    }
}
__device__ __forceinline__ void prologue_cast(CArgsP a) {
    const int gtid = blockIdx.x * 512 + otid(), nth = gridDim.x * 512;
    const f32x4* x4 = (const f32x4*)a->in[0]; u32x2* xb = (u32x2*)(a->ws + WS_XB);
    for (int i0 = gtid; i0 < NTOK * DM / 4; i0 += nth * 8) { f32x4 v[8];
#pragma unroll
        for (int u = 0; u < 8; ++u) { const int i = i0 + u * nth; v[u] = (i < NTOK * DM / 4) ? x4[i] : (f32x4){0.f, 0.f, 0.f, 0.f}; }
#pragma unroll
        for (int u = 0; u < 8; ++u) { const int i = i0 + u * nth; if (i < NTOK * DM / 4) { u32x2 o; o.x = pk2(v[u][0], v[u][1]); o.y = pk2(v[u][2], v[u][3]); xb[i] = o; ((h16x4*)a->out)[i] = __builtin_convertvector(v[u], h16x4); } } }
    { float* MR = (float*)(a->ws + WS_MR); for (int i = gtid; i < NTOK; i += nth) { MR[2 * i] = 0.f; MR[2 * i + 1] = 1.f; } }
    const f32x4* m4 = (const f32x4*)a->in[1]; u32x2* mb = (u32x2*)(a->ws + WS_MISC + 2 * MiB);
    for (int i = gtid; i < 512 * DM / 4; i += nth) { const f32x4 v = m4[i]; u32x2 o; o.x = pk2(v[0], v[1]); o.y = pk2(v[2], v[3]); mb[i] = o; }
}
#define DPP_F(v, ctrl) __builtin_bit_cast(float, __builtin_amdgcn_update_dpp(0, __builtin_bit_cast(int, (v)), (ctrl), 0xF, 0xF, false))
__device__ __forceinline__ float wsum_fast(float v) {
    v += DPP_F(v, 0xB1); v += DPP_F(v, 0x4E); v += DPP_F(v, 0x141); v += DPP_F(v, 0x140);
    const int iv = __builtin_bit_cast(int, v);
    const float s0 = __builtin_bit_cast(float, __builtin_amdgcn_readlane(iv, 0)), s1 = __builtin_bit_cast(float, __builtin_amdgcn_readlane(iv, 16));
    const float s2 = __builtin_bit_cast(float, __builtin_amdgcn_readlane(iv, 32)), s3 = __builtin_bit_cast(float, __builtin_amdgcn_readlane(iv, 48));
    return (s0 + s1) + (s2 + s3);
}
__device__ __forceinline__ void ln_phase(const void* zin, float* xo, bf16_t* XB, float* MR, const float* g, const float* b, int bofs, int nblk) {
    const int lane = otid() & 63, wave = otid() >> 6;
    int row = ((int)blockIdx.x - bofs) * 8 + wave; const int rstep = nblk * 8;
    {
        f32x4 g4[2][2], b4[2][2];
#pragma unroll
        for (int j = 0; j < 2; ++j)
#pragma unroll
            for (int q = 0; q < 2; ++q) { g4[j][q] = *(const f32x4*)(g + 8 * lane + 512 * j + 4 * q); b4[j][q] = *(const f32x4*)(b + 8 * lane + 512 * j + 4 * q); }
        h16x8 nx[2];
        if (row < NTOK) {
#pragma unroll
            for (int j = 0; j < 2; ++j) nx[j] = *(const h16x8*)((const h16*)zin + (size_t)row * DM + 8 * lane + 512 * j);
        }
        for (; row < NTOK; row += rstep) {
            float v[2][8]; float s = 0.f;
#pragma unroll
            for (int j = 0; j < 2; ++j)
#pragma unroll
                for (int q = 0; q < 8; ++q) { v[j][q] = (float)nx[j][q]; s += v[j][q]; }
            if (row + rstep < NTOK) {
#pragma unroll
                for (int j = 0; j < 2; ++j) nx[j] = *(const h16x8*)((const h16*)zin + (size_t)(row + rstep) * DM + 8 * lane + 512 * j);
            }
            const float mean = wsum_fast(s) * (1.f / DM); float s2 = 0.f;
#pragma unroll
            for (int j = 0; j < 2; ++j)
#pragma unroll
                for (int q = 0; q < 8; ++q) { v[j][q] -= mean; s2 += v[j][q] * v[j][q]; }
            const float rstd = rsqrtf(wsum_fast(s2) * (1.f / DM) + 1e-5f);
            if (lane == 0) { MR[2 * row] = mean; MR[2 * row + 1] = rstd; }
#pragma unroll
            for (int j = 0; j < 2; ++j) { float y[8];
#pragma unroll
                for (int q = 0; q < 8; ++q) y[q] = v[j][q] * rstd * g4[j][q >> 2][q & 3] + b4[j][q >> 2][q & 3];
                u32x4 o; o.x = pk2(y[0], y[1]); o.y = pk2(y[2], y[3]); o.z = pk2(y[4], y[5]); o.w = pk2(y[6], y[7]);
                *(u32x4*)(XB + (size_t)row * DM + 8 * lane + 512 * j) = o; }
        }
    }
}
__device__ __forceinline__ void ln_final_load(const h16* zin, h16x8 (&zr)[16][2]) {
    const int lane = otid() & 63, wave = otid() >> 6;
#pragma unroll
    for (int i = 0; i < 16; ++i) { const int row = (int)blockIdx.x * 8 + wave + i * (int)gridDim.x * 8;
#pragma unroll
        for (int j = 0; j < 2; ++j) zr[i][j] = (row < NTOK) ? *(const h16x8*)(zin + (size_t)row * DM + 8 * lane + 512 * j) : (h16x8)(h16)0; }
}
__device__ __forceinline__ void ln_final_store(const h16x8 (&zr)[16][2], float* xo, const float* g, const float* b) {
    const int lane = otid() & 63, wave = otid() >> 6;
    f32x4 g4[2][2], b4[2][2];
#pragma unroll
    for (int j = 0; j < 2; ++j)
#pragma unroll
        for (int q = 0; q < 2; ++q) { g4[j][q] = *(const f32x4*)(g + 8 * lane + 512 * j + 4 * q); b4[j][q] = *(const f32x4*)(b + 8 * lane + 512 * j + 4 * q); }
#pragma unroll
    for (int i = 0; i < 16; ++i) { const int row = (int)blockIdx.x * 8 + wave + i * (int)gridDim.x * 8; float v[2][8]; float s = 0.f;
#pragma unroll
        for (int j = 0; j < 2; ++j)
#pragma unroll
            for (int q = 0; q < 8; ++q) { v[j][q] = (float)zr[i][j][q]; s += v[j][q]; }
        const float mean = wsum_fast(s) * (1.f / DM); float s2 = 0.f;
#pragma unroll
        for (int j = 0; j < 2; ++j)
#pragma unroll
            for (int q = 0; q < 8; ++q) { v[j][q] -= mean; s2 += v[j][q] * v[j][q]; }
        const float rstd = rsqrtf(wsum_fast(s2) * (1.f / DM) + 1e-5f);
        if (row < NTOK) {
#pragma unroll
            for (int j = 0; j < 2; ++j)
#pragma unroll
                for (int q = 0; q < 2; ++q) { f32x4 y;
#pragma unroll
                    for (int t = 0; t < 4; ++t) y[t] = v[j][4 * q + t] * rstd * g4[j][q][t] + b4[j][q][t];
                    *(f32x4*)(xo + (size_t)row * DM + 8 * lane + 512 * j + 4 * q) = y; } } }
}
constexpr int AT_LD = 528;
__device__ __forceinline__ void attn_fill(LAS unsigned char* lds, const bf16_t* src, int ld_src, int tid) {
#pragma unroll 1
    for (int hb = 0; hb < 16; hb += 8) { u32x4 t[8];
#pragma unroll
        for (int i = 0; i < 8; ++i) { const int id = (hb + i) * 512 + tid, row = id >> 5, c = id & 31; t[i] = *(const u32x4*)(src + (size_t)row * ld_src + c * 8); }
#pragma unroll
        for (int i = 0; i < 8; ++i) { const int id = (hb + i) * 512 + tid, row = id >> 5, c = id & 31; *(LAS u32x4*)(lds + row * AT_LD + c * 16) = t[i]; } }
}
__device__ __forceinline__ void attn_phase(const bf16_t* Q, const bf16_t* Kb, const bf16_t* VT, bf16_t* O, unsigned char* shm) {
    const int tid = otid(), lane = tid & 63, wave = tid >> 6, fr = lane & 15, fq = lane >> 4;
    LAS unsigned char* lds = (LAS unsigned char*)shm;
    for (int item = blockIdx.x; item < 512; item += gridDim.x) {
        const int bh = item & 7, b = bh >> 2, h = bh & 3, row0 = b * SEQ + (item >> 3) * 256 + wave * 32;
        bf16x8 qf[2][8];
#pragma unroll
        for (int t = 0; t < 2; ++t)
#pragma unroll
            for (int ks = 0; ks < 8; ++ks) qf[t][ks] = *(const bf16x8*)(Q + (size_t)(row0 + t * 16 + fr) * DM + h * 256 + ks * 32 + fq * 8);
        attn_fill(lds, Kb + (size_t)(b * 256) * DM + h * 256, DM, tid);
        __syncthreads();
        f32x4 s[2][16];
        {
            bf16x8 kf[3][2]; f32x4 a0 = {0.f, 0.f, 0.f, 0.f}, a1 = {0.f, 0.f, 0.f, 0.f};
            const LAS unsigned char* kb = lds + fr * AT_LD + fq * 16;
#pragma unroll
            for (int pg = 0; pg < 2; ++pg)
#pragma unroll
                for (int ks = 0; ks < 2; ++ks) kf[pg][ks] = *(const LAS bf16x8*)(kb + pg * 128 + ks * 64);
#pragma unroll
            for (int g = 0; g < 64; ++g) { const int mt = g >> 2, qd = g & 3;
                if (g + 2 < 64) { const int ng = g + 2; const LAS unsigned char* np = kb + (ng >> 2) * 16 * AT_LD + (ng & 3) * 128;
#pragma unroll
                    for (int ks = 0; ks < 2; ++ks) kf[ng % 3][ks] = *(const LAS bf16x8*)(np + ks * 64); }
                __builtin_amdgcn_sched_barrier(0);
#pragma unroll
                for (int ks = 0; ks < 2; ++ks) { const bf16x8 kv = kf[g % 3][ks];
                    a0 = __builtin_amdgcn_mfma_f32_16x16x32_bf16(kv, qf[0][qd * 2 + ks], a0, 0, 0, 0); a1 = __builtin_amdgcn_mfma_f32_16x16x32_bf16(kv, qf[1][qd * 2 + ks], a1, 0, 0, 0); }
                if (qd == 3) { s[0][mt] = a0; s[1][mt] = a1; a0 = (f32x4){0.f, 0.f, 0.f, 0.f}; a1 = (f32x4){0.f, 0.f, 0.f, 0.f}; }
                __builtin_amdgcn_sched_barrier(0); }
        }
        bf16x8 pb[2][8]; float inv[2];
#pragma unroll
        for (int t = 0; t < 2; ++t) { float mx = -3.0e38f;
#pragma unroll
            for (int mt = 0; mt < 16; ++mt)
#pragma unroll
                for (int q = 0; q < 4; ++q) mx = fmaxf(mx, s[t][mt][q]);
            mx = fmaxf(mx, __shfl_xor(mx, 16)); mx = fmaxf(mx, __shfl_xor(mx, 32));
            float sum = 0.f;
#pragma unroll
            for (int mt = 0; mt < 16; ++mt)
#pragma unroll
                for (int q = 0; q < 4; ++q) { const float pv = __expf(s[t][mt][q] - mx); s[t][mt][q] = pv; sum += pv; }
            sum += __shfl_xor(sum, 16); sum += __shfl_xor(sum, 32); inv[t] = 1.0f / sum;
#pragma unroll
            for (int kp = 0; kp < 8; ++kp) { u32x4 tt; tt.x = pk2(s[t][2 * kp][0], s[t][2 * kp][1]); tt.y = pk2(s[t][2 * kp][2], s[t][2 * kp][3]); tt.z = pk2(s[t][2 * kp + 1][0], s[t][2 * kp + 1][1]); tt.w = pk2(s[t][2 * kp + 1][2], s[t][2 * kp + 1][3]);
                pb[t][kp] = __builtin_bit_cast(bf16x8, tt); } }
        __syncthreads();
        attn_fill(lds, VT + (size_t)((b * 4 + h) * 256) * 256, 256, tid);
        __syncthreads();
        {
            u32x2 vA[8], vB[8]; f32x4 a0 = {0.f, 0.f, 0.f, 0.f}, a1 = {0.f, 0.f, 0.f, 0.f};
            const LAS unsigned char* vb = lds + fr * AT_LD + fq * 8;
#pragma unroll
            for (int q = 0; q < 8; ++q) vA[q] = *(const LAS u32x2*)(vb + q * 32);
#pragma unroll
            for (int g = 0; g < 32; ++g) { const int dt = g >> 1, hf = g & 1;
                if (g + 1 < 32) { const int ndt = (g + 1) >> 1, nhf = (g + 1) & 1; const LAS unsigned char* np = vb + ndt * 16 * AT_LD + nhf * 256;
#pragma unroll
                    for (int q = 0; q < 8; ++q) { if (g & 1) vA[q] = *(const LAS u32x2*)(np + q * 32); else vB[q] = *(const LAS u32x2*)(np + q * 32); } }
                __builtin_amdgcn_sched_barrier(0);
#pragma unroll
                for (int kq = 0; kq < 4; ++kq) { const u32x2 lo = (g & 1) ? vB[2 * kq] : vA[2 * kq], hi = (g & 1) ? vB[2 * kq + 1] : vA[2 * kq + 1]; u32x4 tt; tt.x = lo.x; tt.y = lo.y; tt.z = hi.x; tt.w = hi.y;
                    const bf16x8 vf = __builtin_bit_cast(bf16x8, tt);
                    a0 = __builtin_amdgcn_mfma_f32_16x16x32_bf16(vf, pb[0][hf * 4 + kq], a0, 0, 0, 0); a1 = __builtin_amdgcn_mfma_f32_16x16x32_bf16(vf, pb[1][hf * 4 + kq], a1, 0, 0, 0); }
                if (hf) { u32x2 o; o.x = pk2(a0[0] * inv[0], a0[1] * inv[0]); o.y = pk2(a0[2] * inv[0], a0[3] * inv[0]);
                    *(u32x2*)(O + (size_t)(row0 + fr) * DM + h * 256 + dt * 16 + fq * 4) = o;
                    o.x = pk2(a1[0] * inv[1], a1[1] * inv[1]); o.y = pk2(a1[2] * inv[1], a1[3] * inv[1]);
                    *(u32x2*)(O + (size_t)(row0 + 16 + fr) * DM + h * 256 + dt * 16 + fq * 4) = o;
                    a0 = (f32x4){0.f, 0.f, 0.f, 0.f}; a1 = (f32x4){0.f, 0.f, 0.f, 0.f}; }
                __builtin_amdgcn_sched_barrier(0); }
        }
        __syncthreads();
    }
}
__device__ __forceinline__ void even_core(CArgsP a, int e, unsigned char* shm) {
    const bf16_t* H = (const bf16_t*)(a->ws + WS_H); bf16_t* POOLED = (bf16_t*)(a->ws + WS_LO); bf16_t* CONCAT = (bf16_t*)(a->ws + WS_XB);
    const int tid = otid(), lane = tid & 63, wave = tid >> 6;
    LAS float* Wl = (LAS float*)shm; LAS float* Vl = Wl + 128 * 129; LAS float* st = Vl + 128 * 128;
    const float* sgw = a->in[17] + (size_t)e * 4 * 128 * 128; const float* sgb = a->in[18] + (size_t)e * 4 * 128;
    const float* lng = a->in[15] + (size_t)e * 512; const float* lnb = a->in[16] + (size_t)e * 512;
    for (int chunk = blockIdx.x; chunk < NTOK / 128; chunk += gridDim.x) {
        const int tok0 = chunk * 128, tseq0 = tok0 & (SEQ - 1);
        {
            const int c = tid, grp = c >> 7; float hist[16]; hist[0] = 0.f;
#pragma unroll
            for (int u = 1; u < 16; ++u) { const int p = u - 16; hist[u] = (tseq0 + p >= 0) ? bf2f(H[(size_t)(tok0 + p) * 1536 + c]) : 0.f; }
            for (int tb = 0; tb < 128; tb += 16) { unsigned short xs[16];
#pragma unroll
                for (int u = 0; u < 16; ++u) xs[u] = H[(size_t)(tok0 + tb + u) * 1536 + c];
#pragma unroll
                for (int u = 0; u < 16; ++u) { const int t = tb + u; const float x = bf2f(xs[u]); hist[u] = x;
                    const float s2 = x + hist[(u + 15) & 15];
                    const float s4 = s2 + hist[(u + 14) & 15] + hist[(u + 13) & 15];
                    const float s8 = s4 + (hist[(u + 12) & 15] + hist[(u + 11) & 15]) + (hist[(u + 10) & 15] + hist[(u + 9) & 15]);
                    const float s16 = s8 + ((hist[(u + 8) & 15] + hist[(u + 7) & 15]) + (hist[(u + 6) & 15] + hist[(u + 5) & 15])) + ((hist[(u + 4) & 15] + hist[(u + 3) & 15]) + (hist[(u + 2) & 15] + hist[(u + 1) & 15]));
                    const float sum = grp == 0 ? s2 : grp == 1 ? s4 : grp == 2 ? s8 : s16; const int win = 2 << grp, pos = tseq0 + t + 1;
                    const float dv = (float)(pos < win ? pos : win);
                    POOLED[(size_t)(tok0 + t) * 512 + c] = f2bf(sum / dv - x); }
            }
        }
        { bf16x8 v8a[16];
#pragma unroll
          for (int i = 0; i < 16; ++i) v8a[i] = *(const bf16x8*)(H + (size_t)(tok0 + wave + 8 * i) * 1536 + 1024 + lane * 8);
          __builtin_amdgcn_sched_barrier(0);
#pragma unroll
          for (int i = 0; i < 16; ++i) { const int t = wave + 8 * i; float f[8], s = 0.f;
#pragma unroll
            for (int q = 0; q < 8; ++q) { f[q] = bfs2f(v8a[i][q]); s += f[q]; }
            const float mean = wsum_fast(s) * (1.f / 512.f); float s2 = 0.f;
#pragma unroll
            for (int q = 0; q < 8; ++q) { const float d = f[q] - mean; s2 += d * d; }
            const float var = wsum_fast(s2) * (1.f / 512.f);
            if (lane == 0) { st[2 * t] = mean; st[2 * t + 1] = rsqrtf(var + 1e-5f); } } }
        __syncthreads();
        for (int h = 0; h < 4; ++h) {
            { f32x4 w4a[8];
#pragma unroll
              for (int it = 0; it < 8; ++it) { const int idx = it * 512 + tid, t = idx >> 5, s0 = (idx & 31) * 4; w4a[it] = *(const f32x4*)(sgw + (size_t)(h * 128 + t) * 128 + s0); }
              __builtin_amdgcn_sched_barrier(0);
#pragma unroll
              for (int it = 0; it < 8; ++it) { const int idx = it * 512 + tid, t = idx >> 5, s0 = (idx & 31) * 4;
#pragma unroll
                  for (int q = 0; q < 4; ++q) Wl[t * 129 + s0 + q] = (s0 + q <= t) ? w4a[it][q] : 0.f; } }
#pragma unroll
            for (int it = 0; it < 4; ++it) { const int idx = it * 512 + tid, s = idx >> 4, d0 = (idx & 15) * 8; const bf16x8 v8 = *(const bf16x8*)(H + (size_t)(tok0 + s) * 1536 + 1024 + h * 128 + d0);
                const float mean = st[2 * s], rstd = st[2 * s + 1];
#pragma unroll
                for (int q = 0; q < 8; ++q) Vl[s * 128 + d0 + q] = (bfs2f(v8[q]) - mean) * rstd * lng[h * 128 + d0 + q] + lnb[h * 128 + d0 + q]; }
            __syncthreads();
            const int d0 = (tid & 15) * 8, t0 = (tid >> 4) * 4;
            float acc[4][8];
#pragma unroll
            for (int i = 0; i < 4; ++i)
#pragma unroll
                for (int q = 0; q < 8; ++q) acc[i][q] = 0.f;
            for (int s = 0; s <= t0 + 3; ++s) { const f32x4 va = *(const LAS f32x4*)(Vl + s * 128 + d0), vb = *(const LAS f32x4*)(Vl + s * 128 + d0 + 4);
#pragma unroll
                for (int i = 0; i < 4; ++i) { const float w = Wl[(t0 + i) * 129 + s];
#pragma unroll
                    for (int q = 0; q < 4; ++q) { acc[i][q] += w * va[q]; acc[i][4 + q] += w * vb[q]; } } }
            bf16x8 u8a[4]; float biasa[4];
#pragma unroll
            for (int i = 0; i < 4; ++i) { u8a[i] = *(const bf16x8*)(H + (size_t)(tok0 + t0 + i) * 1536 + 512 + h * 128 + d0); biasa[i] = sgb[h * 128 + t0 + i]; }
#pragma unroll
            for (int i = 0; i < 4; ++i) { const int t = t0 + i; const float bias = biasa[i]; const bf16x8 u8 = u8a[i];
                float o[8];
#pragma unroll
                for (int q = 0; q < 8; ++q) o[q] = bfs2f(u8[q]) * (acc[i][q] + bias);
                u32x4 ov; ov.x = pk2(o[0], o[1]); ov.y = pk2(o[2], o[3]); ov.z = pk2(o[4], o[5]); ov.w = pk2(o[6], o[7]);
                *(u32x4*)(CONCAT + (size_t)(tok0 + t) * 1024 + 512 + h * 128 + d0) = ov; }
            __syncthreads();
        }
    }
}
__device__ __forceinline__ void odd_prep(CArgsP a, int e) {
    const bf16_t* H = (const bf16_t*)(a->ws + WS_H); bf16_t* AP = (bf16_t*)(a->ws + WS_AP); bf16_t* XC = (bf16_t*)(a->ws + WS_XC);
    const float* mu = a->in[21] + (size_t)e * 1792; const float* cw = a->in[32] + (size_t)e * 4 * 512; const float* cb = a->in[33] + (size_t)e * 512;
    const int gtid = blockIdx.x * 512 + otid(), nth = gridDim.x * 512;
    const bf16x8 z8 = {0, 0, 0, 0, 0, 0, 0, 0};
    float muA[8], cbX[8], cwX[4][8];
    { const int cA = (gtid & 31) * 8, cX = (gtid & 63) * 8;
#pragma unroll
      for (int q = 0; q < 8; ++q) { muA[q] = mu[1536 + cA + q]; cbX[q] = cb[cX + q];
#pragma unroll
          for (int i = 0; i < 4; ++i) cwX[i][q] = cw[i * 512 + cX + q]; } }
    for (int it0 = gtid; it0 < NTOK * 32; it0 += nth * 4) { bf16x8 cur[4], prv[4];
#pragma unroll
        for (int u = 0; u < 4; ++u) { const int it = it0 + u * nth, tok = it >> 5, c0 = (it & 31) * 8; const bool ok = it < NTOK * 32;
            cur[u] = ok ? *(const bf16x8*)(H + (size_t)tok * 2816 + 1536 + c0) : z8;
            prv[u] = (ok && (tok & (SEQ - 1))) ? *(const bf16x8*)(H + (size_t)(tok - 1) * 2816 + 1536 + c0) : z8; }
#pragma unroll
        for (int u = 0; u < 4; ++u) { const int it = it0 + u * nth, tok = it >> 5, c0 = (it & 31) * 8; if (it < NTOK * 32) { float v[8];
#pragma unroll
            for (int q = 0; q < 8; ++q) { const float c = bfs2f(cur[u][q]), z = c + muA[q] * (bfs2f(prv[u][q]) - c); v[q] = c0 < 64 ? tanhf_(z) : (c0 < 128 ? z : sigmoidf_(z)); }
            u32x4 o; o.x = pk2(v[0], v[1]); o.y = pk2(v[2], v[3]); o.z = pk2(v[4], v[5]); o.w = pk2(v[6], v[7]); *(u32x4*)(AP + (size_t)tok * 256 + c0) = o; } } }
    for (int it0 = gtid; it0 < NTOK * 64; it0 += nth * 4) { bf16x8 x8[4][4];
#pragma unroll
        for (int u = 0; u < 4; ++u) { const int it = it0 + u * nth, tok = it >> 6, c0 = (it & 63) * 8, tseq = tok & (SEQ - 1); const bool ok = it < NTOK * 64;
#pragma unroll
            for (int i = 0; i < 4; ++i) x8[u][i] = (ok && tseq - 3 + i >= 0) ? *(const bf16x8*)(H + (size_t)(tok - 3 + i) * 2816 + 2304 + c0) : z8; }
#pragma unroll
        for (int u = 0; u < 4; ++u) { const int it = it0 + u * nth, tok = it >> 6, c0 = (it & 63) * 8; if (it < NTOK * 64) { float v[8];
#pragma unroll
            for (int q = 0; q < 8; ++q) v[q] = cbX[q];
#pragma unroll
            for (int i = 0; i < 4; ++i)
#pragma unroll
                for (int q = 0; q < 8; ++q) v[q] += cwX[i][q] * bfs2f(x8[u][i][q]);
            u32x4 o; o.x = pk2(v[0], v[1]); o.y = pk2(v[2], v[3]); o.z = pk2(v[4], v[5]); o.w = pk2(v[6], v[7]); *(u32x4*)(XC + (size_t)tok * 512 + c0) = o; } } }
}
constexpr int RW_STEP = 448, RW_WAVE = 8 * RW_STEP + 8;
typedef float f32x2 __attribute__((ext_vector_type(2)));
__device__ __forceinline__ float red8(float v) {
    v += __builtin_bit_cast(float, __builtin_amdgcn_update_dpp(0, __builtin_bit_cast(int, v), 0xB1, 0xF, 0xF, false));
    v += __builtin_bit_cast(float, __builtin_amdgcn_update_dpp(0, __builtin_bit_cast(int, v), 0x4E, 0xF, 0xF, false));
    v += __builtin_bit_cast(float, __builtin_amdgcn_update_dpp(0, __builtin_bit_cast(int, v), 0x141, 0xF, 0xF, false));
    return v;
}
__device__ __forceinline__ float red4(float v) { v += DPP_F(v, 0xB1); v += DPP_F(v, 0x4E); return v; }
#define LD8P(dst, ptr) do { _Pragma("unroll") for (int _q = 0; _q < 4; ++_q) { const f32x4 _t = *(const LAS f32x4*)((ptr) + 4 * _q); dst[2 * _q] = (f32x2){_t[0], _t[1]}; dst[2 * _q + 1] = (f32x2){_t[2], _t[3]}; } } while (0)
template <int MODE> __device__ __forceinline__ void rwkv_scan(CArgsP a, int e, int bh, int c, LAS float* wl) {
    const int lane = otid() & 63, b = bh >> 3, h = bh & 7, cj = h * 64 + lane, ib = lane >> 2, jb = lane & 3;
    const bf16_t* H = (const bf16_t*)(a->ws + WS_H); const bf16_t* LO = (const bf16_t*)(a->ws + WS_LO); bf16_t* CONCAT = (bf16_t*)(a->ws + WS_XB);
    float* Lc = (float*)(a->ws + WS_AP); float* Mc = Lc + (size_t)16 * NCH * 4096; float* Ss = Mc + (size_t)16 * NCH * 4096;
    const size_t sidx = ((size_t)bh * NCH + c) * 4096 + (size_t)(ib * 4) * 64 + jb * 16;
    const int tok0 = b * SEQ + c * TCH;
    const float* mu = a->in[21] + (size_t)e * 1792;
    const float mu_r = mu[cj], mu_k = mu[512 + cj], mu_v = mu[1024 + cj], kkc = a->in[27][e * 512 + cj], kac = a->in[28][e * 512 + cj], rkc = a->in[29][e * 512 + cj];
    const float gng = a->in[30][e * 512 + cj], gnb = a->in[31][e * 512 + cj];
    const float w0c = a->in[22][e * 512 + cj], a0c = a->in[24][e * 512 + cj];
    f32x2 S[4][8];
    if (MODE == 2) {
#pragma unroll
        for (int r = 0; r < 4; ++r)
#pragma unroll
            for (int q = 0; q < 4; ++q) { const f32x4 t = *(const f32x4*)(Ss + sidx + r * 64 + 4 * q); S[r][2 * q] = (f32x2){t[0], t[1]}; S[r][2 * q + 1] = (f32x2){t[2], t[3]}; }
    } else {
#pragma unroll
        for (int r = 0; r < 4; ++r)
#pragma unroll
            for (int q = 0; q < 8; ++q) { const int row = ib * 4 + r, col = jb * 16 + 2 * q; S[r][q][0] = (MODE == 1 && row == col) ? 1.f : 0.f; S[r][q][1] = (MODE == 1 && row == col + 1) ? 1.f : 0.f; }
    }
    float pr = 0.f, pk = 0.f, pv = 0.f;
    if (c > 0) { const bf16_t* hp = H + (size_t)(tok0 - 1) * 2816 + cj; pr = bf2f(hp[0]); pk = bf2f(hp[512]); pv = bf2f(hp[1024]); }
    unsigned short rw[8][6];
#define RW_LOAD(T0) do { _Pragma("unroll") for (int s = 0; s < 8; ++s) { const size_t tok = (size_t)(tok0 + (T0) + s); const bf16_t* hp = H + tok * 2816 + cj; const bf16_t* lp = LO + tok * 1536 + cj; \
        rw[s][0] = hp[0]; rw[s][1] = hp[512]; rw[s][2] = hp[1024]; rw[s][3] = lp[0]; rw[s][4] = lp[512]; if (MODE == 2) rw[s][5] = lp[1024]; } } while (0)
    RW_LOAD(0);
    for (int t0 = 0; t0 < TCH; t0 += 8) {
#pragma unroll
        for (int s = 0; s < 8; ++s) {
            const float rr = bf2f(rw[s][0]), kr = bf2f(rw[s][1]), vr = bf2f(rw[s][2]), ee = __expf(-softplusf_(-(w0c + bf2f(rw[s][3]))) - 0.5f), aa = sigmoidf_(a0c + bf2f(rw[s][4]));
            const float rl = rr + mu_r * (pr - rr), kl = kr + mu_k * (pk - kr), vl = vr + mu_v * (pv - vr); pr = rr; pk = kr; pv = vr;
            const float kkj = kl * kkc, ss = wsum_fast(kkj * kkj), kn = kkj * rsqrtf(fmaxf(ss, 1e-24f));
            const float kp = kl * (1.0f + (aa - 1.0f) * kac), dec = __expf(-ee);
            LAS float* base = wl + s * RW_STEP;
            base[lane] = -kn; base[64 + lane] = dec; base[128 + lane] = kn * aa; base[192 + lane] = kp; base[320 + lane] = vl;
            if (MODE == 2) { base[256 + lane] = rl; base[384 + lane] = bf2f(rw[s][5]); const float bd = wsum_fast(rl * kp * rkc); if (lane == 0) wl[8 * RW_STEP + s] = bd; } }
        if (t0 + 8 < TCH) RW_LOAD(t0 + 8);
        LDS_SYNC_WAVE();
#pragma unroll 2
        for (int s = 0; s < 8; ++s) { const LAS float* base = wl + s * RW_STEP;
            f32x2 av[8], dc[8], bv[8], kp[8]; f32x4 vr4 = {0.f, 0.f, 0.f, 0.f};
            LD8P(av, base + jb * 16); LD8P(dc, base + 64 + jb * 16); LD8P(bv, base + 128 + jb * 16);
            if (MODE != 1) { LD8P(kp, base + 192 + jb * 16); vr4 = *(const LAS f32x4*)(base + 320 + ib * 4); }
            float sa[4];
#pragma unroll
            for (int r = 0; r < 4; ++r) { f32x2 p = S[r][0] * av[0];
#pragma unroll
                for (int q = 1; q < 8; ++q) p += S[r][q] * av[q];
                sa[r] = red4(p[0] + p[1]); }
#pragma unroll
            for (int r = 0; r < 4; ++r) { const f32x2 sa2 = (f32x2){sa[r], sa[r]};
                if (MODE == 1) {
#pragma unroll
                    for (int q = 0; q < 8; ++q) S[r][q] = S[r][q] * dc[q] + sa2 * bv[q];
                } else { const f32x2 v2 = (f32x2){vr4[r], vr4[r]};
#pragma unroll
                    for (int q = 0; q < 8; ++q) S[r][q] = S[r][q] * dc[q] + (sa2 * bv[q] + v2 * kp[q]); } }
            if (MODE == 2) { f32x2 rv[8]; LD8P(rv, base + 256 + jb * 16);
                float y = 0.f;
#pragma unroll
                for (int r = 0; r < 4; ++r) { f32x2 p = S[r][0] * rv[0];
#pragma unroll
                    for (int q = 1; q < 8; ++q) p += S[r][q] * rv[q];
                    const float yr = red4(p[0] + p[1]); y = (jb == r) ? yr : y; }
                const float vi = base[320 + lane];
                const float mean = wsum_fast(y) * (1.f / 64.f), ey2 = wsum_fast(y * y) * (1.f / 64.f), dl = y - mean, var = fmaxf(ey2 - mean * mean, 0.f);
                const float yn = dl * rsqrtf(var + 64e-5f) * gng + gnb;
                const float o = (yn + wl[8 * RW_STEP + s] * vi) * base[384 + lane];
                CONCAT[(size_t)(tok0 + t0 + s) * 1024 + cj] = f2bf(o); } }
        LDS_SYNC_WAVE();
    }
#undef RW_LOAD
    if (MODE != 2) { float* dst = (MODE == 0 ? Lc : Mc) + sidx;
#pragma unroll
        for (int r = 0; r < 4; ++r)
#pragma unroll
            for (int q = 0; q < 4; ++q) { f32x4 t; t[0] = S[r][2 * q][0]; t[1] = S[r][2 * q][1]; t[2] = S[r][2 * q + 1][0]; t[3] = S[r][2 * q + 1][1]; *(f32x4*)(dst + r * 64 + 4 * q) = t; } }
}
template <int MODE> __device__ __forceinline__ void rwkv_pass1_pair(CArgsP a, int e, int bh, int c, LAS float* pl) {
    const int lane = otid() & 63, b = bh >> 3, h = bh & 7, cj = h * 64 + lane, ib = lane >> 2, jb = lane & 3;
    const bf16_t* H = (const bf16_t*)(a->ws + WS_H); const bf16_t* LO = (const bf16_t*)(a->ws + WS_LO);
    float* Lc = (float*)(a->ws + WS_AP); float* Mc = Lc + (size_t)16 * NCH * 4096;
    const size_t sidx = ((size_t)bh * NCH + c) * 4096 + (size_t)(ib * 4) * 64 + jb * 16;
    const int tok0 = b * SEQ + c * TCH;
    const float* mu = a->in[21] + (size_t)e * 1792;
    const float mu_k = mu[512 + cj], mu_v = mu[1024 + cj], kkc = a->in[27][e * 512 + cj], kac = a->in[28][e * 512 + cj];
    const float w0c = a->in[22][e * 512 + cj], a0c = a->in[24][e * 512 + cj];
    f32x2 S[4][8];
#pragma unroll
    for (int r = 0; r < 4; ++r)
#pragma unroll
        for (int q = 0; q < 8; ++q) { const int row = ib * 4 + r, col = jb * 16 + 2 * q; S[r][q][0] = (MODE == 1 && row == col) ? 1.f : 0.f; S[r][q][1] = (MODE == 1 && row == col + 1) ? 1.f : 0.f; }
    unsigned short rw[5][4];
#define RW1_LOAD(T0) do { _Pragma("unroll") for (int s = 0; s < 5; ++s) { const int tk = tok0 + (T0) + MODE * 4 + s - 1; const bf16_t* hp = H + (size_t)tk * 2816 + cj; const bf16_t* lp = LO + (size_t)tk * 1536 + cj; \
        if (s == 0) { const bool have = (c > 0) || ((T0) + MODE * 4 > 0); rw[0][0] = have ? hp[512] : (unsigned short)0; rw[0][1] = have ? hp[1024] : (unsigned short)0; } \
        else { rw[s][0] = hp[512]; rw[s][1] = hp[1024]; rw[s][2] = lp[0]; rw[s][3] = lp[512]; } } } while (0)
    RW1_LOAD(0);
    for (int t0 = 0; t0 < TCH; t0 += 8) {
        float pk = bf2f(rw[0][0]), pv = bf2f(rw[0][1]);
#pragma unroll
        for (int u = 0; u < 4; ++u) { const int s = MODE * 4 + u;
            const float kr = bf2f(rw[u + 1][0]), vr = bf2f(rw[u + 1][1]), ee = __expf(-softplusf_(-(w0c + bf2f(rw[u + 1][2]))) - 0.5f), aa = sigmoidf_(a0c + bf2f(rw[u + 1][3]));
            const float kl = kr + mu_k * (pk - kr), vl = vr + mu_v * (pv - vr); pk = kr; pv = vr;
            const float kkj = kl * kkc, ss = wsum_fast(kkj * kkj), kn = kkj * rsqrtf(fmaxf(ss, 1e-24f));
            const float kp = kl * (1.0f + (aa - 1.0f) * kac), dec = __expf(-ee);
            LAS float* base = pl + s * RW_STEP;
            base[lane] = -kn; base[64 + lane] = dec; base[128 + lane] = kn * aa; base[192 + lane] = kp; base[320 + lane] = vl; }
        if (t0 + 8 < TCH) RW1_LOAD(t0 + 8);
        __syncthreads();
#pragma unroll 2
        for (int s = 0; s < 8; ++s) { const LAS float* base = pl + s * RW_STEP;
            f32x2 av[8], dc[8], bv[8], kp[8]; f32x4 vr4 = {0.f, 0.f, 0.f, 0.f};
            LD8P(av, base + jb * 16); LD8P(dc, base + 64 + jb * 16); LD8P(bv, base + 128 + jb * 16);
            if (MODE == 0) { LD8P(kp, base + 192 + jb * 16); vr4 = *(const LAS f32x4*)(base + 320 + ib * 4); }
            float sa[4];
#pragma unroll
            for (int r = 0; r < 4; ++r) { f32x2 pp = S[r][0] * av[0];
#pragma unroll
                for (int q = 1; q < 8; ++q) pp += S[r][q] * av[q];
                sa[r] = red4(pp[0] + pp[1]); }
#pragma unroll
            for (int r = 0; r < 4; ++r) { const f32x2 sa2 = (f32x2){sa[r], sa[r]};
                if (MODE == 1) {
#pragma unroll
                    for (int q = 0; q < 8; ++q) S[r][q] = S[r][q] * dc[q] + sa2 * bv[q];
                } else { const f32x2 v2 = (f32x2){vr4[r], vr4[r]};
#pragma unroll
                    for (int q = 0; q < 8; ++q) S[r][q] = S[r][q] * dc[q] + (sa2 * bv[q] + v2 * kp[q]); } } }
        __syncthreads();
    }
#undef RW1_LOAD
    float* dst = (MODE == 0 ? Lc : Mc) + sidx;
#pragma unroll
    for (int r = 0; r < 4; ++r)
#pragma unroll
        for (int q = 0; q < 4; ++q) { f32x4 t; t[0] = S[r][2 * q][0]; t[1] = S[r][2 * q][1]; t[2] = S[r][2 * q + 1][0]; t[3] = S[r][2 * q + 1][1]; *(f32x4*)(dst + r * 64 + 4 * q) = t; }
}
#define LD4P(dst, ptr) do { const f32x4 _t0 = *(const LAS f32x4*)(ptr), _t1 = *(const LAS f32x4*)((ptr) + 4); dst[0] = (f32x2){_t0[0], _t0[1]}; dst[1] = (f32x2){_t0[2], _t0[3]}; dst[2] = (f32x2){_t1[0], _t1[1]}; dst[3] = (f32x2){_t1[2], _t1[3]}; } while (0)
constexpr int RW_PAIR = RW_WAVE + 1024;
__device__ __forceinline__ void rwkv_pass2_pair(CArgsP a, int e, int bh, int c, int hf, LAS float* pl) {
    const int lane = otid() & 63, b = bh >> 3, h = bh & 7, cj = h * 64 + lane, ib = lane >> 3, jb = lane & 7;
    const bf16_t* H = (const bf16_t*)(a->ws + WS_H); const bf16_t* LO = (const bf16_t*)(a->ws + WS_LO); bf16_t* CONCAT = (bf16_t*)(a->ws + WS_XB);
    const float* Ss = (const float*)(a->ws + WS_AP) + (size_t)2 * 16 * NCH * 4096;
    const size_t sidx = ((size_t)bh * NCH + c) * 4096 + (size_t)(hf * 32 + ib * 4) * 64 + jb * 8;
    const int tok0 = b * SEQ + c * TCH;
    const float* mu = a->in[21] + (size_t)e * 1792;
    const float mu_r = mu[cj], mu_k = mu[512 + cj], mu_v = mu[1024 + cj], kkc = a->in[27][e * 512 + cj], kac = a->in[28][e * 512 + cj], rkc = a->in[29][e * 512 + cj];
    const float gng = a->in[30][e * 512 + cj], gnb = a->in[31][e * 512 + cj];
    const float w0c = a->in[22][e * 512 + cj], a0c = a->in[24][e * 512 + cj];
    LAS float* yb = pl + RW_WAVE;
    f32x2 S[4][4];
#pragma unroll
    for (int r = 0; r < 4; ++r) { const f32x4 t0 = *(const f32x4*)(Ss + sidx + r * 64), t1 = *(const f32x4*)(Ss + sidx + r * 64 + 4);
        S[r][0] = (f32x2){t0[0], t0[1]}; S[r][1] = (f32x2){t0[2], t0[3]}; S[r][2] = (f32x2){t1[0], t1[1]}; S[r][3] = (f32x2){t1[2], t1[3]}; }
    unsigned short rw[5][6];
#define RW2_LOAD(T0) do { _Pragma("unroll") for (int s = 0; s < 5; ++s) { const int tk = tok0 + (T0) + hf * 4 + s - 1; const bool ok = ((tk & (SEQ - 1)) != SEQ - 1) || s > 0 || true; \
        const bf16_t* hp = H + (size_t)tk * 2816 + cj; const bf16_t* lp = LO + (size_t)tk * 1536 + cj; (void)ok; \
        if (s == 0) { const bool have = (c > 0) || ((T0) + hf * 4 > 0); rw[0][0] = have ? hp[0] : (unsigned short)0; rw[0][1] = have ? hp[512] : (unsigned short)0; rw[0][2] = have ? hp[1024] : (unsigned short)0; } \
        else { rw[s][0] = hp[0]; rw[s][1] = hp[512]; rw[s][2] = hp[1024]; rw[s][3] = lp[0]; rw[s][4] = lp[512]; rw[s][5] = lp[1024]; } } } while (0)
    RW2_LOAD(0);
    for (int t0 = 0; t0 < TCH; t0 += 8) {
        float pr = bf2f(rw[0][0]), pk = bf2f(rw[0][1]), pv = bf2f(rw[0][2]);
#pragma unroll
        for (int u = 0; u < 4; ++u) { const int s = hf * 4 + u;
            const float rr = bf2f(rw[u + 1][0]), kr = bf2f(rw[u + 1][1]), vr = bf2f(rw[u + 1][2]), ee = __expf(-softplusf_(-(w0c + bf2f(rw[u + 1][3]))) - 0.5f), aa = sigmoidf_(a0c + bf2f(rw[u + 1][4]));
            const float rl = rr + mu_r * (pr - rr), kl = kr + mu_k * (pk - kr), vl = vr + mu_v * (pv - vr); pr = rr; pk = kr; pv = vr;
            const float kkj = kl * kkc, ss = wsum_fast(kkj * kkj), kn = kkj * rsqrtf(fmaxf(ss, 1e-24f));
            const float kp = kl * (1.0f + (aa - 1.0f) * kac), dec = __expf(-ee);
            LAS float* base = pl + s * RW_STEP;
            base[lane] = -kn; base[64 + lane] = dec; base[128 + lane] = kn * aa; base[192 + lane] = kp; base[256 + lane] = rl; base[320 + lane] = vl; base[384 + lane] = bf2f(rw[u + 1][5]);
            const float bd = wsum_fast(rl * kp * rkc); if (lane == 0) pl[8 * RW_STEP + s] = bd; }
        if (t0 + 8 < TCH) RW2_LOAD(t0 + 8);
        __syncthreads();
#pragma unroll 2
        for (int s = 0; s < 8; ++s) { const LAS float* base = pl + s * RW_STEP;
            f32x2 av[4], dc[4], bv[4], kp[4], rv[4];
            LD4P(av, base + jb * 8); LD4P(dc, base + 64 + jb * 8); LD4P(bv, base + 128 + jb * 8); LD4P(kp, base + 192 + jb * 8); LD4P(rv, base + 256 + jb * 8);
            const f32x4 v4 = *(const LAS f32x4*)(base + 320 + hf * 32 + ib * 4);
            float sa[4];
#pragma unroll
            for (int r = 0; r < 4; ++r) { f32x2 pp = S[r][0] * av[0]; pp += S[r][1] * av[1]; pp += S[r][2] * av[2]; pp += S[r][3] * av[3]; sa[r] = red8(pp[0] + pp[1]); }
            float ysel = 0.f;
#pragma unroll
            for (int r = 0; r < 4; ++r) { const f32x2 sa2 = (f32x2){sa[r], sa[r]}, v2 = (f32x2){v4[r], v4[r]};
#pragma unroll
                for (int q = 0; q < 4; ++q) S[r][q] = S[r][q] * dc[q] + (sa2 * bv[q] + v2 * kp[q]);
                f32x2 pp = S[r][0] * rv[0]; pp += S[r][1] * rv[1]; pp += S[r][2] * rv[2]; pp += S[r][3] * rv[3]; const float yr = red8(pp[0] + pp[1]); ysel = (jb == r) ? yr : ysel; }
            if (jb < 4) yb[s * 64 + hf * 32 + ib * 4 + jb] = ysel; }
        __syncthreads();
#pragma unroll
        for (int u = 0; u < 4; ++u) { const int s = hf * 4 + u; const LAS float* base = pl + s * RW_STEP; const float y = yb[s * 64 + lane], vi = base[320 + lane];
            const float mean = wsum_fast(y) * (1.f / 64.f), ey2 = wsum_fast(y * y) * (1.f / 64.f), dl = y - mean, var = fmaxf(ey2 - mean * mean, 0.f);
            const float yn = dl * rsqrtf(var + 64e-5f) * gng + gnb;
            const float o = (yn + pl[8 * RW_STEP + s] * vi) * base[384 + lane];
            CONCAT[(size_t)(tok0 + t0 + s) * 1024 + cj] = f2bf(o); }
        __syncthreads();
    }
#undef RW2_LOAD
}
__device__ __forceinline__ void rwkv_combine(CArgsP a, int blk, unsigned char* shm) {
    float* Lc = (float*)(a->ws + WS_AP); float* Mc = Lc + (size_t)16 * NCH * 4096; float* Ss = Mc + (size_t)16 * NCH * 4096;
    LAS float* Sc = (LAS float*)shm; LAS float* Mb = Sc + 512;
    const int tid = otid(), bh = blk >> 3, rg = blk & 7, r = tid >> 6, j = tid & 63;
    const size_t mbase = (size_t)bh * NCH * 4096, rowoff = (size_t)(rg * 8 + r) * 64 + j;
    float cur = 0.f;
    f32x4 mn0 = *(const f32x4*)(Mc + mbase + tid * 8), mn1 = *(const f32x4*)(Mc + mbase + tid * 8 + 4); float ln = Lc[mbase + rowoff];
    for (int c = 0; c < NCH; ++c) {
        Ss[mbase + (size_t)c * 4096 + rowoff] = cur;
        Sc[r * 64 + j] = cur; *(LAS f32x4*)(Mb + tid * 8) = mn0; *(LAS f32x4*)(Mb + tid * 8 + 4) = mn1;
        float acc = ln;
        __syncthreads();
        if (c + 1 < NCH) { const size_t nb = mbase + (size_t)(c + 1) * 4096; mn0 = *(const f32x4*)(Mc + nb + tid * 8); mn1 = *(const f32x4*)(Mc + nb + tid * 8 + 4); ln = Lc[nb + rowoff]; }
#pragma unroll
        for (int k = 0; k < 64; k += 4) { const f32x4 s4 = *(const LAS f32x4*)(Sc + r * 64 + k);
            acc += s4[0] * Mb[k * 64 + j]; acc += s4[1] * Mb[(k + 1) * 64 + j]; acc += s4[2] * Mb[(k + 2) * 64 + j]; acc += s4[3] * Mb[(k + 3) * 64 + j]; }
        cur = acc;
        __syncthreads();
    }
}
__device__ __forceinline__ void lru_pass_a(CArgsP a, int gtid, int nth) {
    const bf16_t* LGA = (const bf16_t*)(a->ws + WS_LA); const bf16_t* BX = LGA + (size_t)NTOK * 512; float2* PE = (float2*)(a->ws + WS_MISC + 3 * MiB);
    for (int it = gtid; it < 2 * NLCH * 512; it += nth) { const int ch = it & 511, cc = (it >> 9) & (NLCH - 1), b = it >> 16; const size_t base = ((size_t)b * SEQ + (size_t)cc * LCH) * 512 + ch;
        float P = 1.f, E = 0.f;
#pragma unroll 1
        for (int tb = 0; tb < LCH; tb += 16) { unsigned short la[16], bx[16];
#pragma unroll
            for (int u = 0; u < 16; ++u) { la[u] = LGA[base + (size_t)(tb + u) * 512]; bx[u] = BX[base + (size_t)(tb + u) * 512]; }
            __builtin_amdgcn_sched_barrier(0);
#pragma unroll
            for (int u = 0; u < 16; ++u) { const float av = __expf(bf2f(la[u])); P *= av; E = av * E + bf2f(bx[u]); } }
        PE[it] = make_float2(P, E); }
}
__device__ __forceinline__ void lru_pass_c2(CArgsP a, int gtid, int nth) {
    const unsigned* LGA = (const unsigned*)(a->ws + WS_LA); const unsigned* BX = LGA + (size_t)NTOK * 256; const f32x4* PE = (const f32x4*)(a->ws + WS_MISC + 3 * MiB);
    const unsigned* H = (const unsigned*)(a->ws + WS_H); unsigned* CONCAT = (unsigned*)(a->ws + WS_XB);
    for (int it = gtid; it < 2 * NLCH * 256; it += nth) { const int chp = it & 255, cc = (it >> 8) & (NLCH - 1), b = it >> 15; const size_t tokb = (size_t)b * SEQ + (size_t)cc * LCH;
        float h0 = 0.f, h1 = 0.f;
#pragma unroll 8
        for (int c2 = 0; c2 < cc; ++c2) { const f32x4 pe = PE[(b << 15) + (c2 << 8) + chp]; h0 = pe[0] * h0 + pe[1]; h1 = pe[2] * h1 + pe[3]; }
        const unsigned* lp = LGA + tokb * 256 + chp; const unsigned* bp = BX + tokb * 256 + chp; const unsigned* gp = H + tokb * 1408 + 896 + chp; unsigned* op = CONCAT + tokb * 512 + 256 + chp;
#pragma unroll 1
        for (int tb = 0; tb < LCH; tb += 8) { unsigned la[8], bx[8], gt[8];
#pragma unroll
            for (int u = 0; u < 8; ++u) { la[u] = lp[(tb + u) * 256]; bx[u] = bp[(tb + u) * 256]; gt[u] = gp[(size_t)(tb + u) * 1408]; }
#pragma unroll
            for (int u = 0; u < 8; ++u) {
                h0 = __expf(__uint_as_float(la[u] << 16)) * h0 + __uint_as_float(bx[u] << 16); h1 = __expf(__uint_as_float(la[u] & 0xffff0000u)) * h1 + __uint_as_float(bx[u] & 0xffff0000u);
                op[(tb + u) * 512] = pk2(h0 * geluf_(__uint_as_float(gt[u] << 16)), h1 * geluf_(__uint_as_float(gt[u] & 0xffff0000u))); } } }
}
__device__ __forceinline__ void lru_carry(CArgsP a, int gtid) {
    if (gtid >= 1024) return;
    const float2* PE = (const float2*)(a->ws + WS_MISC + 3 * MiB); float* CY = (float*)(a->ws + WS_MR + 512 * 1024);
    const int b = gtid >> 9, ch = gtid & 511; float hsv = 0.f;
#pragma unroll 16
    for (int cc = 0; cc < NLCH; ++cc) { const int idx = (b << 16) + (cc << 9) + ch; const float2 pe = PE[idx]; CY[idx] = hsv; hsv = pe.x * hsv + pe.y; }
}
__device__ __forceinline__ void lru_pass_c(CArgsP a, int gtid, int nth) {
    const bf16_t* LGA = (const bf16_t*)(a->ws + WS_LA); const bf16_t* BX = LGA + (size_t)NTOK * 512; const float2* PE = (const float2*)(a->ws + WS_MISC + 3 * MiB);
    const bf16_t* H = (const bf16_t*)(a->ws + WS_H); bf16_t* CONCAT = (bf16_t*)(a->ws + WS_XB);
    for (int it = gtid; it < 2 * NLCH * 512; it += nth) { const int ch = it & 511, cc = (it >> 9) & (NLCH - 1), b = it >> 16; const size_t tokb = (size_t)b * SEQ + (size_t)cc * LCH;
        float hsv = ((const float*)(a->ws + WS_MR + 512 * 1024))[it];
#pragma unroll 8
        for (int t = 0; t < LCH; ++t) { const size_t tok = tokb + t; const float av = __expf(bf2f(LGA[tok * 512 + ch])), bx = bf2f(BX[tok * 512 + ch]); hsv = av * hsv + bx;
            const float gt = bf2f(H[tok * 2816 + 1792 + ch]);
            CONCAT[tok * 1024 + 512 + ch] = f2bf(hsv * geluf_(gt)); } }
}
#ifndef REP_FFN
#define REP_FFN 1
#endif
#ifndef REP_P1
#define REP_P1 1
#endif
#ifndef REP_CB
#define REP_CB 1
#endif
#ifndef REP_P2
#define REP_P2 1
#endif
#ifndef REP_OPRE
#define REP_OPRE 1
#endif
#ifndef REP_AE
#define REP_AE 1
#endif
#ifndef REP_AT
#define REP_AT 1
#endif
#ifndef REP_LN
#define REP_LN 1
#endif
#ifndef REP_IN
#define REP_IN 1
#endif
#ifndef REP_CV
#define REP_CV 1
#endif
#ifndef REP_LC
#define REP_LC 1
#endif
#ifndef REP_R2
#define REP_R2 1
#endif
#ifndef REP_SYNC
#define REP_SYNC 0
#endif
#ifdef SKIP_E
#define SK_E(x)
#else
#define SK_E(x) x
#endif
#ifdef SKIP_O
#define SK_O(x)
#else
#define SK_O(x) x
#endif
#ifdef SKIP_S
#define SK_S(x)
#else
#define SK_S(x) x
#endif
#ifdef SKIP_A
#define SK_A(x)
#else
#define SK_A(x) x
#endif
__global__ __launch_bounds__(512, 2) void mega_fwd(Args a_unused) {
    extern __shared__ __attribute__((aligned(16))) unsigned char shm[];
    cg::grid_group grid = cg::this_grid();
#define a argp()
#define ws (a->ws)
#define P_W ((bf16_t*)(ws + WS_W))
#define P_XB ((bf16_t*)(ws + WS_XB))
#define P_H ((bf16_t*)(ws + WS_H))
#define P_LO ((bf16_t*)(ws + WS_LO))
#define P_AP ((bf16_t*)(ws + WS_AP))
#define P_XC ((bf16_t*)(ws + WS_XC))
#define P_LGA ((bf16_t*)(ws + WS_LA))
#define P_BX (P_LGA + (size_t)NTOK * 512)
#define P_Kb ((bf16_t*)(ws + WS_MISC))
#define P_VT ((bf16_t*)(ws + WS_MISC + MiB))
#define P_MEMB ((bf16_t*)(ws + WS_MISC + 2 * MiB))
#define P_Qb P_H
#define P_Ob (P_H + (size_t)NTOK * DM)
    volatile LAS unsigned* xst = (volatile LAS unsigned*)(shm + LDS_BYTES - 16);
    if (otid() == 0) { xst[0] = 0u; xst[1] = 0u; }
    __syncthreads();
    const XcdBarrier xb = xcd_barrier_post((unsigned*)(ws + WS_BAR), xst);
    prologue_cast(a); convert_layer(a, 0, shm); grid.sync();
#define GSYNC() xcd_barrier(xb)
    for (int ls = 0; ls < 16; ++ls) {
        const int l = ls >> 2, st = ls & 3, e = l >> 1, odd = l & 1;
        const bf16_t* A2; const bf16_t* W2; int K2; float scale2;
        if (st == 0 || st == 3) {
            EpiSwiGLU E; E.O = P_H;
            for (int rep = 0; rep < REP_FFN; ++rep) { run_gemm(shm, P_XB, P_W + (st == 0 ? W_FF1IN : W_FF2IN), NTOK, 5632, 1024, E); GSYNC(); }
            A2 = P_H; W2 = P_W + (st == 0 ? W_FF1OUT : W_FF2OUT); K2 = 2816; scale2 = 0.5f;
        } else {
            EpiBf16g E; int N; const bf16_t* Win; E.O = P_H;
            if (st == 1) { Win = P_W + W_MIXIN; E.scale = 1.0f; if (odd) { N = 2816; E.ldc = 2816; E.gelu_from = 1000; } else { N = 1536; E.ldc = 1536; E.gelu_from = 2; } }
            else { Win = P_W + W_Q; N = 1024; E.ldc = 1024; E.gelu_from = 1000; E.scale = 0.0625f; }
            for (int rep = 0; rep < REP_IN; ++rep) { run_gemm(shm, P_XB, Win, NTOK, N, 1024, E); if (rep + 1 < REP_IN) GSYNC(); }
            GSYNC();
            if (st == 1) {
                if (!odd) {
                    for (int rep = 0; rep < REP_AE; ++rep) { SK_E(even_core(a, e, shm);) GSYNC(); }
                    EpiPool EP; EP.O = P_XB; EP.scl = a->in[14] + (size_t)e * 512;
                    run_gemm(shm, P_LO, P_W + W_AUX1, NTOK, 512, 512, EP); GSYNC();
                } else {
                    for (int rep = 0; rep < REP_OPRE; ++rep) {
                        SK_O(odd_prep(a, e);) GSYNC();
                        { EpiBf16g EL; EL.O = P_LO; EL.ldc = 1536; EL.gelu_from = 1000; EL.scale = 1.0f; run_gemm(shm, P_AP, P_W + W_AUX1, NTOK, 1536, 256, EL); }
                        { EpiLru ER; ER.XC = P_XC; ER.b_a = a->in[35] + (size_t)e * 512; ER.b_x = a->in[37] + (size_t)e * 512; ER.lam = a->in[38] + (size_t)e * 512; ER.LGA = P_LGA; ER.BX = P_BX;
                          run_gemm(shm, P_XC, P_W + W_AUX2, NTOK, 1024, 512, ER); }
                        GSYNC();
                    }
                    for (int rep = 0; rep < REP_P1; ++rep) {
                        const int wave = otid() >> 6; LAS float* pl = (LAS float*)shm + (wave >> 1) * RW_PAIR;
                        for (int it0 = blockIdx.x * 4; it0 < 16 * NCH; it0 += gridDim.x * 4) { const int item = it0 + (wave >> 1);
                            if (wave & 1) rwkv_pass1_pair<1>(a, e, item / NCH, item % NCH, pl); else rwkv_pass1_pair<0>(a, e, item / NCH, item % NCH, pl); }
                        SK_O(lru_pass_a(a, blockIdx.x * 512 + otid(), gridDim.x * 512);)
                        GSYNC();
                    }
                    for (int rep = 0; rep < REP_CB; ++rep) {
                        if (blockIdx.x < 128) { SK_O(rwkv_combine(a, blockIdx.x, shm);) }
                        else { SK_O(lru_pass_c2(a, ((int)blockIdx.x - 128) * 512 + otid(), ((int)gridDim.x - 128) * 512);) }
                        GSYNC();
                    }
                    for (int rep = 0; rep < REP_P2; ++rep) {
                        const int wave = otid() >> 6; LAS float* pl = (LAS float*)shm + (wave >> 1) * RW_PAIR;
                        for (int it0 = blockIdx.x * 4; it0 < 16 * NCH; it0 += gridDim.x * 4) { const int item = it0 + (wave >> 1); rwkv_pass2_pair(a, e, item / NCH, item % NCH, wave & 1, pl); }
                        GSYNC();
                    }
                }
                A2 = P_XB; W2 = P_W + W_MIXOUT; K2 = 1024; scale2 = 1.0f;
            } else {
                for (int rep = 0; rep < REP_AT; ++rep) { SK_A(attn_phase(P_Qb, P_Kb, P_VT, P_Ob, shm);) GSYNC(); }
                A2 = P_Ob; W2 = P_W + W_O; K2 = 1024; scale2 = 1.0f;
            }
        }
        {
            EpiResid ER; ER.res = (const h16*)a->out; ER.out = (h16*)a->out; ER.MR = (const float*)(ws + WS_MR); ER.first = (ls == 0);
            ER.g = a->in[6] + (size_t)(ls > 0 ? ls - 1 : 0) * DM; ER.b = a->in[7] + (size_t)(ls > 0 ? ls - 1 : 0) * DM; ER.scale = scale2; run_gemm(shm, A2, W2, NTOK, 1024, K2, ER); }
        GSYNC();
        for (int rep = 0; rep < REP_SYNC; ++rep) GSYNC();
        if (st == 1) {
            if (blockIdx.x < 16) { EpiKV EK; EK.Kb = P_Kb; EK.VT = P_VT; run_gemm(shm, P_MEMB, P_W + W_KV, 512, 2048, 1024, EK, 16, (int)blockIdx.x); }
            else ln_phase(a->out, nullptr, P_XB, (float*)(ws + WS_MR), a->in[6] + (size_t)ls * DM, a->in[7] + (size_t)ls * DM, 16, (int)gridDim.x - 16);
        } else if (ls < 15) { for (int rep = 0; rep < REP_LN; ++rep) { ln_phase(a->out, nullptr, P_XB, (float*)(ws + WS_MR), a->in[6] + (size_t)ls * DM, a->in[7] + (size_t)ls * DM, 0, (int)gridDim.x); if (rep + 1 < REP_LN) GSYNC(); }
            if (st == 3) for (int rep = 0; rep < REP_CV; ++rep) { convert_layer(a, l + 1, shm); if (rep + 1 < REP_CV) GSYNC(); } }
        else { h16x8 zr[16][2]; ln_final_load((const h16*)a->out, zr); GSYNC(); ln_final_store(zr, a->out, a->in[6] + (size_t)ls * DM, a->in[7] + (size_t)ls * DM); }
        GSYNC();
    }
}

#undef a
#undef ws
#undef P_W
#undef P_XB
#undef P_H
#undef P_LO
#undef P_AP
#undef P_XC
#undef P_LGA
#undef P_BX
#undef P_Kb
#undef P_VT
#undef P_MEMB
#undef P_Qb
#undef P_Ob
extern "C" void kernel_launch(void* const* d_in, const int* in_sizes, int n_in, void* d_out, int out_size, void* d_ws, size_t ws_size, hipStream_t stream) {
    static int grid = 0;
    if (grid == 0) {
        if (n_in != 39 || out_size != NTOK * DM || ws_size < WS_END) { fprintf(stderr, "kernel_launch: unexpected shapes (n_in %d out %d ws %zu need %zu)\n", n_in, out_size, ws_size, (size_t)WS_END); grid = -1; return; }
        int dev = 0, cus = 0, per_cu = 0;
        hipGetDevice(&dev); hipDeviceGetAttribute(&cus, hipDeviceAttributeMultiprocessorCount, dev);
        if (hipFuncSetAttribute((const void*)mega_fwd, hipFuncAttributeMaxDynamicSharedMemorySize, LDS_BYTES) != hipSuccess) { fprintf(stderr, "kernel_launch: hipFuncSetAttribute failed\n"); }
        if (hipOccupancyMaxActiveBlocksPerMultiprocessor(&per_cu, (const void*)mega_fwd, 512, LDS_BYTES) != hipSuccess || per_cu < 1) { fprintf(stderr, "kernel_launch: occupancy query says %d\n", per_cu); per_cu = 1; }
        (void)hipGetLastError();
        grid = cus > 0 ? cus : 256;
    }
    if (grid < 0) return;
    if (hipMemsetAsync((char*)d_ws + WS_BAR, 0, 16384, stream) != hipSuccess) { fprintf(stderr, "kernel_launch: memset failed\n"); return; }
    Args a{};
    for (int i = 0; i < 39; ++i) a.in[i] = (const float*)d_in[i];
    a.out = (float*)d_out; a.ws = (unsigned char*)d_ws;
    void* args[] = {&a};
    hipError_t e = hipLaunchCooperativeKernel((const void*)mega_fwd, dim3(grid), dim3(512), args, LDS_BYTES, stream);
    if (e != hipSuccess) fprintf(stderr, "cooperative launch failed: %s (grid %d)\n", hipGetErrorString(e), grid);
}
```

```cpp
#include <hip/hip_runtime.h>
#include <hip/hip_cooperative_groups.h>
#include <cstdio>
namespace cg = cooperative_groups;
namespace pg8 {
#define PG8_LAS __attribute__((address_space(3)))
typedef unsigned short bf16_t;
typedef short bf16x8 __attribute__((ext_vector_type(8)));
typedef float f32x4 __attribute__((ext_vector_type(4)));
typedef unsigned u32x4 __attribute__((ext_vector_type(4)));
typedef unsigned u32x2 __attribute__((ext_vector_type(2)));
constexpr int BM = 256, BK = 64, HALF = 128, HTB = HALF * BK * 2  , STAGE_BYTES = 8 * HTB, NXCD = 8, WGM = 8;

__host__ __device__ __forceinline__ int lds_byte(int r, int c) { const int st = (r >> 4) * 2 + (c >> 5), rr = r & 15, cc = c & 31, ob = rr * 64 + cc * 2; return st * 1024 + (ob ^ (((ob >> 9) & 1) << 5)); }
__host__ __device__ __forceinline__ void stage_rc(int b, int& R, int& C) { const int st = b / 1024, sb = b % 1024, swz = sb ^ (((sb >> 9) & 1) << 5); R = (st >> 1) * 16 + swz / 64; C = (st & 1) * 32 + (swz % 64) / 2; }
__host__ __device__ __forceinline__ int perm32(int rho) { const int n = rho >> 4, i = rho & 15; return 8 * (i >> 2) + 4 * n + (i & 3); }

struct Unit { int pm, pn; };
struct Gemm { const bf16_t* A; const bf16_t* Bt; int M, N, K; };

struct StaticOrder {
    int nM, nN, nwg, G, c;
    __host__ __device__ void init(int M, int N, int G_, int c_) { nM = M / BM; nN = N / BM; nwg = nM * nN; G = G_; c = c_; }
    __host__ __device__ bool next(int i, Unit& u) const {
        const long L = (long)i * G + c; if (L >= nwg) return false;
        int wgid = (int)L; { const int q = nwg / NXCD, r = nwg % NXCD, xcd = wgid % NXCD, off = wgid / NXCD; wgid = (xcd < r ? xcd * (q + 1) : r * (q + 1) + (xcd - r) * q) + off; }
        const int nig = WGM * nN, gid = wgid / nig, fm = gid * WGM, gsz = (nM - fm) < WGM ? (nM - fm) : WGM;
        u.pm = fm + ((wgid % nig) % gsz); u.pn = (wgid % nig) / gsz; return true;
    }
    __device__ __forceinline__ void a_ready(const Unit&) const {}
    __device__ __forceinline__ void done(const Unit&) const {}
};
__device__ __forceinline__ unsigned cvt_pk_bf16(float lo, float hi) { unsigned r; asm volatile("v_cvt_pk_bf16_f32 %0, %1, %2" : "=v"(r) : "v"(lo), "v"(hi)); return r; }

template <class Epi, class Sched>
__device__ __forceinline__ void gemm_phase(PG8_LAS unsigned char* lds, const Gemm g, const Sched& S, const Epi& E) {
    int tid_ = threadIdx.x; asm volatile("" : "+v"(tid_));
    const int tid = tid_, wid = __builtin_amdgcn_readfirstlane(tid >> 6), lane = tid & 63, wr = wid >> 2, wc = wid & 3, fr = lane & 15, fq = lane >> 4;
    const int K = g.K, nt = K / BK;
    unsigned voffA[2], voffB[2];
#pragma unroll
    for (int i = 0; i < 2; ++i) { int R, C; stage_rc(tid * 16 + i * 8192, R, C); const int Rb = Epi::PERM ? ((R & ~31) + perm32(R & 31)) : R;
        voffA[i] = (unsigned)(R * K + C) * 2u; voffB[i] = (unsigned)(Rb * K + C) * 2u; }
    const size_t kstep = (size_t)(BK * 2);
    const size_t hstep = (size_t)HALF * K * 2;
    const size_t tstep = 2 * hstep;
    const unsigned ldsw = (unsigned)wid * 1024u;
    const int aoff = lds_byte(wr * 64 + fr, fq * 8), boff = lds_byte(wc * 32 + fr, fq * 8);
#define PG8_SA(b, h) (((b) * 2 + (h)) * HTB)
#define PG8_SB(b, h) ((4 + (b) * 2 + (h)) * HTB)
#define PG8_STAGE(bufoff, gbase, voff) do { _Pragma("unroll") for (int _i = 0; _i < 2; ++_i) \
        __builtin_amdgcn_global_load_lds((const unsigned*)((const char*)(gbase) + (voff)[_i]), (PG8_LAS unsigned*)(lds + (bufoff) + ldsw + _i * 8192), 16, 0, 0); } while (0)
#define PG8_LDA(dst, b, h) do { _Pragma("unroll") for (int m = 0; m < 4; ++m) _Pragma("unroll") for (int k = 0; k < 2; ++k) dst[m][k] = *(const PG8_LAS bf16x8*)(lds + PG8_SA(b, h) + aoff + m * 2048 + k * 1024); } while (0)
#define PG8_LDB(dst, b, h) do { _Pragma("unroll") for (int n = 0; n < 2; ++n) _Pragma("unroll") for (int k = 0; k < 2; ++k) dst[n][k] = *(const PG8_LAS bf16x8*)(lds + PG8_SB(b, h) + boff + n * 2048 + k * 1024); } while (0)
#define PG8_MMA(ai, bj, At, Bt) do { __builtin_amdgcn_s_setprio(1); _Pragma("unroll") for (int m = 0; m < 4; ++m) _Pragma("unroll") for (int n = 0; n < 2; ++n) _Pragma("unroll") for (int k = 0; k < 2; ++k) \
        acc[ai][bj][m][n] = __builtin_amdgcn_mfma_f32_16x16x32_bf16(Bt[n][k], At[m][k], acc[ai][bj][m][n], 0, 0, 0); __builtin_amdgcn_s_setprio(0); } while (0)
#define PG8_WAIT_V(n) asm volatile("s_waitcnt vmcnt(" #n ")" ::: "memory")
#define PG8_WAIT_L(n) asm volatile("s_waitcnt lgkmcnt(" #n ")" ::: "memory")
#define PG8_BAR __builtin_amdgcn_s_barrier()
#define PG8_SCHED __builtin_amdgcn_sched_barrier(0)
    Unit cur, nxt; int ui = 0;
    if (!S.next(0, cur)) return;
    f32x4 acc[2][2][4][2];
#pragma unroll
    for (int a = 0; a < 2; ++a)
#pragma unroll
        for (int b = 0; b < 2; ++b)
#pragma unroll
            for (int m = 0; m < 4; ++m)
#pragma unroll
                for (int n = 0; n < 2; ++n) acc[a][b][m][n] = (f32x4){0.f, 0.f, 0.f, 0.f};
    bf16x8 At[4][2], B0[2][2], B1[2][2];
    const char* cA = (const char*)g.A + (size_t)cur.pm * tstep; const char* cB = (const char*)g.Bt + (size_t)cur.pn * tstep;
    S.a_ready(cur);
    PG8_STAGE(PG8_SB(0, 0), cB, voffB); PG8_STAGE(PG8_SA(0, 0), cA, voffA); PG8_STAGE(PG8_SB(0, 1), cB + hstep, voffB); PG8_STAGE(PG8_SA(0, 1), cA + hstep, voffA);
    if (wr == 1) PG8_BAR;
    PG8_WAIT_V(4); PG8_BAR;
    PG8_STAGE(PG8_SB(1, 0), cB + kstep, voffB); PG8_STAGE(PG8_SA(1, 0), cA + kstep, voffA); PG8_STAGE(PG8_SB(1, 1), cB + hstep + kstep, voffB);
    PG8_WAIT_V(6); PG8_BAR;
    for (;;) {
        const bool has_next = S.next(ui + 1, nxt);
        const char* nA = has_next ? (const char*)g.A + (size_t)nxt.pm * tstep : cA; const char* nB = has_next ? (const char*)g.Bt + (size_t)nxt.pn * tstep : cB;
        for (int t = 0; t < nt; t += 2) {
            const bool last = (t == nt - 2);
            const char* a1 = cA + (size_t)(t + 1) * kstep;
            const char* a2 = last ? nA : cA + (size_t)(t + 2) * kstep; const char* b2 = last ? nB : cB + (size_t)(t + 2) * kstep;
            const char* a3 = a2 + kstep; const char* b3 = b2 + kstep;
            if (last && has_next) S.a_ready(nxt);
            PG8_LDB(B0, 0, 0); PG8_SCHED; PG8_LDA(At, 0, 0); PG8_STAGE(PG8_SA(1, 1), a1 + hstep, voffA);
            PG8_WAIT_L(8); PG8_BAR; PG8_WAIT_L(0); PG8_MMA(0, 0, At, B0); PG8_BAR; PG8_SCHED;
            PG8_LDB(B1, 0, 1); PG8_STAGE(PG8_SB(0, 0), b2, voffB);
            PG8_BAR; PG8_WAIT_L(0); PG8_MMA(0, 1, At, B1); PG8_BAR;
            PG8_LDA(At, 0, 1); PG8_STAGE(PG8_SA(0, 0), a2, voffA);
            PG8_BAR; PG8_WAIT_L(0); PG8_MMA(1, 0, At, B0); PG8_BAR; PG8_SCHED;
            PG8_STAGE(PG8_SB(0, 1), b2 + hstep, voffB);
            PG8_WAIT_V(6); PG8_BAR; PG8_MMA(1, 1, At, B1); PG8_BAR;
            PG8_LDB(B0, 1, 0); PG8_SCHED; PG8_LDA(At, 1, 0); PG8_STAGE(PG8_SA(0, 1), a2 + hstep, voffA);
            PG8_WAIT_L(8); PG8_BAR; PG8_WAIT_L(0); PG8_MMA(0, 0, At, B0); PG8_BAR; PG8_SCHED;
            PG8_LDB(B1, 1, 1); PG8_STAGE(PG8_SB(1, 0), b3, voffB);
            PG8_BAR; PG8_WAIT_L(0); PG8_MMA(0, 1, At, B1); PG8_BAR;
            PG8_LDA(At, 1, 1); PG8_STAGE(PG8_SA(1, 0), a3, voffA);
            PG8_BAR; PG8_WAIT_L(0); PG8_MMA(1, 0, At, B0); PG8_BAR; PG8_SCHED;
            PG8_STAGE(PG8_SB(1, 1), b3 + hstep, voffB);
            PG8_WAIT_V(6); PG8_BAR; PG8_MMA(1, 1, At, B1); PG8_BAR;
        }
        if constexpr (!Epi::AFTER_DRAIN) { E(acc, cur, wr, wc, fr, fq); S.done(cur); }
        if (!has_next) break;
#pragma unroll
        for (int a = 0; a < 2; ++a)
#pragma unroll
            for (int b = 0; b < 2; ++b)
#pragma unroll
                for (int m = 0; m < 4; ++m)
#pragma unroll
                    for (int n = 0; n < 2; ++n) acc[a][b][m][n] = (f32x4){0.f, 0.f, 0.f, 0.f};
        cur = nxt; cA = nA; cB = nB; ++ui;
    }
    PG8_WAIT_V(0);
    if (wr == 0) PG8_BAR;
    PG8_BAR;
    if constexpr (Epi::AFTER_DRAIN) { E.fused(acc, cur, wr, wc, fr, fq, lds, wid, lane); S.done(cur); }
#undef PG8_SA
#undef PG8_SB
#undef PG8_STAGE
#undef PG8_LDA
#undef PG8_LDB
#undef PG8_MMA
#undef PG8_WAIT_V
#undef PG8_WAIT_L
#undef PG8_BAR
#undef PG8_SCHED
}
}

using pg8::bf16_t; using pg8::bf16x8; using pg8::f32x4; using pg8::u32x4; using pg8::u32x2;
#define LAS __attribute__((address_space(3)))
constexpr int NTOK = 32768, SEQ = 16384, DM = 1024, FF = 2816;
constexpr int NCH = 64;
constexpr int TCH = SEQ / NCH;
constexpr int LCH = 128;
constexpr int NLCH = SEQ / LCH;
constexpr float ALPHA = 1.681792830507429f;
constexpr int LDS_BYTES = 136 * 1024;

constexpr size_t MiB = 1024 * 1024;
constexpr size_t E_FFIN = (size_t)5632 * 1024, E_FFOUT = (size_t)1024 * 2816, E_SQ = (size_t)1024 * 1024, E_KV = (size_t)2048 * 1024, E_MIXIN = (size_t)2816 * 1024;
constexpr size_t W_FF1IN = 0, W_FF1OUT = W_FF1IN + E_FFIN, W_FF2IN = W_FF1OUT + E_FFOUT, W_FF2OUT = W_FF2IN + E_FFIN, W_Q = W_FF2OUT + E_FFOUT, W_KV = W_Q + E_SQ, W_O = W_KV + E_KV,
                 W_MIXIN = W_O + E_SQ, W_MIXOUT = W_MIXIN + E_MIXIN, W_AUX1 = W_MIXOUT + E_SQ, W_AUX2 = W_AUX1 + (size_t)1536 * 256, W_END = W_AUX2 + (size_t)1024 * 512;
constexpr size_t WS_W = 0;
constexpr size_t WS_XB = 52 * MiB;
constexpr size_t WS_H = WS_XB + 64 * MiB;
constexpr size_t WS_LO = WS_H + 176 * MiB;
constexpr size_t WS_AP = WS_LO + 96 * MiB;
constexpr size_t WS_XC = WS_AP + 16 * MiB;
constexpr size_t WS_LA = WS_XC + 32 * MiB;
constexpr size_t WS_MISC = WS_LA + 64 * MiB;
constexpr size_t WS_BAR = WS_MISC + 4 * MiB;
constexpr size_t WS_MR = WS_BAR + 1 * MiB;
constexpr size_t WS_END = WS_MR + 1 * MiB;
static_assert(W_END * 2 <= 52 * MiB, "weights");
static_assert(WS_END <= 512 * MiB, "workspace");

struct Args { const float* in[39]; float* out; unsigned char* ws; };
typedef const __attribute__((address_space(4))) Args* CArgsP;
__device__ __forceinline__ CArgsP argp() { CArgsP p = (CArgsP)__builtin_amdgcn_kernarg_segment_ptr(); asm volatile("" : "+s"(p)); return p; }

__device__ __forceinline__ float bf2f(unsigned short b) { return __uint_as_float(((unsigned)b) << 16); }
__device__ __forceinline__ float bfs2f(short b) { return __uint_as_float(((unsigned)(unsigned short)b) << 16); }
__device__ __forceinline__ unsigned short f2bf(float f) { unsigned u = __float_as_uint(f); u += 0x7FFFu + ((u >> 16) & 1u); return (unsigned short)(u >> 16); }
__device__ __forceinline__ unsigned pk2(float lo, float hi) { return pg8::cvt_pk_bf16(lo, hi); }
__device__ __forceinline__ float sigmoidf_(float x) { return __builtin_amdgcn_rcpf(1.0f + __expf(-x)); }
__device__ __forceinline__ float siluf_(float x) { return x * sigmoidf_(x); }
__device__ __forceinline__ float tanhf_(float y) { return 1.0f - 2.0f * __builtin_amdgcn_rcpf(1.0f + __expf(2.0f * y)); }
__device__ __forceinline__ float geluf_(float x) { return 0.5f * x * (1.0f + tanhf_(0.7978845608028654f * (x + 0.044715f * x * x * x))); }
__device__ __forceinline__ float softplusf_(float x) { return fmaxf(x, 0.0f) + __logf(1.0f + __expf(-fabsf(x))); }
__device__ __forceinline__ float wave_sum(float v) {
#pragma unroll
    for (int o = 1; o < 64; o <<= 1) v += __shfl_xor(v, o);
    return v;
}
__device__ __forceinline__ int otid() { int t = threadIdx.x; asm volatile("" : "+v"(t)); return t; }
#define LDS_SYNC_WAVE() asm volatile("s_waitcnt lgkmcnt(0)" ::: "memory")

typedef const f32x4 (&AccRef)[2][2][4][2];
struct EpiSwiGLU { static constexpr bool PERM = true, AFTER_DRAIN = false; bf16_t* O;
    __device__ __forceinline__ void operator()(AccRef acc, const pg8::Unit& u, int wr, int wc, int fr, int fq) const {
        const int row0 = u.pm * 256 + wr * 64 + fr, col0 = u.pn * 128 + wc * 32 + 8 * fq;
#pragma unroll
        for (int ai = 0; ai < 2; ++ai)
#pragma unroll
            for (int m = 0; m < 4; ++m) { bf16_t* rowp = O + (size_t)(row0 + ai * 128 + m * 16) * FF + col0;
                const f32x4 g0 = acc[ai][0][m][0], g1 = acc[ai][0][m][1], u0 = acc[ai][1][m][0], u1 = acc[ai][1][m][1];
                u32x4 o; o.x = pk2(siluf_(g0[0]) * u0[0], siluf_(g0[1]) * u0[1]); o.y = pk2(siluf_(g0[2]) * u0[2], siluf_(g0[3]) * u0[3]);
                o.z = pk2(siluf_(g1[0]) * u1[0], siluf_(g1[1]) * u1[1]); o.w = pk2(siluf_(g1[2]) * u1[2], siluf_(g1[3]) * u1[3]);
                *(u32x4*)rowp = o; __builtin_amdgcn_sched_barrier(0); }
    } };
typedef _Float16 h16; typedef h16 h16x4 __attribute__((ext_vector_type(4))); typedef h16 h16x8 __attribute__((ext_vector_type(8)));
struct EpiResid { static constexpr bool PERM = false, AFTER_DRAIN = false; const h16* res; h16* out; const float* MR; const float* g; const float* b; float scale; int first;
    __device__ __forceinline__ void operator()(AccRef acc, const pg8::Unit& u, int wr, int wc, int fr, int fq) const {
        const int row0 = u.pm * 256 + wr * 64 + fr, col0 = u.pn * 256 + wc * 32 + 4 * fq;
        f32x4 g4[2][2], b4[2][2];
#pragma unroll
        for (int bj = 0; bj < 2; ++bj)
#pragma unroll
            for (int n = 0; n < 2; ++n) { if (first) { g4[bj][n] = (f32x4){1.f, 1.f, 1.f, 1.f}; b4[bj][n] = (f32x4){0.f, 0.f, 0.f, 0.f}; } else { g4[bj][n] = *(const f32x4*)(g + col0 + bj * 128 + n * 16); b4[bj][n] = *(const f32x4*)(b + col0 + bj * 128 + n * 16); } }
#pragma unroll
        for (int ai = 0; ai < 2; ++ai)
#pragma unroll
        for (int mh = 0; mh < 4; mh += 2) {
            float mean[2], rstd[2]; h16x4 rr[2][2][2];
#pragma unroll
            for (int mm = 0; mm < 2; ++mm) { const int row = row0 + ai * 128 + (mh + mm) * 16; const size_t off = (size_t)row * DM + col0; mean[mm] = MR[2 * row]; rstd[mm] = MR[2 * row + 1];
#pragma unroll
                for (int bj = 0; bj < 2; ++bj)
#pragma unroll
                    for (int n = 0; n < 2; ++n) rr[mm][bj][n] = *(const h16x4*)(res + off + bj * 128 + n * 16); }
#pragma unroll
            for (int mm = 0; mm < 2; ++mm) { const int m = mh + mm, row = row0 + ai * 128 + m * 16; const size_t off = (size_t)row * DM + col0;
#pragma unroll
                for (int bj = 0; bj < 2; ++bj)
#pragma unroll
                    for (int n = 0; n < 2; ++n) { const f32x4 r = __builtin_convertvector(rr[mm][bj][n], f32x4);
                        const f32x4 x = (r - mean[mm]) * rstd[mm] * g4[bj][n] + b4[bj][n], z = x * ALPHA + acc[ai][bj][m][n] * scale;
                        *(h16x4*)(out + off + bj * 128 + n * 16) = __builtin_convertvector(z, h16x4); } } }
    } };
struct EpiBf16g { static constexpr bool PERM = true, AFTER_DRAIN = false; bf16_t* O; int ldc; int gelu_from; float scale;
    __device__ __forceinline__ void operator()(AccRef acc, const pg8::Unit& u, int wr, int wc, int fr, int fq) const {
        const int row0 = u.pm * 256 + wr * 64 + fr, col0 = u.pn * 256 + wc * 32 + 8 * fq; const bool dog = u.pn >= gelu_from;
#pragma unroll
        for (int ai = 0; ai < 2; ++ai)
#pragma unroll
            for (int m = 0; m < 4; ++m) { bf16_t* rowp = O + (size_t)(row0 + ai * 128 + m * 16) * ldc + col0;
#pragma unroll
                for (int bj = 0; bj < 2; ++bj) { f32x4 v0 = acc[ai][bj][m][0] * scale, v1 = acc[ai][bj][m][1] * scale;
                    if (dog) {
#pragma unroll
                        for (int e = 0; e < 4; ++e) { v0[e] = geluf_(v0[e]); v1[e] = geluf_(v1[e]); } }
                    u32x4 o; o.x = pk2(v0[0], v0[1]); o.y = pk2(v0[2], v0[3]); o.z = pk2(v1[0], v1[1]); o.w = pk2(v1[2], v1[3]);
                    *(u32x4*)(rowp + bj * 128) = o; } }
    } };
struct EpiKV { static constexpr bool PERM = false, AFTER_DRAIN = false; bf16_t* Kb; bf16_t* VT;
    __device__ __forceinline__ void operator()(AccRef acc, const pg8::Unit& u, int wr, int wc, int fr, int fq) const {
        const int row0 = u.pm * 256 + wr * 64 + fr, col0 = u.pn * 256 + wc * 32 + 4 * fq;
#pragma unroll
        for (int ai = 0; ai < 2; ++ai)
#pragma unroll
            for (int m = 0; m < 4; ++m) { const int row = row0 + ai * 128 + m * 16;
#pragma unroll
                for (int bj = 0; bj < 2; ++bj)
#pragma unroll
                    for (int n = 0; n < 2; ++n) { const int col = col0 + bj * 128 + n * 16; const f32x4 v = acc[ai][bj][m][n];
                        if (u.pn < 4) { u32x2 o; o.x = pk2(v[0], v[1]); o.y = pk2(v[2], v[3]); *(u32x2*)(Kb + (size_t)row * 1024 + col) = o; }
                        else { const int cc = col - 1024, hh = cc >> 8, d = cc & 255, b = row >> 8, mm = row & 255;
#pragma unroll
                            for (int e = 0; e < 4; ++e) VT[(size_t)((b * 4 + hh) * 256 + d + e) * 256 + mm] = f2bf(v[e]); } } }
    } };
struct EpiLru { static constexpr bool PERM = true, AFTER_DRAIN = false; const bf16_t* XC; const float* b_a; const float* b_x; const float* lam; bf16_t* LGA; bf16_t* BX;
    __device__ __forceinline__ void operator()(AccRef acc, const pg8::Unit& u, int wr, int wc, int fr, int fq) const {
        const int row0 = u.pm * 256 + wr * 64 + fr, ch0 = u.pn * 128 + wc * 32 + 8 * fq;
#pragma unroll
        for (int n = 0; n < 2; ++n) { float sp[4]; const f32x4 lm = *(const f32x4*)(lam + ch0 + 4 * n), ba = *(const f32x4*)(b_a + ch0 + 4 * n), bx_ = *(const f32x4*)(b_x + ch0 + 4 * n);
#pragma unroll
            for (int e = 0; e < 4; ++e) sp[e] = -8.0f * softplusf_(-lm[e]);
            u32x2 xrr[2][4];
#pragma unroll
            for (int ai = 0; ai < 2; ++ai)
#pragma unroll
                for (int m = 0; m < 4; ++m) xrr[ai][m] = *(const u32x2*)(XC + (size_t)(row0 + ai * 128 + m * 16) * 512 + ch0 + 4 * n);
#pragma unroll
            for (int ai = 0; ai < 2; ++ai)
#pragma unroll
                for (int m = 0; m < 4; ++m) { const size_t off = (size_t)(row0 + ai * 128 + m * 16) * 512 + ch0 + 4 * n;
                    const u32x2 xr = xrr[ai][m]; float xc[4] = {__uint_as_float(xr.x << 16), __uint_as_float(xr.x & 0xffff0000u), __uint_as_float(xr.y << 16), __uint_as_float(xr.y & 0xffff0000u)};
                    float la[4], bb[4];
#pragma unroll
                    for (int e = 0; e < 4; ++e) { const float rec = sigmoidf_(acc[ai][0][m][n][e] + ba[e]), inp = sigmoidf_(acc[ai][1][m][n][e] + bx_[e]);
                        const float lg = sp[e] * rec; la[e] = lg; bb[e] = sqrtf(fmaxf(1.0f - __expf(2.0f * lg), 0.0f)) * (inp * xc[e]); }
                    u32x2 o; o.x = pk2(la[0], la[1]); o.y = pk2(la[2], la[3]); *(u32x2*)(LGA + off) = o;
                    o.x = pk2(bb[0], bb[1]); o.y = pk2(bb[2], bb[3]); *(u32x2*)(BX + off) = o; } }
    } };
struct EpiPool { static constexpr bool PERM = true, AFTER_DRAIN = false; bf16_t* O; const float* scl;
    __device__ __forceinline__ void operator()(AccRef acc, const pg8::Unit& u, int wr, int wc, int fr, int fq) const {
        const int row0 = u.pm * 256 + wr * 64 + fr, col0 = u.pn * 256 + wc * 32 + 8 * fq;
        float sc[2][8];
#pragma unroll
        for (int bj = 0; bj < 2; ++bj)
#pragma unroll
            for (int e = 0; e < 8; ++e) sc[bj][e] = scl[col0 + bj * 128 + e];
#pragma unroll
        for (int ai = 0; ai < 2; ++ai)
#pragma unroll
            for (int m = 0; m < 4; ++m) { bf16_t* rowp = O + (size_t)(row0 + ai * 128 + m * 16) * 1024 + col0;
#pragma unroll
                for (int bj = 0; bj < 2; ++bj) { float v[8];
#pragma unroll
                    for (int e = 0; e < 8; ++e) v[e] = acc[ai][bj][m][e >> 2][e & 3] * sc[bj][e];
                    u32x4 o; o.x = pk2(v[0], v[1]); o.y = pk2(v[2], v[3]); o.z = pk2(v[4], v[5]); o.w = pk2(v[6], v[7]);
                    *(u32x4*)(rowp + bj * 128) = o; } }
    } };

template <class Epi> __device__ __forceinline__ void run_gemm(unsigned char* shm, const bf16_t* A, const bf16_t* Bt, int M, int N, int K, const Epi& E, int G = 0, int c = -1) {
    pg8::Gemm g; g.A = A; g.Bt = Bt; g.M = M; g.N = N; g.K = K;
    pg8::StaticOrder S; S.init(M, N, G > 0 ? G : (int)gridDim.x, c >= 0 ? c : (int)blockIdx.x);
    pg8::gemm_phase<Epi, pg8::StaticOrder>((PG8_LAS unsigned char*)shm, g, S, E);
}

template <int MODE> __device__ __forceinline__ int rowmap(int n) {
    if (MODE == 0) return n;
    const int up = n >= FF, i = up ? n - FF : n; return (i >> 7) * 256 + up * 128 + (i & 127);
}
template <int MODE> __device__ __forceinline__ void conv_tile(const float* src, int K, int N, bf16_t* dst, int tile, float* tb) {
    const int tid = otid(), ntn = N >> 6, k0 = (tile / ntn) << 6, n0 = (tile % ntn) << 6;
#pragma unroll
    for (int i = 0; i < 8; ++i) { const int kk = i * 8 + (tid >> 6), nn = tid & 63; tb[kk * 65 + nn] = src[(size_t)(k0 + kk) * N + n0 + nn]; }
    __syncthreads();
#pragma unroll
    for (int i = 0; i < 4; ++i) { const int nn = i * 16 + (tid >> 5), kk = 2 * (tid & 31);
        *(unsigned*)(dst + (size_t)rowmap<MODE>(n0 + nn) * K + k0 + kk) = pk2(tb[kk * 65 + nn], tb[(kk + 1) * 65 + nn]); }
    __syncthreads();
}

#define XB_TMO      128
#define XB_XCNT(j)  (256  + 64 * (j))
#define XB_XSUB(j)  (1280 + 64 * (j))
#define XB_XGEN(j)  (2304 + 64 * (j))
#define XB_TOP      3328
#define XB_TOPGEN   3392
#define XCD_BAR_WORDS 3456
#define XB_SPIN_CAP (1u << 18)

__device__ __forceinline__ unsigned xb_ld(unsigned* p)              { return __hip_atomic_load(p, __ATOMIC_RELAXED, __HIP_MEMORY_SCOPE_AGENT); }
__device__ __forceinline__ unsigned xb_add(unsigned* p, unsigned v) { return __hip_atomic_fetch_add(p, v, __ATOMIC_RELAXED, __HIP_MEMORY_SCOPE_AGENT); }
__device__ __forceinline__ unsigned xb_xcc_id() { return (unsigned)__builtin_amdgcn_s_getreg((3 << 11) | 20) & 0xFu; }
#define XB_SPIN(cond, bar) do { unsigned _sp = 0; while (cond) { __builtin_amdgcn_s_sleep(1); \
    if ((++_sp & 255u) == 0u) { if (xb_ld(&(bar)[XB_TMO])) break; if (_sp > XB_SPIN_CAP) { atomicAdd(&(bar)[XB_TMO], 1u); break; } } } } while (0)

struct XcdBarrier {
    unsigned* bar; unsigned x;
    volatile LAS unsigned* st;
};

__device__ __forceinline__ XcdBarrier xcd_barrier_post(unsigned* bar, volatile LAS unsigned* st) {
    XcdBarrier b; b.bar = bar; b.x = xb_xcc_id(); b.st = st;
    if (otid() == 0) (void)xb_add(&bar[XB_XCNT(b.x)], 1u);
    return b;
}
__device__ __forceinline__ void xcd_barrier_complete(unsigned* bar, unsigned x, unsigned& nloc, unsigned& nx) {
    const unsigned G = gridDim.x * gridDim.y * gridDim.z;
    unsigned sum, cnt, mine, sp = 0u;
    for (;;) {
        sum = 0u; cnt = 0u; mine = 0u;
#pragma unroll
        for (unsigned j = 0; j < 16; ++j) { const unsigned c = xb_ld(&bar[XB_XCNT(j)]); sum += c; cnt += (c > 0u) ? 1u : 0u; mine = (j == x) ? c : mine; }
        if (sum == G) break;
        __builtin_amdgcn_s_sleep(1);
        if ((++sp & 255u) == 0u) { if (xb_ld(&bar[XB_TMO])) break; if (sp > XB_SPIN_CAP) { atomicAdd(&bar[XB_TMO], 1u); break; } }
    }
    nloc = mine > 0u ? mine : 1u; nx = cnt > 0u ? cnt : 1u;
}

__device__ __forceinline__ void xcd_barrier(const XcdBarrier& b) {
    asm volatile("s_waitcnt vmcnt(0)" ::: "memory");
    __syncthreads();
    if (otid() == 0) {
        unsigned* bar = b.bar;
        __builtin_amdgcn_s_waitcnt(0);
        unsigned nloc = b.st[0], nx = b.st[1];
        if (nloc == 0u) { xcd_barrier_complete(bar, b.x, nloc, nx); b.st[0] = nloc; b.st[1] = nx; }
        const unsigned old = xb_add(&bar[XB_XSUB(b.x)], 1u);
        const unsigned gen = old / nloc;
        if (old + 1u == (gen + 1u) * nloc) {
            __builtin_amdgcn_fence(__ATOMIC_RELEASE, "agent");
            asm volatile("s_waitcnt vmcnt(0)" ::: "memory");
            const unsigned og = xb_add(&bar[XB_TOP], 1u);
            const unsigned tg = og / nx;
            if (og + 1u == (tg + 1u) * nx) xb_add(&bar[XB_TOPGEN], 1u);
            else XB_SPIN(xb_ld(&bar[XB_TOPGEN]) == tg, bar);
            __builtin_amdgcn_fence(__ATOMIC_ACQUIRE, "agent");
            xb_add(&bar[XB_XGEN(b.x)], 1u);
            asm volatile("s_waitcnt vmcnt(0)" ::: "memory");
        } else {
            XB_SPIN(xb_ld(&bar[XB_XGEN(b.x)]) == gen, bar);
            __builtin_amdgcn_fence(__ATOMIC_ACQUIRE, "agent");
            asm volatile("s_waitcnt vmcnt(0)" ::: "memory");
        }
    }
    __syncthreads();
}

struct CvDesc { const float* src; bf16_t* dst; int K, N, mode, tile; };
__device__ __forceinline__ bool cv_decode(CArgsP a, int l, int it, CvDesc& d) {
    bf16_t* W = (bf16_t*)(a->ws + WS_W); const int e = l >> 1, odd = l & 1;
    constexpr int T_FFIN = 8 * 88, T_FFOUT = 22 * 16, T_SQ = 128, T_KV = 8 * 32;
    const int T_MIXIN = odd ? 8 * 44 : 8 * 24;
    int r = it; d.mode = 0;
    if (r < T_FFIN) { d.src = a->in[2] + (size_t)l * 1024 * 5632; d.K = 1024; d.N = 5632; d.dst = W + W_FF1IN; d.mode = 1; d.tile = r; return true; } r -= T_FFIN;
    if (r < T_FFIN) { d.src = a->in[4] + (size_t)l * 1024 * 5632; d.K = 1024; d.N = 5632; d.dst = W + W_FF2IN; d.mode = 1; d.tile = r; return true; } r -= T_FFIN;
    if (r < T_FFOUT) { d.src = a->in[3] + (size_t)l * 2816 * 1024; d.K = 2816; d.N = 1024; d.dst = W + W_FF1OUT; d.tile = r; return true; } r -= T_FFOUT;
    if (r < T_FFOUT) { d.src = a->in[5] + (size_t)l * 2816 * 1024; d.K = 2816; d.N = 1024; d.dst = W + W_FF2OUT; d.tile = r; return true; } r -= T_FFOUT;
    if (r < T_SQ) { d.src = a->in[8] + (size_t)l * 1024 * 1024; d.K = 1024; d.N = 1024; d.dst = W + W_Q; d.tile = r; return true; } r -= T_SQ;
    if (r < T_KV) { d.src = a->in[9] + (size_t)l * 1024 * 2048; d.K = 1024; d.N = 2048; d.dst = W + W_KV; d.tile = r; return true; } r -= T_KV;
    if (r < T_SQ) { d.src = a->in[10] + (size_t)l * 1024 * 1024; d.K = 1024; d.N = 1024; d.dst = W + W_O; d.tile = r; return true; } r -= T_SQ;
    if (r < T_SQ) { d.src = (odd ? a->in[20] : a->in[12]) + (size_t)e * 1024 * 1024; d.K = 1024; d.N = 1024; d.dst = W + W_MIXOUT; d.tile = r; return true; } r -= T_SQ;
    if (r < T_MIXIN) { d.K = 1024; d.dst = W + W_MIXIN; d.tile = r; if (odd) { d.src = a->in[19] + (size_t)e * 1024 * 2816; d.N = 2816; } else { d.src = a->in[11] + (size_t)e * 1024 * 1536; d.N = 1536; } return true; }
    return false;
}
__device__ __forceinline__ void cv_load(const CvDesc& d, int tid, float (&v)[16]) {
    const int ntn = d.N >> 6, k0 = (d.tile / ntn) << 7, n0 = (d.tile % ntn) << 6;
#pragma unroll
    for (int i = 0; i < 16; ++i) v[i] = d.src[(size_t)(k0 + i * 8 + (tid >> 6)) * d.N + n0 + (tid & 63)];
}
__device__ __forceinline__ void convert_layer(CArgsP a, int l, unsigned char* shm) {
    float* tb = (float*)shm; bf16_t* W = (bf16_t*)(a->ws + WS_W);
    const int e = l >> 1, odd = l & 1, tid = otid();
    {
        CvDesc d, nx; float v[16]; int it = blockIdx.x; bool have = cv_decode(a, l, it, d);
        if (have) cv_load(d, tid, v);
        while (have) {
#pragma unroll
            for (int i = 0; i < 16; ++i) tb[(i * 8 + (tid >> 6)) * 65 + (tid & 63)] = v[i];
            __syncthreads();
            it += gridDim.x; const bool hn = cv_decode(a, l, it, nx);
            if (hn) cv_load(nx, tid, v);
            const int ntn = d.N >> 6, k0 = (d.tile / ntn) << 7, n0 = (d.tile % ntn) << 6;
#pragma unroll
            for (int i = 0; i < 8; ++i) { const int nn = i * 8 + (tid >> 6), kk = 2 * (tid & 63), n = n0 + nn; const int row = d.mode ? rowmap<1>(n) : n;
                *(unsigned*)(d.dst + (size_t)row * d.K + k0 + kk) = pk2(tb[kk * 65 + nn], tb[(kk + 1) * 65 + nn]); }
            __syncthreads();
            d = nx; have = hn;
        }
    }
    const int gtid = blockIdx.x * 512 + otid(), nth = gridDim.x * 512;
    if (!odd) {
        const float* pw = a->in[13] + (size_t)e * 4 * 128 * 128;
        for (int idx = gtid; idx < 512 * 512; idx += nth) { const int n = idx >> 9, k = idx & 511, g = n >> 7, d = n & 127, g2 = k >> 7, c = k & 127;
            W[W_AUX1 + idx] = (g == g2) ? f2bf(pw[(g * 128 + c) * 128 + d]) : (bf16_t)0; }
    } else {
        const float* wup = a->in[23] + (size_t)e * 64 * 512; const float* aup = a->in[25] + (size_t)e * 64 * 512; const float* gup = a->in[26] + (size_t)e * 128 * 512;
        for (int idx = gtid; idx < 1536 * 256; idx += nth) { const int n = idx >> 8, k = idx & 255, kind = n >> 9, j = n & 511; float v = 0.f;
            if (kind == 0) { if (k < 64) v = wup[k * 512 + j]; } else if (kind == 1) { if (k >= 64 && k < 128) v = aup[(k - 64) * 512 + j]; } else { if (k >= 128) v = gup[(k - 128) * 512 + j]; }
            W[W_AUX1 + idx] = f2bf(v); }
        const float* wa = a->in[34] + (size_t)e * 8 * 64 * 64; const float* wx = a->in[36] + (size_t)e * 8 * 64 * 64;
        for (int idx = gtid; idx < 1024 * 512; idx += nth) { const int n = idx >> 9, k = idx & 511, pn = n >> 8, bj = (n >> 7) & 1, cc = n & 127, ch = pn * 128 + cc, hb = ch >> 6, jj = ch & 63; float v = 0.f;
            if ((k >> 6) == hb) v = (bj ? wx : wa)[(hb * 64 + (k & 63)) * 64 + jj];
            W[W_AUX2 + idx] = f2bf(v); }
    }
}
__device__ __forceinline__ void prologue_cast(CArgsP a) {
    const int gtid = blockIdx.x * 512 + otid(), nth = gridDim.x * 512;
    const f32x4* x4 = (const f32x4*)a->in[0]; u32x2* xb = (u32x2*)(a->ws + WS_XB);
    for (int i0 = gtid; i0 < NTOK * DM / 4; i0 += nth * 8) { f32x4 v[8];
#pragma unroll
        for (int u = 0; u < 8; ++u) { const int i = i0 + u * nth; v[u] = (i < NTOK * DM / 4) ? x4[i] : (f32x4){0.f, 0.f, 0.f, 0.f}; }
#pragma unroll
        for (int u = 0; u < 8; ++u) { const int i = i0 + u * nth; if (i < NTOK * DM / 4) { u32x2 o; o.x = pk2(v[u][0], v[u][1]); o.y = pk2(v[u][2], v[u][3]); xb[i] = o; ((h16x4*)a->out)[i] = __builtin_convertvector(v[u], h16x4); } } }
    { float* MR = (float*)(a->ws + WS_MR); for (int i = gtid; i < NTOK; i += nth) { MR[2 * i] = 0.f; MR[2 * i + 1] = 1.f; } }
    const f32x4* m4 = (const f32x4*)a->in[1]; u32x2* mb = (u32x2*)(a->ws + WS_MISC + 2 * MiB);
    for (int i = gtid; i < 512 * DM / 4; i += nth) { const f32x4 v = m4[i]; u32x2 o; o.x = pk2(v[0], v[1]); o.y = pk2(v[2], v[3]); mb[i] = o; }
}
#define DPP_F(v, ctrl) __builtin_bit_cast(float, __builtin_amdgcn_update_dpp(0, __builtin_bit_cast(int, (v)), (ctrl), 0xF, 0xF, false))
__device__ __forceinline__ float wsum_fast(float v) {
    v += DPP_F(v, 0xB1); v += DPP_F(v, 0x4E); v += DPP_F(v, 0x141); v += DPP_F(v, 0x140);
    const int iv = __builtin_bit_cast(int, v);
    const float s0 = __builtin_bit_cast(float, __builtin_amdgcn_readlane(iv, 0)), s1 = __builtin_bit_cast(float, __builtin_amdgcn_readlane(iv, 16));
    const float s2 = __builtin_bit_cast(float, __builtin_amdgcn_readlane(iv, 32)), s3 = __builtin_bit_cast(float, __builtin_amdgcn_readlane(iv, 48));
    return (s0 + s1) + (s2 + s3);
}
__device__ __forceinline__ void ln_phase(const void* zin, float* xo, bf16_t* XB, float* MR, const float* g, const float* b, int bofs, int nblk) {
    const int lane = otid() & 63, wave = otid() >> 6;
    int row = ((int)blockIdx.x - bofs) * 8 + wave; const int rstep = nblk * 8;
    {
        f32x4 g4[2][2], b4[2][2];
#pragma unroll
        for (int j = 0; j < 2; ++j)
#pragma unroll
            for (int q = 0; q < 2; ++q) { g4[j][q] = *(const f32x4*)(g + 8 * lane + 512 * j + 4 * q); b4[j][q] = *(const f32x4*)(b + 8 * lane + 512 * j + 4 * q); }
        h16x8 nx[2];
        if (row < NTOK) {
#pragma unroll
            for (int j = 0; j < 2; ++j) nx[j] = *(const h16x8*)((const h16*)zin + (size_t)row * DM + 8 * lane + 512 * j);
        }
        for (; row < NTOK; row += rstep) {
            float v[2][8]; float s = 0.f;
#pragma unroll
            for (int j = 0; j < 2; ++j)
#pragma unroll
                for (int q = 0; q < 8; ++q) { v[j][q] = (float)nx[j][q]; s += v[j][q]; }
            if (row + rstep < NTOK) {
#pragma unroll
                for (int j = 0; j < 2; ++j) nx[j] = *(const h16x8*)((const h16*)zin + (size_t)(row + rstep) * DM + 8 * lane + 512 * j);
            }
            const float mean = wsum_fast(s) * (1.f / DM); float s2 = 0.f;
#pragma unroll
            for (int j = 0; j < 2; ++j)
#pragma unroll
                for (int q = 0; q < 8; ++q) { v[j][q] -= mean; s2 += v[j][q] * v[j][q]; }
            const float rstd = rsqrtf(wsum_fast(s2) * (1.f / DM) + 1e-5f);
            if (lane == 0) { MR[2 * row] = mean; MR[2 * row + 1] = rstd; }
#pragma unroll
            for (int j = 0; j < 2; ++j) { float y[8];
#pragma unroll
                for (int q = 0; q < 8; ++q) y[q] = v[j][q] * rstd * g4[j][q >> 2][q & 3] + b4[j][q >> 2][q & 3];
                u32x4 o; o.x = pk2(y[0], y[1]); o.y = pk2(y[2], y[3]); o.z = pk2(y[4], y[5]); o.w = pk2(y[6], y[7]);
                *(u32x4*)(XB + (size_t)row * DM + 8 * lane + 512 * j) = o; }
        }
    }
}
__device__ __forceinline__ void ln_final_load(const h16* zin, h16x8 (&zr)[16][2]) {
    const int lane = otid() & 63, wave = otid() >> 6;
#pragma unroll
    for (int i = 0; i < 16; ++i) { const int row = (int)blockIdx.x * 8 + wave + i * (int)gridDim.x * 8;
#pragma unroll
        for (int j = 0; j < 2; ++j) zr[i][j] = (row < NTOK) ? *(const h16x8*)(zin + (size_t)row * DM + 8 * lane + 512 * j) : (h16x8)(h16)0; }
}
__device__ __forceinline__ void ln_final_store(const h16x8 (&zr)[16][2], float* xo, const float* g, const float* b) {
    const int lane = otid() & 63, wave = otid() >> 6;
    f32x4 g4[2][2], b4[2][2];
#pragma unroll
    for (int j = 0; j < 2; ++j)
#pragma unroll
        for (int q = 0; q < 2; ++q) { g4[j][q] = *(const f32x4*)(g + 8 * lane + 512 * j + 4 * q); b4[j][q] = *(const f32x4*)(b + 8 * lane + 512 * j + 4 * q); }
#pragma unroll
    for (int i = 0; i < 16; ++i) { const int row = (int)blockIdx.x * 8 + wave + i * (int)gridDim.x * 8; float v[2][8]; float s = 0.f;
#pragma unroll
        for (int j = 0; j < 2; ++j)
#pragma unroll
            for (int q = 0; q < 8; ++q) { v[j][q] = (float)zr[i][j][q]; s += v[j][q]; }
        const float mean = wsum_fast(s) * (1.f / DM); float s2 = 0.f;
#pragma unroll
        for (int j = 0; j < 2; ++j)
#pragma unroll
            for (int q = 0; q < 8; ++q) { v[j][q] -= mean; s2 += v[j][q] * v[j][q]; }
        const float rstd = rsqrtf(wsum_fast(s2) * (1.f / DM) + 1e-5f);
        if (row < NTOK) {
#pragma unroll
            for (int j = 0; j < 2; ++j)
#pragma unroll
                for (int q = 0; q < 2; ++q) { f32x4 y;
#pragma unroll
                    for (int t = 0; t < 4; ++t) y[t] = v[j][4 * q + t] * rstd * g4[j][q][t] + b4[j][q][t];
                    *(f32x4*)(xo + (size_t)row * DM + 8 * lane + 512 * j + 4 * q) = y; } } }
}
constexpr int AT_LD = 528;
__device__ __forceinline__ void attn_fill(LAS unsigned char* lds, const bf16_t* src, int ld_src, int tid) {
#pragma unroll 1
    for (int hb = 0; hb < 16; hb += 8) { u32x4 t[8];
#pragma unroll
        for (int i = 0; i < 8; ++i) { const int id = (hb + i) * 512 + tid, row = id >> 5, c = id & 31; t[i] = *(const u32x4*)(src + (size_t)row * ld_src + c * 8); }
#pragma unroll
        for (int i = 0; i < 8; ++i) { const int id = (hb + i) * 512 + tid, row = id >> 5, c = id & 31; *(LAS u32x4*)(lds + row * AT_LD + c * 16) = t[i]; } }
}
__device__ __forceinline__ void attn_phase(const bf16_t* Q, const bf16_t* Kb, const bf16_t* VT, bf16_t* O, unsigned char* shm) {
    const int tid = otid(), lane = tid & 63, wave = tid >> 6, fr = lane & 15, fq = lane >> 4;
    LAS unsigned char* lds = (LAS unsigned char*)shm;
    for (int item = blockIdx.x; item < 512; item += gridDim.x) {
        const int bh = item & 7, b = bh >> 2, h = bh & 3, row0 = b * SEQ + (item >> 3) * 256 + wave * 32;
        bf16x8 qf[2][8];
#pragma unroll
        for (int t = 0; t < 2; ++t)
#pragma unroll
            for (int ks = 0; ks < 8; ++ks) qf[t][ks] = *(const bf16x8*)(Q + (size_t)(row0 + t * 16 + fr) * DM + h * 256 + ks * 32 + fq * 8);
        attn_fill(lds, Kb + (size_t)(b * 256) * DM + h * 256, DM, tid);
        __syncthreads();
        f32x4 s[2][16];
        {
            bf16x8 kf[3][2]; f32x4 a0 = {0.f, 0.f, 0.f, 0.f}, a1 = {0.f, 0.f, 0.f, 0.f};
            const LAS unsigned char* kb = lds + fr * AT_LD + fq * 16;
#pragma unroll
            for (int pg = 0; pg < 2; ++pg)
#pragma unroll
                for (int ks = 0; ks < 2; ++ks) kf[pg][ks] = *(const LAS bf16x8*)(kb + pg * 128 + ks * 64);
#pragma unroll
            for (int g = 0; g < 64; ++g) { const int mt = g >> 2, qd = g & 3;
                if (g + 2 < 64) { const int ng = g + 2; const LAS unsigned char* np = kb + (ng >> 2) * 16 * AT_LD + (ng & 3) * 128;
#pragma unroll
                    for (int ks = 0; ks < 2; ++ks) kf[ng % 3][ks] = *(const LAS bf16x8*)(np + ks * 64); }
                __builtin_amdgcn_sched_barrier(0);
#pragma unroll
                for (int ks = 0; ks < 2; ++ks) { const bf16x8 kv = kf[g % 3][ks];
                    a0 = __builtin_amdgcn_mfma_f32_16x16x32_bf16(kv, qf[0][qd * 2 + ks], a0, 0, 0, 0); a1 = __builtin_amdgcn_mfma_f32_16x16x32_bf16(kv, qf[1][qd * 2 + ks], a1, 0, 0, 0); }
                if (qd == 3) { s[0][mt] = a0; s[1][mt] = a1; a0 = (f32x4){0.f, 0.f, 0.f, 0.f}; a1 = (f32x4){0.f, 0.f, 0.f, 0.f}; }
                __builtin_amdgcn_sched_barrier(0); }
        }
        bf16x8 pb[2][8]; float inv[2];
#pragma unroll
        for (int t = 0; t < 2; ++t) { float mx = -3.0e38f;
#pragma unroll
            for (int mt = 0; mt < 16; ++mt)
#pragma unroll
                for (int q = 0; q < 4; ++q) mx = fmaxf(mx, s[t][mt][q]);
            mx = fmaxf(mx, __shfl_xor(mx, 16)); mx = fmaxf(mx, __shfl_xor(mx, 32));
            float sum = 0.f;
#pragma unroll
            for (int mt = 0; mt < 16; ++mt)
#pragma unroll
                for (int q = 0; q < 4; ++q) { const float pv = __expf(s[t][mt][q] - mx); s[t][mt][q] = pv; sum += pv; }
            sum += __shfl_xor(sum, 16); sum += __shfl_xor(sum, 32); inv[t] = 1.0f / sum;
#pragma unroll
            for (int kp = 0; kp < 8; ++kp) { u32x4 tt; tt.x = pk2(s[t][2 * kp][0], s[t][2 * kp][1]); tt.y = pk2(s[t][2 * kp][2], s[t][2 * kp][3]); tt.z = pk2(s[t][2 * kp + 1][0], s[t][2 * kp + 1][1]); tt.w = pk2(s[t][2 * kp + 1][2], s[t][2 * kp + 1][3]);
                pb[t][kp] = __builtin_bit_cast(bf16x8, tt); } }
        __syncthreads();
        attn_fill(lds, VT + (size_t)((b * 4 + h) * 256) * 256, 256, tid);
        __syncthreads();
        {
            u32x2 vA[8], vB[8]; f32x4 a0 = {0.f, 0.f, 0.f, 0.f}, a1 = {0.f, 0.f, 0.f, 0.f};
            const LAS unsigned char* vb = lds + fr * AT_LD + fq * 8;
#pragma unroll
            for (int q = 0; q < 8; ++q) vA[q] = *(const LAS u32x2*)(vb + q * 32);
#pragma unroll
            for (int g = 0; g < 32; ++g) { const int dt = g >> 1, hf = g & 1;
                if (g + 1 < 32) { const int ndt = (g + 1) >> 1, nhf = (g + 1) & 1; const LAS unsigned char* np = vb + ndt * 16 * AT_LD + nhf * 256;
#pragma unroll
                    for (int q = 0; q < 8; ++q) { if (g & 1) vA[q] = *(const LAS u32x2*)(np + q * 32); else vB[q] = *(const LAS u32x2*)(np + q * 32); } }
                __builtin_amdgcn_sched_barrier(0);
#pragma unroll
                for (int kq = 0; kq < 4; ++kq) { const u32x2 lo = (g & 1) ? vB[2 * kq] : vA[2 * kq], hi = (g & 1) ? vB[2 * kq + 1] : vA[2 * kq + 1]; u32x4 tt; tt.x = lo.x; tt.y = lo.y; tt.z = hi.x; tt.w = hi.y;
                    const bf16x8 vf = __builtin_bit_cast(bf16x8, tt);
                    a0 = __builtin_amdgcn_mfma_f32_16x16x32_bf16(vf, pb[0][hf * 4 + kq], a0, 0, 0, 0); a1 = __builtin_amdgcn_mfma_f32_16x16x32_bf16(vf, pb[1][hf * 4 + kq], a1, 0, 0, 0); }
                if (hf) { u32x2 o; o.x = pk2(a0[0] * inv[0], a0[1] * inv[0]); o.y = pk2(a0[2] * inv[0], a0[3] * inv[0]);
                    *(u32x2*)(O + (size_t)(row0 + fr) * DM + h * 256 + dt * 16 + fq * 4) = o;
                    o.x = pk2(a1[0] * inv[1], a1[1] * inv[1]); o.y = pk2(a1[2] * inv[1], a1[3] * inv[1]);
                    *(u32x2*)(O + (size_t)(row0 + 16 + fr) * DM + h * 256 + dt * 16 + fq * 4) = o;
                    a0 = (f32x4){0.f, 0.f, 0.f, 0.f}; a1 = (f32x4){0.f, 0.f, 0.f, 0.f}; }
                __builtin_amdgcn_sched_barrier(0); }
        }
        __syncthreads();
    }
}
__device__ __forceinline__ void even_core(CArgsP a, int e, unsigned char* shm) {
    const bf16_t* H = (const bf16_t*)(a->ws + WS_H); bf16_t* POOLED = (bf16_t*)(a->ws + WS_LO); bf16_t* CONCAT = (bf16_t*)(a->ws + WS_XB);
    const int tid = otid(), lane = tid & 63, wave = tid >> 6;
    LAS float* Wl = (LAS float*)shm; LAS float* Vl = Wl + 128 * 129; LAS float* st = Vl + 128 * 128;
    const float* sgw = a->in[17] + (size_t)e * 4 * 128 * 128; const float* sgb = a->in[18] + (size_t)e * 4 * 128;
    const float* lng = a->in[15] + (size_t)e * 512; const float* lnb = a->in[16] + (size_t)e * 512;
    for (int chunk = blockIdx.x; chunk < NTOK / 128; chunk += gridDim.x) {
        const int tok0 = chunk * 128, tseq0 = tok0 & (SEQ - 1);
        {
            const int c = tid, grp = c >> 7; float hist[16]; hist[0] = 0.f;
#pragma unroll
            for (int u = 1; u < 16; ++u) { const int p = u - 16; hist[u] = (tseq0 + p >= 0) ? bf2f(H[(size_t)(tok0 + p) * 1536 + c]) : 0.f; }
            for (int tb = 0; tb < 128; tb += 16) { unsigned short xs[16];
#pragma unroll
                for (int u = 0; u < 16; ++u) xs[u] = H[(size_t)(tok0 + tb + u) * 1536 + c];
#pragma unroll
                for (int u = 0; u < 16; ++u) { const int t = tb + u; const float x = bf2f(xs[u]); hist[u] = x;
                    const float s2 = x + hist[(u + 15) & 15];
                    const float s4 = s2 + hist[(u + 14) & 15] + hist[(u + 13) & 15];
                    const float s8 = s4 + (hist[(u + 12) & 15] + hist[(u + 11) & 15]) + (hist[(u + 10) & 15] + hist[(u + 9) & 15]);
                    const float s16 = s8 + ((hist[(u + 8) & 15] + hist[(u + 7) & 15]) + (hist[(u + 6) & 15] + hist[(u + 5) & 15])) + ((hist[(u + 4) & 15] + hist[(u + 3) & 15]) + (hist[(u + 2) & 15] + hist[(u + 1) & 15]));
                    const float sum = grp == 0 ? s2 : grp == 1 ? s4 : grp == 2 ? s8 : s16; const int win = 2 << grp, pos = tseq0 + t + 1;
                    const float dv = (float)(pos < win ? pos : win);
                    POOLED[(size_t)(tok0 + t) * 512 + c] = f2bf(sum / dv - x); }
            }
        }
        { bf16x8 v8a[16];
#pragma unroll
          for (int i = 0; i < 16; ++i) v8a[i] = *(const bf16x8*)(H + (size_t)(tok0 + wave + 8 * i) * 1536 + 1024 + lane * 8);
          __builtin_amdgcn_sched_barrier(0);
#pragma unroll
          for (int i = 0; i < 16; ++i) { const int t = wave + 8 * i; float f[8], s = 0.f;
#pragma unroll
            for (int q = 0; q < 8; ++q) { f[q] = bfs2f(v8a[i][q]); s += f[q]; }
            const float mean = wsum_fast(s) * (1.f / 512.f); float s2 = 0.f;
#pragma unroll
            for (int q = 0; q < 8; ++q) { const float d = f[q] - mean; s2 += d * d; }
            const float var = wsum_fast(s2) * (1.f / 512.f);
            if (lane == 0) { st[2 * t] = mean; st[2 * t + 1] = rsqrtf(var + 1e-5f); } } }
        __syncthreads();
        for (int h = 0; h < 4; ++h) {
            { f32x4 w4a[8];
#pragma unroll
              for (int it = 0; it < 8; ++it) { const int idx = it * 512 + tid, t = idx >> 5, s0 = (idx & 31) * 4; w4a[it] = *(const f32x4*)(sgw + (size_t)(h * 128 + t) * 128 + s0); }
              __builtin_amdgcn_sched_barrier(0);
#pragma unroll
              for (int it = 0; it < 8; ++it) { const int idx = it * 512 + tid, t = idx >> 5, s0 = (idx & 31) * 4;
#pragma unroll
                  for (int q = 0; q < 4; ++q) Wl[t * 129 + s0 + q] = (s0 + q <= t) ? w4a[it][q] : 0.f; } }
#pragma unroll
            for (int it = 0; it < 4; ++it) { const int idx = it * 512 + tid, s = idx >> 4, d0 = (idx & 15) * 8; const bf16x8 v8 = *(const bf16x8*)(H + (size_t)(tok0 + s) * 1536 + 1024 + h * 128 + d0);
                const float mean = st[2 * s], rstd = st[2 * s + 1];
#pragma unroll
                for (int q = 0; q < 8; ++q) Vl[s * 128 + d0 + q] = (bfs2f(v8[q]) - mean) * rstd * lng[h * 128 + d0 + q] + lnb[h * 128 + d0 + q]; }
            __syncthreads();
            const int d0 = (tid & 15) * 8, t0 = (tid >> 4) * 4;
            float acc[4][8];
#pragma unroll
            for (int i = 0; i < 4; ++i)
#pragma unroll
                for (int q = 0; q < 8; ++q) acc[i][q] = 0.f;
            for (int s = 0; s <= t0 + 3; ++s) { const f32x4 va = *(const LAS f32x4*)(Vl + s * 128 + d0), vb = *(const LAS f32x4*)(Vl + s * 128 + d0 + 4);
#pragma unroll
                for (int i = 0; i < 4; ++i) { const float w = Wl[(t0 + i) * 129 + s];
#pragma unroll
                    for (int q = 0; q < 4; ++q) { acc[i][q] += w * va[q]; acc[i][4 + q] += w * vb[q]; } } }
            bf16x8 u8a[4]; float biasa[4];
#pragma unroll
            for (int i = 0; i < 4; ++i) { u8a[i] = *(const bf16x8*)(H + (size_t)(tok0 + t0 + i) * 1536 + 512 + h * 128 + d0); biasa[i] = sgb[h * 128 + t0 + i]; }
#pragma unroll
            for (int i = 0; i < 4; ++i) { const int t = t0 + i; const float bias = biasa[i]; const bf16x8 u8 = u8a[i];
                float o[8];
#pragma unroll
                for (int q = 0; q < 8; ++q) o[q] = bfs2f(u8[q]) * (acc[i][q] + bias);
                u32x4 ov; ov.x = pk2(o[0], o[1]); ov.y = pk2(o[2], o[3]); ov.z = pk2(o[4], o[5]); ov.w = pk2(o[6], o[7]);
                *(u32x4*)(CONCAT + (size_t)(tok0 + t) * 1024 + 512 + h * 128 + d0) = ov; }
            __syncthreads();
        }
    }
}
__device__ __forceinline__ void odd_prep(CArgsP a, int e) {
    const bf16_t* H = (const bf16_t*)(a->ws + WS_H); bf16_t* AP = (bf16_t*)(a->ws + WS_AP); bf16_t* XC = (bf16_t*)(a->ws + WS_XC);
    const float* mu = a->in[21] + (size_t)e * 1792; const float* cw = a->in[32] + (size_t)e * 4 * 512; const float* cb = a->in[33] + (size_t)e * 512;
    const int gtid = blockIdx.x * 512 + otid(), nth = gridDim.x * 512;
    const bf16x8 z8 = {0, 0, 0, 0, 0, 0, 0, 0};
    float muA[8], cbX[8], cwX[4][8];
    { const int cA = (gtid & 31) * 8, cX = (gtid & 63) * 8;
#pragma unroll
      for (int q = 0; q < 8; ++q) { muA[q] = mu[1536 + cA + q]; cbX[q] = cb[cX + q];
#pragma unroll
          for (int i = 0; i < 4; ++i) cwX[i][q] = cw[i * 512 + cX + q]; } }
    for (int it0 = gtid; it0 < NTOK * 32; it0 += nth * 4) { bf16x8 cur[4], prv[4];
#pragma unroll
        for (int u = 0; u < 4; ++u) { const int it = it0 + u * nth, tok = it >> 5, c0 = (it & 31) * 8; const bool ok = it < NTOK * 32;
            cur[u] = ok ? *(const bf16x8*)(H + (size_t)tok * 2816 + 1536 + c0) : z8;
            prv[u] = (ok && (tok & (SEQ - 1))) ? *(const bf16x8*)(H + (size_t)(tok - 1) * 2816 + 1536 + c0) : z8; }
#pragma unroll
        for (int u = 0; u < 4; ++u) { const int it = it0 + u * nth, tok = it >> 5, c0 = (it & 31) * 8; if (it < NTOK * 32) { float v[8];
#pragma unroll
            for (int q = 0; q < 8; ++q) { const float c = bfs2f(cur[u][q]), z = c + muA[q] * (bfs2f(prv[u][q]) - c); v[q] = c0 < 64 ? tanhf_(z) : (c0 < 128 ? z : sigmoidf_(z)); }
            u32x4 o; o.x = pk2(v[0], v[1]); o.y = pk2(v[2], v[3]); o.z = pk2(v[4], v[5]); o.w = pk2(v[6], v[7]); *(u32x4*)(AP + (size_t)tok * 256 + c0) = o; } } }
    for (int it0 = gtid; it0 < NTOK * 64; it0 += nth * 4) { bf16x8 x8[4][4];
#pragma unroll
        for (int u = 0; u < 4; ++u) { const int it = it0 + u * nth, tok = it >> 6, c0 = (it & 63) * 8, tseq = tok & (SEQ - 1); const bool ok = it < NTOK * 64;
#pragma unroll
            for (int i = 0; i < 4; ++i) x8[u][i] = (ok && tseq - 3 + i >= 0) ? *(const bf16x8*)(H + (size_t)(tok - 3 + i) * 2816 + 2304 + c0) : z8; }
#pragma unroll
        for (int u = 0; u < 4; ++u) { const int it = it0 + u * nth, tok = it >> 6, c0 = (it & 63) * 8; if (it < NTOK * 64) { float v[8];
#pragma unroll
            for (int q = 0; q < 8; ++q) v[q] = cbX[q];
#pragma unroll
            for (int i = 0; i < 4; ++i)
#pragma unroll
                for (int q = 0; q < 8; ++q) v[q] += cwX[i][q] * bfs2f(x8[u][i][q]);
            u32x4 o; o.x = pk2(v[0], v[1]); o.y = pk2(v[2], v[3]); o.z = pk2(v[4], v[5]); o.w = pk2(v[6], v[7]); *(u32x4*)(XC + (size_t)tok * 512 + c0) = o; } } }
}
constexpr int RW_STEP = 448, RW_WAVE = 8 * RW_STEP + 8;
typedef float f32x2 __attribute__((ext_vector_type(2)));
__device__ __forceinline__ float red8(float v) {
    v += __builtin_bit_cast(float, __builtin_amdgcn_update_dpp(0, __builtin_bit_cast(int, v), 0xB1, 0xF, 0xF, false));
    v += __builtin_bit_cast(float, __builtin_amdgcn_update_dpp(0, __builtin_bit_cast(int, v), 0x4E, 0xF, 0xF, false));
    v += __builtin_bit_cast(float, __builtin_amdgcn_update_dpp(0, __builtin_bit_cast(int, v), 0x141, 0xF, 0xF, false));
    return v;
}
__device__ __forceinline__ float red4(float v) { v += DPP_F(v, 0xB1); v += DPP_F(v, 0x4E); return v; }
#define LD8P(dst, ptr) do { _Pragma("unroll") for (int _q = 0; _q < 4; ++_q) { const f32x4 _t = *(const LAS f32x4*)((ptr) + 4 * _q); dst[2 * _q] = (f32x2){_t[0], _t[1]}; dst[2 * _q + 1] = (f32x2){_t[2], _t[3]}; } } while (0)
template <int MODE> __device__ __forceinline__ void rwkv_scan(CArgsP a, int e, int bh, int c, LAS float* wl) {
    const int lane = otid() & 63, b = bh >> 3, h = bh & 7, cj = h * 64 + lane, ib = lane >> 2, jb = lane & 3;
    const bf16_t* H = (const bf16_t*)(a->ws + WS_H); const bf16_t* LO = (const bf16_t*)(a->ws + WS_LO); bf16_t* CONCAT = (bf16_t*)(a->ws + WS_XB);
    float* Lc = (float*)(a->ws + WS_AP); float* Mc = Lc + (size_t)16 * NCH * 4096; float* Ss = Mc + (size_t)16 * NCH * 4096;
    const size_t sidx = ((size_t)bh * NCH + c) * 4096 + (size_t)(ib * 4) * 64 + jb * 16;
    const int tok0 = b * SEQ + c * TCH;
    const float* mu = a->in[21] + (size_t)e * 1792;
    const float mu_r = mu[cj], mu_k = mu[512 + cj], mu_v = mu[1024 + cj], kkc = a->in[27][e * 512 + cj], kac = a->in[28][e * 512 + cj], rkc = a->in[29][e * 512 + cj];
    const float gng = a->in[30][e * 512 + cj], gnb = a->in[31][e * 512 + cj];
    const float w0c = a->in[22][e * 512 + cj], a0c = a->in[24][e * 512 + cj];
    f32x2 S[4][8];
    if (MODE == 2) {
#pragma unroll
        for (int r = 0; r < 4; ++r)
#pragma unroll
            for (int q = 0; q < 4; ++q) { const f32x4 t = *(const f32x4*)(Ss + sidx + r * 64 + 4 * q); S[r][2 * q] = (f32x2){t[0], t[1]}; S[r][2 * q + 1] = (f32x2){t[2], t[3]}; }
    } else {
#pragma unroll
        for (int r = 0; r < 4; ++r)
#pragma unroll
            for (int q = 0; q < 8; ++q) { const int row = ib * 4 + r, col = jb * 16 + 2 * q; S[r][q][0] = (MODE == 1 && row == col) ? 1.f : 0.f; S[r][q][1] = (MODE == 1 && row == col + 1) ? 1.f : 0.f; }
    }
    float pr = 0.f, pk = 0.f, pv = 0.f;
    if (c > 0) { const bf16_t* hp = H + (size_t)(tok0 - 1) * 2816 + cj; pr = bf2f(hp[0]); pk = bf2f(hp[512]); pv = bf2f(hp[1024]); }
    unsigned short rw[8][6];
#define RW_LOAD(T0) do { _Pragma("unroll") for (int s = 0; s < 8; ++s) { const size_t tok = (size_t)(tok0 + (T0) + s); const bf16_t* hp = H + tok * 2816 + cj; const bf16_t* lp = LO + tok * 1536 + cj; \
        rw[s][0] = hp[0]; rw[s][1] = hp[512]; rw[s][2] = hp[1024]; rw[s][3] = lp[0]; rw[s][4] = lp[512]; if (MODE == 2) rw[s][5] = lp[1024]; } } while (0)
    RW_LOAD(0);
    for (int t0 = 0; t0 < TCH; t0 += 8) {
#pragma unroll
        for (int s = 0; s < 8; ++s) {
            const float rr = bf2f(rw[s][0]), kr = bf2f(rw[s][1]), vr = bf2f(rw[s][2]), ee = __expf(-softplusf_(-(w0c + bf2f(rw[s][3]))) - 0.5f), aa = sigmoidf_(a0c + bf2f(rw[s][4]));
            const float rl = rr + mu_r * (pr - rr), kl = kr + mu_k * (pk - kr), vl = vr + mu_v * (pv - vr); pr = rr; pk = kr; pv = vr;
            const float kkj = kl * kkc, ss = wsum_fast(kkj * kkj), kn = kkj * rsqrtf(fmaxf(ss, 1e-24f));
            const float kp = kl * (1.0f + (aa - 1.0f) * kac), dec = __expf(-ee);
            LAS float* base = wl + s * RW_STEP;
            base[lane] = -kn; base[64 + lane] = dec; base[128 + lane] = kn * aa; base[192 + lane] = kp; base[320 + lane] = vl;
            if (MODE == 2) { base[256 + lane] = rl; base[384 + lane] = bf2f(rw[s][5]); const float bd = wsum_fast(rl * kp * rkc); if (lane == 0) wl[8 * RW_STEP + s] = bd; } }
        if (t0 + 8 < TCH) RW_LOAD(t0 + 8);
        LDS_SYNC_WAVE();
#pragma unroll 2
        for (int s = 0; s < 8; ++s) { const LAS float* base = wl + s * RW_STEP;
            f32x2 av[8], dc[8], bv[8], kp[8]; f32x4 vr4 = {0.f, 0.f, 0.f, 0.f};
            LD8P(av, base + jb * 16); LD8P(dc, base + 64 + jb * 16); LD8P(bv, base + 128 + jb * 16);
            if (MODE != 1) { LD8P(kp, base + 192 + jb * 16); vr4 = *(const LAS f32x4*)(base + 320 + ib * 4); }
            float sa[4];
#pragma unroll
            for (int r = 0; r < 4; ++r) { f32x2 p = S[r][0] * av[0];
#pragma unroll
                for (int q = 1; q < 8; ++q) p += S[r][q] * av[q];
                sa[r] = red4(p[0] + p[1]); }
#pragma unroll
            for (int r = 0; r < 4; ++r) { const f32x2 sa2 = (f32x2){sa[r], sa[r]};
                if (MODE == 1) {
#pragma unroll
                    for (int q = 0; q < 8; ++q) S[r][q] = S[r][q] * dc[q] + sa2 * bv[q];
                } else { const f32x2 v2 = (f32x2){vr4[r], vr4[r]};
#pragma unroll
                    for (int q = 0; q < 8; ++q) S[r][q] = S[r][q] * dc[q] + (sa2 * bv[q] + v2 * kp[q]); } }
            if (MODE == 2) { f32x2 rv[8]; LD8P(rv, base + 256 + jb * 16);
                float y = 0.f;
#pragma unroll
                for (int r = 0; r < 4; ++r) { f32x2 p = S[r][0] * rv[0];
#pragma unroll
                    for (int q = 1; q < 8; ++q) p += S[r][q] * rv[q];
                    const float yr = red4(p[0] + p[1]); y = (jb == r) ? yr : y; }
                const float vi = base[320 + lane];
                const float mean = wsum_fast(y) * (1.f / 64.f), ey2 = wsum_fast(y * y) * (1.f / 64.f), dl = y - mean, var = fmaxf(ey2 - mean * mean, 0.f);
                const float yn = dl * rsqrtf(var + 64e-5f) * gng + gnb;
                const float o = (yn + wl[8 * RW_STEP + s] * vi) * base[384 + lane];
                CONCAT[(size_t)(tok0 + t0 + s) * 1024 + cj] = f2bf(o); } }
        LDS_SYNC_WAVE();
    }
#undef RW_LOAD
    if (MODE != 2) { float* dst = (MODE == 0 ? Lc : Mc) + sidx;
#pragma unroll
        for (int r = 0; r < 4; ++r)
#pragma unroll
            for (int q = 0; q < 4; ++q) { f32x4 t; t[0] = S[r][2 * q][0]; t[1] = S[r][2 * q][1]; t[2] = S[r][2 * q + 1][0]; t[3] = S[r][2 * q + 1][1]; *(f32x4*)(dst + r * 64 + 4 * q) = t; } }
}
template <int MODE> __device__ __forceinline__ void rwkv_pass1_pair(CArgsP a, int e, int bh, int c, LAS float* pl) {
    const int lane = otid() & 63, b = bh >> 3, h = bh & 7, cj = h * 64 + lane, ib = lane >> 2, jb = lane & 3;
    const bf16_t* H = (const bf16_t*)(a->ws + WS_H); const bf16_t* LO = (const bf16_t*)(a->ws + WS_LO);
    float* Lc = (float*)(a->ws + WS_AP); float* Mc = Lc + (size_t)16 * NCH * 4096;
    const size_t sidx = ((size_t)bh * NCH + c) * 4096 + (size_t)(ib * 4) * 64 + jb * 16;
    const int tok0 = b * SEQ + c * TCH;
    const float* mu = a->in[21] + (size_t)e * 1792;
    const float mu_k = mu[512 + cj], mu_v = mu[1024 + cj], kkc = a->in[27][e * 512 + cj], kac = a->in[28][e * 512 + cj];
    const float w0c = a->in[22][e * 512 + cj], a0c = a->in[24][e * 512 + cj];
    f32x2 S[4][8];
#pragma unroll
    for (int r = 0; r < 4; ++r)
#pragma unroll
        for (int q = 0; q < 8; ++q) { const int row = ib * 4 + r, col = jb * 16 + 2 * q; S[r][q][0] = (MODE == 1 && row == col) ? 1.f : 0.f; S[r][q][1] = (MODE == 1 && row == col + 1) ? 1.f : 0.f; }
    unsigned short rw[5][4];
#define RW1_LOAD(T0) do { _Pragma("unroll") for (int s = 0; s < 5; ++s) { const int tk = tok0 + (T0) + MODE * 4 + s - 1; const bf16_t* hp = H + (size_t)tk * 2816 + cj; const bf16_t* lp = LO + (size_t)tk * 1536 + cj; \
        if (s == 0) { const bool have = (c > 0) || ((T0) + MODE * 4 > 0); rw[0][0] = have ? hp[512] : (unsigned short)0; rw[0][1] = have ? hp[1024] : (unsigned short)0; } \
        else { rw[s][0] = hp[512]; rw[s][1] = hp[1024]; rw[s][2] = lp[0]; rw[s][3] = lp[512]; } } } while (0)
    RW1_LOAD(0);
    for (int t0 = 0; t0 < TCH; t0 += 8) {
        float pk = bf2f(rw[0][0]), pv = bf2f(rw[0][1]);
#pragma unroll
        for (int u = 0; u < 4; ++u) { const int s = MODE * 4 + u;
            const float kr = bf2f(rw[u + 1][0]), vr = bf2f(rw[u + 1][1]), ee = __expf(-softplusf_(-(w0c + bf2f(rw[u + 1][2]))) - 0.5f), aa = sigmoidf_(a0c + bf2f(rw[u + 1][3]));
            const float kl = kr + mu_k * (pk - kr), vl = vr + mu_v * (pv - vr); pk = kr; pv = vr;
            const float kkj = kl * kkc, ss = wsum_fast(kkj * kkj), kn = kkj * rsqrtf(fmaxf(ss, 1e-24f));
            const float kp = kl * (1.0f + (aa - 1.0f) * kac), dec = __expf(-ee);
            LAS float* base = pl + s * RW_STEP;
            base[lane] = -kn; base[64 + lane] = dec; base[128 + lane] = kn * aa; base[192 + lane] = kp; base[320 + lane] = vl; }
        if (t0 + 8 < TCH) RW1_LOAD(t0 + 8);
        __syncthreads();
#pragma unroll 2
        for (int s = 0; s < 8; ++s) { const LAS float* base = pl + s * RW_STEP;
            f32x2 av[8], dc[8], bv[8], kp[8]; f32x4 vr4 = {0.f, 0.f, 0.f, 0.f};
            LD8P(av, base + jb * 16); LD8P(dc, base + 64 + jb * 16); LD8P(bv, base + 128 + jb * 16);
            if (MODE == 0) { LD8P(kp, base + 192 + jb * 16); vr4 = *(const LAS f32x4*)(base + 320 + ib * 4); }
            float sa[4];
#pragma unroll
            for (int r = 0; r < 4; ++r) { f32x2 pp = S[r][0] * av[0];
#pragma unroll
                for (int q = 1; q < 8; ++q) pp += S[r][q] * av[q];
                sa[r] = red4(pp[0] + pp[1]); }
#pragma unroll
            for (int r = 0; r < 4; ++r) { const f32x2 sa2 = (f32x2){sa[r], sa[r]};
                if (MODE == 1) {
#pragma unroll
                    for (int q = 0; q < 8; ++q) S[r][q] = S[r][q] * dc[q] + sa2 * bv[q];
                } else { const f32x2 v2 = (f32x2){vr4[r], vr4[r]};
#pragma unroll
                    for (int q = 0; q < 8; ++q) S[r][q] = S[r][q] * dc[q] + (sa2 * bv[q] + v2 * kp[q]); } } }
        __syncthreads();
    }
#undef RW1_LOAD
    float* dst = (MODE == 0 ? Lc : Mc) + sidx;
#pragma unroll
    for (int r = 0; r < 4; ++r)
#pragma unroll
        for (int q = 0; q < 4; ++q) { f32x4 t; t[0] = S[r][2 * q][0]; t[1] = S[r][2 * q][1]; t[2] = S[r][2 * q + 1][0]; t[3] = S[r][2 * q + 1][1]; *(f32x4*)(dst + r * 64 + 4 * q) = t; }
}
#define LD4P(dst, ptr) do { const f32x4 _t0 = *(const LAS f32x4*)(ptr), _t1 = *(const LAS f32x4*)((ptr) + 4); dst[0] = (f32x2){_t0[0], _t0[1]}; dst[1] = (f32x2){_t0[2], _t0[3]}; dst[2] = (f32x2){_t1[0], _t1[1]}; dst[3] = (f32x2){_t1[2], _t1[3]}; } while (0)
constexpr int RW_PAIR = RW_WAVE + 1024;
__device__ __forceinline__ void rwkv_pass2_pair(CArgsP a, int e, int bh, int c, int hf, LAS float* pl) {
    const int lane = otid() & 63, b = bh >> 3, h = bh & 7, cj = h * 64 + lane, ib = lane >> 3, jb = lane & 7;
    const bf16_t* H = (const bf16_t*)(a->ws + WS_H); const bf16_t* LO = (const bf16_t*)(a->ws + WS_LO); bf16_t* CONCAT = (bf16_t*)(a->ws + WS_XB);
    const float* Ss = (const float*)(a->ws + WS_AP) + (size_t)2 * 16 * NCH * 4096;
    const size_t sidx = ((size_t)bh * NCH + c) * 4096 + (size_t)(hf * 32 + ib * 4) * 64 + jb * 8;
    const int tok0 = b * SEQ + c * TCH;
    const float* mu = a->in[21] + (size_t)e * 1792;
    const float mu_r = mu[cj], mu_k = mu[512 + cj], mu_v = mu[1024 + cj], kkc = a->in[27][e * 512 + cj], kac = a->in[28][e * 512 + cj], rkc = a->in[29][e * 512 + cj];
    const float gng = a->in[30][e * 512 + cj], gnb = a->in[31][e * 512 + cj];
    const float w0c = a->in[22][e * 512 + cj], a0c = a->in[24][e * 512 + cj];
    LAS float* yb = pl + RW_WAVE;
    f32x2 S[4][4];
#pragma unroll
    for (int r = 0; r < 4; ++r) { const f32x4 t0 = *(const f32x4*)(Ss + sidx + r * 64), t1 = *(const f32x4*)(Ss + sidx + r * 64 + 4);
        S[r][0] = (f32x2){t0[0], t0[1]}; S[r][1] = (f32x2){t0[2], t0[3]}; S[r][2] = (f32x2){t1[0], t1[1]}; S[r][3] = (f32x2){t1[2], t1[3]}; }
    unsigned short rw[5][6];
#define RW2_LOAD(T0) do { _Pragma("unroll") for (int s = 0; s < 5; ++s) { const int tk = tok0 + (T0) + hf * 4 + s - 1; const bool ok = ((tk & (SEQ - 1)) != SEQ - 1) || s > 0 || true; \
        const bf16_t* hp = H + (size_t)tk * 2816 + cj; const bf16_t* lp = LO + (size_t)tk * 1536 + cj; (void)ok; \
        if (s == 0) { const bool have = (c > 0) || ((T0) + hf * 4 > 0); rw[0][0] = have ? hp[0] : (unsigned short)0; rw[0][1] = have ? hp[512] : (unsigned short)0; rw[0][2] = have ? hp[1024] : (unsigned short)0; } \
        else { rw[s][0] = hp[0]; rw[s][1] = hp[512]; rw[s][2] = hp[1024]; rw[s][3] = lp[0]; rw[s][4] = lp[512]; rw[s][5] = lp[1024]; } } } while (0)
    RW2_LOAD(0);
    for (int t0 = 0; t0 < TCH; t0 += 8) {
        float pr = bf2f(rw[0][0]), pk = bf2f(rw[0][1]), pv = bf2f(rw[0][2]);
#pragma unroll
        for (int u = 0; u < 4; ++u) { const int s = hf * 4 + u;
            const float rr = bf2f(rw[u + 1][0]), kr = bf2f(rw[u + 1][1]), vr = bf2f(rw[u + 1][2]), ee = __expf(-softplusf_(-(w0c + bf2f(rw[u + 1][3]))) - 0.5f), aa = sigmoidf_(a0c + bf2f(rw[u + 1][4]));
            const float rl = rr + mu_r * (pr - rr), kl = kr + mu_k * (pk - kr), vl = vr + mu_v * (pv - vr); pr = rr; pk = kr; pv = vr;
            const float kkj = kl * kkc, ss = wsum_fast(kkj * kkj), kn = kkj * rsqrtf(fmaxf(ss, 1e-24f));
            const float kp = kl * (1.0f + (aa - 1.0f) * kac), dec = __expf(-ee);
            LAS float* base = pl + s * RW_STEP;
            base[lane] = -kn; base[64 + lane] = dec; base[128 + lane] = kn * aa; base[192 + lane] = kp; base[256 + lane] = rl; base[320 + lane] = vl; base[384 + lane] = bf2f(rw[u + 1][5]);
            const float bd = wsum_fast(rl * kp * rkc); if (lane == 0) pl[8 * RW_STEP + s] = bd; }
        if (t0 + 8 < TCH) RW2_LOAD(t0 + 8);
        __syncthreads();
#pragma unroll 2
        for (int s = 0; s < 8; ++s) { const LAS float* base = pl + s * RW_STEP;
            f32x2 av[4], dc[4], bv[4], kp[4], rv[4];
            LD4P(av, base + jb * 8); LD4P(dc, base + 64 + jb * 8); LD4P(bv, base + 128 + jb * 8); LD4P(kp, base + 192 + jb * 8); LD4P(rv, base + 256 + jb * 8);
            const f32x4 v4 = *(const LAS f32x4*)(base + 320 + hf * 32 + ib * 4);
            float sa[4];
#pragma unroll
            for (int r = 0; r < 4; ++r) { f32x2 pp = S[r][0] * av[0]; pp += S[r][1] * av[1]; pp += S[r][2] * av[2]; pp += S[r][3] * av[3]; sa[r] = red8(pp[0] + pp[1]); }
            float ysel = 0.f;
#pragma unroll
            for (int r = 0; r < 4; ++r) { const f32x2 sa2 = (f32x2){sa[r], sa[r]}, v2 = (f32x2){v4[r], v4[r]};
#pragma unroll
                for (int q = 0; q < 4; ++q) S[r][q] = S[r][q] * dc[q] + (sa2 * bv[q] + v2 * kp[q]);
                f32x2 pp = S[r][0] * rv[0]; pp += S[r][1] * rv[1]; pp += S[r][2] * rv[2]; pp += S[r][3] * rv[3]; const float yr = red8(pp[0] + pp[1]); ysel = (jb == r) ? yr : ysel; }
            if (jb < 4) yb[s * 64 + hf * 32 + ib * 4 + jb] = ysel; }
        __syncthreads();
#pragma unroll
        for (int u = 0; u < 4; ++u) { const int s = hf * 4 + u; const LAS float* base = pl + s * RW_STEP; const float y = yb[s * 64 + lane], vi = base[320 + lane];
            const float mean = wsum_fast(y) * (1.f / 64.f), ey2 = wsum_fast(y * y) * (1.f / 64.f), dl = y - mean, var = fmaxf(ey2 - mean * mean, 0.f);
            const float yn = dl * rsqrtf(var + 64e-5f) * gng + gnb;
            const float o = (yn + pl[8 * RW_STEP + s] * vi) * base[384 + lane];
            CONCAT[(size_t)(tok0 + t0 + s) * 1024 + cj] = f2bf(o); }
        __syncthreads();
    }
#undef RW2_LOAD
}
__device__ __forceinline__ void rwkv_combine(CArgsP a, int blk, unsigned char* shm) {
    float* Lc = (float*)(a->ws + WS_AP); float* Mc = Lc + (size_t)16 * NCH * 4096; float* Ss = Mc + (size_t)16 * NCH * 4096;
    LAS float* Sc = (LAS float*)shm; LAS float* Mb = Sc + 512;
    const int tid = otid(), bh = blk >> 3, rg = blk & 7, r = tid >> 6, j = tid & 63;
    const size_t mbase = (size_t)bh * NCH * 4096, rowoff = (size_t)(rg * 8 + r) * 64 + j;
    float cur = 0.f;
    f32x4 mn0 = *(const f32x4*)(Mc + mbase + tid * 8), mn1 = *(const f32x4*)(Mc + mbase + tid * 8 + 4); float ln = Lc[mbase + rowoff];
    for (int c = 0; c < NCH; ++c) {
        Ss[mbase + (size_t)c * 4096 + rowoff] = cur;
        Sc[r * 64 + j] = cur; *(LAS f32x4*)(Mb + tid * 8) = mn0; *(LAS f32x4*)(Mb + tid * 8 + 4) = mn1;
        float acc = ln;
        __syncthreads();
        if (c + 1 < NCH) { const size_t nb = mbase + (size_t)(c + 1) * 4096; mn0 = *(const f32x4*)(Mc + nb + tid * 8); mn1 = *(const f32x4*)(Mc + nb + tid * 8 + 4); ln = Lc[nb + rowoff]; }
#pragma unroll
        for (int k = 0; k < 64; k += 4) { const f32x4 s4 = *(const LAS f32x4*)(Sc + r * 64 + k);
            acc += s4[0] * Mb[k * 64 + j]; acc += s4[1] * Mb[(k + 1) * 64 + j]; acc += s4[2] * Mb[(k + 2) * 64 + j]; acc += s4[3] * Mb[(k + 3) * 64 + j]; }
        cur = acc;
        __syncthreads();
    }
}
__device__ __forceinline__ void lru_pass_a(CArgsP a, int gtid, int nth) {
    const bf16_t* LGA = (const bf16_t*)(a->ws + WS_LA); const bf16_t* BX = LGA + (size_t)NTOK * 512; float2* PE = (float2*)(a->ws + WS_MISC + 3 * MiB);
    for (int it = gtid; it < 2 * NLCH * 512; it += nth) { const int ch = it & 511, cc = (it >> 9) & (NLCH - 1), b = it >> 16; const size_t base = ((size_t)b * SEQ + (size_t)cc * LCH) * 512 + ch;
        float P = 1.f, E = 0.f;
#pragma unroll 1
        for (int tb = 0; tb < LCH; tb += 16) { unsigned short la[16], bx[16];
#pragma unroll
            for (int u = 0; u < 16; ++u) { la[u] = LGA[base + (size_t)(tb + u) * 512]; bx[u] = BX[base + (size_t)(tb + u) * 512]; }
            __builtin_amdgcn_sched_barrier(0);
#pragma unroll
            for (int u = 0; u < 16; ++u) { const float av = __expf(bf2f(la[u])); P *= av; E = av * E + bf2f(bx[u]); } }
        PE[it] = make_float2(P, E); }
}
__device__ __forceinline__ void lru_pass_c2(CArgsP a, int gtid, int nth) {
    const unsigned* LGA = (const unsigned*)(a->ws + WS_LA); const unsigned* BX = LGA + (size_t)NTOK * 256; const f32x4* PE = (const f32x4*)(a->ws + WS_MISC + 3 * MiB);
    const unsigned* H = (const unsigned*)(a->ws + WS_H); unsigned* CONCAT = (unsigned*)(a->ws + WS_XB);
    for (int it = gtid; it < 2 * NLCH * 256; it += nth) { const int chp = it & 255, cc = (it >> 8) & (NLCH - 1), b = it >> 15; const size_t tokb = (size_t)b * SEQ + (size_t)cc * LCH;
        float h0 = 0.f, h1 = 0.f;
#pragma unroll 1
        for (int c0 = 0; c0 < cc; c0 += 8) { f32x4 pe[8];
#pragma unroll
            for (int u = 0; u < 8; ++u) pe[u] = (c0 + u < cc) ? PE[(b << 15) + ((c0 + u) << 8) + chp] : (f32x4){1.f, 0.f, 1.f, 0.f};
            __builtin_amdgcn_sched_barrier(0);
#pragma unroll
            for (int u = 0; u < 8; ++u) { h0 = pe[u][0] * h0 + pe[u][1]; h1 = pe[u][2] * h1 + pe[u][3]; } }
        const unsigned* lp = LGA + tokb * 256 + chp; const unsigned* bp = BX + tokb * 256 + chp; const unsigned* gp = H + tokb * 1408 + 896 + chp; unsigned* op = CONCAT + tokb * 512 + 256 + chp;
#pragma unroll 1
        for (int tb = 0; tb < LCH; tb += 8) { unsigned la[8], bx[8], gt[8];
#pragma unroll
            for (int u = 0; u < 8; ++u) { la[u] = lp[(tb + u) * 256]; bx[u] = bp[(tb + u) * 256]; gt[u] = gp[(size_t)(tb + u) * 1408]; }
#pragma unroll
            for (int u = 0; u < 8; ++u) {
                h0 = __expf(__uint_as_float(la[u] << 16)) * h0 + __uint_as_float(bx[u] << 16); h1 = __expf(__uint_as_float(la[u] & 0xffff0000u)) * h1 + __uint_as_float(bx[u] & 0xffff0000u);
                op[(tb + u) * 512] = pk2(h0 * geluf_(__uint_as_float(gt[u] << 16)), h1 * geluf_(__uint_as_float(gt[u] & 0xffff0000u))); } } }
}
__device__ __forceinline__ void lru_carry(CArgsP a, int gtid) {
    if (gtid >= 1024) return;
    const float2* PE = (const float2*)(a->ws + WS_MISC + 3 * MiB); float* CY = (float*)(a->ws + WS_MR + 512 * 1024);
    const int b = gtid >> 9, ch = gtid & 511; float hsv = 0.f;
#pragma unroll 16
    for (int cc = 0; cc < NLCH; ++cc) { const int idx = (b << 16) + (cc << 9) + ch; const float2 pe = PE[idx]; CY[idx] = hsv; hsv = pe.x * hsv + pe.y; }
}
__device__ __forceinline__ void lru_pass_c(CArgsP a, int gtid, int nth) {
    const bf16_t* LGA = (const bf16_t*)(a->ws + WS_LA); const bf16_t* BX = LGA + (size_t)NTOK * 512; const float2* PE = (const float2*)(a->ws + WS_MISC + 3 * MiB);
    const bf16_t* H = (const bf16_t*)(a->ws + WS_H); bf16_t* CONCAT = (bf16_t*)(a->ws + WS_XB);
    for (int it = gtid; it < 2 * NLCH * 512; it += nth) { const int ch = it & 511, cc = (it >> 9) & (NLCH - 1), b = it >> 16; const size_t tokb = (size_t)b * SEQ + (size_t)cc * LCH;
        float hsv = ((const float*)(a->ws + WS_MR + 512 * 1024))[it];
#pragma unroll 8
        for (int t = 0; t < LCH; ++t) { const size_t tok = tokb + t; const float av = __expf(bf2f(LGA[tok * 512 + ch])), bx = bf2f(BX[tok * 512 + ch]); hsv = av * hsv + bx;
            const float gt = bf2f(H[tok * 2816 + 1792 + ch]);
            CONCAT[tok * 1024 + 512 + ch] = f2bf(hsv * geluf_(gt)); } }
}
#ifndef REP_FFN
#define REP_FFN 1
#endif
#ifndef REP_P1
#define REP_P1 1
#endif
#ifndef REP_CB
#define REP_CB 1
#endif
#ifndef REP_P2
#define REP_P2 1
#endif
#ifndef REP_OPRE
#define REP_OPRE 1
#endif
#ifndef REP_AE
#define REP_AE 1
#endif
#ifndef REP_AT
#define REP_AT 1
#endif
#ifndef REP_LN
#define REP_LN 1
#endif
#ifndef REP_IN
#define REP_IN 1
#endif
#ifndef REP_CV
#define REP_CV 1
#endif
#ifndef REP_LC
#define REP_LC 1
#endif
#ifndef REP_R2
#define REP_R2 1
#endif
#ifndef REP_SYNC
#define REP_SYNC 0
#endif
#ifdef SKIP_E
#define SK_E(x)
#else
#define SK_E(x) x
#endif
#ifdef SKIP_O
#define SK_O(x)
#else
#define SK_O(x) x
#endif
#ifdef SKIP_S
#define SK_S(x)
#else
#define SK_S(x) x
#endif
#ifdef SKIP_A
#define SK_A(x)
#else
#define SK_A(x) x
#endif
__global__ __launch_bounds__(512, 2) void mega_fwd(Args a_unused) {
    extern __shared__ __attribute__((aligned(16))) unsigned char shm[];
    cg::grid_group grid = cg::this_grid();
#define a argp()
#define ws (a->ws)
#define P_W ((bf16_t*)(ws + WS_W))
#define P_XB ((bf16_t*)(ws + WS_XB))
#define P_H ((bf16_t*)(ws + WS_H))
#define P_LO ((bf16_t*)(ws + WS_LO))
#define P_AP ((bf16_t*)(ws + WS_AP))
#define P_XC ((bf16_t*)(ws + WS_XC))
#define P_LGA ((bf16_t*)(ws + WS_LA))
#define P_BX (P_LGA + (size_t)NTOK * 512)
#define P_Kb ((bf16_t*)(ws + WS_MISC))
#define P_VT ((bf16_t*)(ws + WS_MISC + MiB))
#define P_MEMB ((bf16_t*)(ws + WS_MISC + 2 * MiB))
#define P_Qb P_H
#define P_Ob (P_H + (size_t)NTOK * DM)
    volatile LAS unsigned* xst = (volatile LAS unsigned*)(shm + LDS_BYTES - 16);
    if (otid() == 0) { xst[0] = 0u; xst[1] = 0u; }
    __syncthreads();
    const XcdBarrier xb = xcd_barrier_post((unsigned*)(ws + WS_BAR), xst);
    prologue_cast(a); convert_layer(a, 0, shm); grid.sync();
#define GSYNC() xcd_barrier(xb)
    for (int ls = 0; ls < 16; ++ls) {
        const int l = ls >> 2, st = ls & 3, e = l >> 1, odd = l & 1;
        const bf16_t* A2; const bf16_t* W2; int K2; float scale2;
        if (st == 0 || st == 3) {
            EpiSwiGLU E; E.O = P_H;
            for (int rep = 0; rep < REP_FFN; ++rep) { run_gemm(shm, P_XB, P_W + (st == 0 ? W_FF1IN : W_FF2IN), NTOK, 5632, 1024, E); GSYNC(); }
            A2 = P_H; W2 = P_W + (st == 0 ? W_FF1OUT : W_FF2OUT); K2 = 2816; scale2 = 0.5f;
        } else {
            EpiBf16g E; int N; const bf16_t* Win; E.O = P_H;
            if (st == 1) { Win = P_W + W_MIXIN; E.scale = 1.0f; if (odd) { N = 2816; E.ldc = 2816; E.gelu_from = 1000; } else { N = 1536; E.ldc = 1536; E.gelu_from = 2; } }
            else { Win = P_W + W_Q; N = 1024; E.ldc = 1024; E.gelu_from = 1000; E.scale = 0.0625f; }
            for (int rep = 0; rep < REP_IN; ++rep) { run_gemm(shm, P_XB, Win, NTOK, N, 1024, E); if (rep + 1 < REP_IN) GSYNC(); }
            GSYNC();
            if (st == 1) {
                if (!odd) {
                    for (int rep = 0; rep < REP_AE; ++rep) { SK_E(even_core(a, e, shm);) GSYNC(); }
                    EpiPool EP; EP.O = P_XB; EP.scl = a->in[14] + (size_t)e * 512;
                    run_gemm(shm, P_LO, P_W + W_AUX1, NTOK, 512, 512, EP); GSYNC();
                } else {
                    for (int rep = 0; rep < REP_OPRE; ++rep) {
                        SK_O(odd_prep(a, e);) GSYNC();
                        { EpiBf16g EL; EL.O = P_LO; EL.ldc = 1536; EL.gelu_from = 1000; EL.scale = 1.0f; run_gemm(shm, P_AP, P_W + W_AUX1, NTOK, 1536, 256, EL); }
                        { EpiLru ER; ER.XC = P_XC; ER.b_a = a->in[35] + (size_t)e * 512; ER.b_x = a->in[37] + (size_t)e * 512; ER.lam = a->in[38] + (size_t)e * 512; ER.LGA = P_LGA; ER.BX = P_BX;
                          run_gemm(shm, P_XC, P_W + W_AUX2, NTOK, 1024, 512, ER); }
                        GSYNC();
                    }
                    for (int rep = 0; rep < REP_P1; ++rep) {
                        const int wave = otid() >> 6; LAS float* pl = (LAS float*)shm + (wave >> 1) * RW_PAIR;
                        for (int it0 = blockIdx.x * 4; it0 < 16 * NCH; it0 += gridDim.x * 4) { const int item = it0 + (wave >> 1);
                            if (wave & 1) rwkv_pass1_pair<1>(a, e, item / NCH, item % NCH, pl); else rwkv_pass1_pair<0>(a, e, item / NCH, item % NCH, pl); }
                        SK_O(lru_pass_a(a, blockIdx.x * 512 + otid(), gridDim.x * 512);)
                        GSYNC();
                    }
                    for (int rep = 0; rep < REP_CB; ++rep) {
                        if (blockIdx.x < 128) { SK_O(rwkv_combine(a, blockIdx.x, shm);) }
                        else { SK_O(lru_pass_c2(a, ((int)blockIdx.x - 128) * 512 + otid(), ((int)gridDim.x - 128) * 512);) }
                        GSYNC();
                    }
                    for (int rep = 0; rep < REP_P2; ++rep) {
                        const int wave = otid() >> 6; LAS float* pl = (LAS float*)shm + (wave >> 1) * RW_PAIR;
                        for (int it0 = blockIdx.x * 4; it0 < 16 * NCH; it0 += gridDim.x * 4) { const int item = it0 + (wave >> 1); rwkv_pass2_pair(a, e, item / NCH, item % NCH, wave & 1, pl); }
                        GSYNC();
                    }
                }
                A2 = P_XB; W2 = P_W + W_MIXOUT; K2 = 1024; scale2 = 1.0f;
            } else {
                for (int rep = 0; rep < REP_AT; ++rep) { SK_A(attn_phase(P_Qb, P_Kb, P_VT, P_Ob, shm);) GSYNC(); }
                A2 = P_Ob; W2 = P_W + W_O; K2 = 1024; scale2 = 1.0f;
            }
        }
        {
            EpiResid ER; ER.res = (const h16*)a->out; ER.out = (h16*)a->out; ER.MR = (const float*)(ws + WS_MR); ER.first = (ls == 0);
            ER.g = a->in[6] + (size_t)(ls > 0 ? ls - 1 : 0) * DM; ER.b = a->in[7] + (size_t)(ls > 0 ? ls - 1 : 0) * DM; ER.scale = scale2; run_gemm(shm, A2, W2, NTOK, 1024, K2, ER); }
        GSYNC();
        for (int rep = 0; rep < REP_SYNC; ++rep) GSYNC();
        if (st == 1) {
            if (blockIdx.x < 16) { EpiKV EK; EK.Kb = P_Kb; EK.VT = P_VT; run_gemm(shm, P_MEMB, P_W + W_KV, 512, 2048, 1024, EK, 16, (int)blockIdx.x); }
            else ln_phase(a->out, nullptr, P_XB, (float*)(ws + WS_MR), a->in[6] + (size_t)ls * DM, a->in[7] + (size_t)ls * DM, 16, (int)gridDim.x - 16);
        } else if (ls < 15) { for (int rep = 0; rep < REP_LN; ++rep) { ln_phase(a->out, nullptr, P_XB, (float*)(ws + WS_MR), a->in[6] + (size_t)ls * DM, a->in[7] + (size_t)ls * DM, 0, (int)gridDim.x); if (rep + 1 < REP_LN) GSYNC(); }
            if (st == 3) for (int rep = 0; rep < REP_CV; ++rep) { convert_layer(a, l + 1, shm); if (rep + 1 < REP_CV) GSYNC(); } }
        else { h16x8 zr[16][2]; ln_final_load((const h16*)a->out, zr); GSYNC(); ln_final_store(zr, a->out, a->in[6] + (size_t)ls * DM, a->in[7] + (size_t)ls * DM); }
        GSYNC();
    }
}

#undef a
#undef ws
#undef P_W
#undef P_XB
#undef P_H
#undef P_LO
#undef P_AP
#undef P_XC
#undef P_LGA
#undef P_BX
#undef P_Kb
#undef P_VT
#undef P_MEMB
#undef P_Qb
#undef P_Ob
extern "C" void kernel_launch(void* const* d_in, const int* in_sizes, int n_in, void* d_out, int out_size, void* d_ws, size_t ws_size, hipStream_t stream) {
    static int grid = 0;
    if (grid == 0) {
        if (n_in != 39 || out_size != NTOK * DM || ws_size < WS_END) { fprintf(stderr, "kernel_launch: unexpected shapes (n_in %d out %d ws %zu need %zu)\n", n_in, out_size, ws_size, (size_t)WS_END); grid = -1; return; }
        int dev = 0, cus = 0, per_cu = 0;
        hipGetDevice(&dev); hipDeviceGetAttribute(&cus, hipDeviceAttributeMultiprocessorCount, dev);
        if (hipFuncSetAttribute((const void*)mega_fwd, hipFuncAttributeMaxDynamicSharedMemorySize, LDS_BYTES) != hipSuccess) { fprintf(stderr, "kernel_launch: hipFuncSetAttribute failed\n"); }
        if (hipOccupancyMaxActiveBlocksPerMultiprocessor(&per_cu, (const void*)mega_fwd, 512, LDS_BYTES) != hipSuccess || per_cu < 1) { fprintf(stderr, "kernel_launch: occupancy query says %d\n", per_cu); per_cu = 1; }
        (void)hipGetLastError();
        grid = cus > 0 ? cus : 256;
    }
    if (grid < 0) return;
    if (hipMemsetAsync((char*)d_ws + WS_BAR, 0, 16384, stream) != hipSuccess) { fprintf(stderr, "kernel_launch: memset failed\n"); return; }
    Args a{};
    for (int i = 0; i < 39; ++i) a.in[i] = (const float*)d_in[i];
    a.out = (float*)d_out; a.ws = (unsigned char*)d_ws;
    void* args[] = {&a};
    hipError_t e = hipLaunchCooperativeKernel((const void*)mega_fwd, dim3(grid), dim3(512), args, LDS_BYTES, stream);
    if (e != hipSuccess) fprintf(stderr, "cooperative launch failed: %s (grid %d)\n", hipGetErrorString(e), grid);
}
```

```cpp
#include <hip/hip_runtime.h>
#include <hip/hip_cooperative_groups.h>
#include <cstdio>
namespace cg = cooperative_groups;
namespace pg8 {
#define PG8_LAS __attribute__((address_space(3)))
typedef unsigned short bf16_t;
typedef short bf16x8 __attribute__((ext_vector_type(8)));
typedef float f32x4 __attribute__((ext_vector_type(4)));
typedef unsigned u32x4 __attribute__((ext_vector_type(4)));
typedef unsigned u32x2 __attribute__((ext_vector_type(2)));
constexpr int BM = 256, BK = 64, HALF = 128, HTB = HALF * BK * 2  , STAGE_BYTES = 8 * HTB, NXCD = 8, WGM = 8;

__host__ __device__ __forceinline__ int lds_byte(int r, int c) { const int st = (r >> 4) * 2 + (c >> 5), rr = r & 15, cc = c & 31, ob = rr * 64 + cc * 2; return st * 1024 + (ob ^ (((ob >> 9) & 1) << 5)); }
__host__ __device__ __forceinline__ void stage_rc(int b, int& R, int& C) { const int st = b / 1024, sb = b % 1024, swz = sb ^ (((sb >> 9) & 1) << 5); R = (st >> 1) * 16 + swz / 64; C = (st & 1) * 32 + (swz % 64) / 2; }
__host__ __device__ __forceinline__ int perm32(int rho) { const int n = rho >> 4, i = rho & 15; return 8 * (i >> 2) + 4 * n + (i & 3); }

struct Unit { int pm, pn; };
struct Gemm { const bf16_t* A; const bf16_t* Bt; int M, N, K; };

struct StaticOrder {
    int nM, nN, nwg, G, c;
    __host__ __device__ void init(int M, int N, int G_, int c_) { nM = M / BM; nN = N / BM; nwg = nM * nN; G = G_; c = c_; }
    __host__ __device__ bool next(int i, Unit& u) const {
        const long L = (long)i * G + c; if (L >= nwg) return false;
        int wgid = (int)L; { const int q = nwg / NXCD, r = nwg % NXCD, xcd = wgid % NXCD, off = wgid / NXCD; wgid = (xcd < r ? xcd * (q + 1) : r * (q + 1) + (xcd - r) * q) + off; }
        const int nig = WGM * nN, gid = wgid / nig, fm = gid * WGM, gsz = (nM - fm) < WGM ? (nM - fm) : WGM;
        u.pm = fm + ((wgid % nig) % gsz); u.pn = (wgid % nig) / gsz; return true;
    }
    __device__ __forceinline__ void a_ready(const Unit&) const {}
    __device__ __forceinline__ void done(const Unit&) const {}
};
__device__ __forceinline__ unsigned cvt_pk_bf16(float lo, float hi) { unsigned r; asm volatile("v_cvt_pk_bf16_f32 %0, %1, %2" : "=v"(r) : "v"(lo), "v"(hi)); return r; }

template <class Epi, class Sched>
__device__ __forceinline__ void gemm_phase(PG8_LAS unsigned char* lds, const Gemm g, const Sched& S, const Epi& E) {
    int tid_ = threadIdx.x; asm volatile("" : "+v"(tid_));
    const int tid = tid_, wid = __builtin_amdgcn_readfirstlane(tid >> 6), lane = tid & 63, wr = wid >> 2, wc = wid & 3, fr = lane & 15, fq = lane >> 4;
    const int K = g.K, nt = K / BK;
    unsigned voffA[2], voffB[2];
#pragma unroll
    for (int i = 0; i < 2; ++i) { int R, C; stage_rc(tid * 16 + i * 8192, R, C); const int Rb = Epi::PERM ? ((R & ~31) + perm32(R & 31)) : R;
        voffA[i] = (unsigned)(R * K + C) * 2u; voffB[i] = (unsigned)(Rb * K + C) * 2u; }
    const size_t kstep = (size_t)(BK * 2);
    const size_t hstep = (size_t)HALF * K * 2;
    const size_t tstep = 2 * hstep;
    const unsigned ldsw = (unsigned)wid * 1024u;
    const int aoff = lds_byte(wr * 64 + fr, fq * 8), boff = lds_byte(wc * 32 + fr, fq * 8);
#define PG8_SA(b, h) (((b) * 2 + (h)) * HTB)
#define PG8_SB(b, h) ((4 + (b) * 2 + (h)) * HTB)
#define PG8_STAGE(bufoff, gbase, voff) do { _Pragma("unroll") for (int _i = 0; _i < 2; ++_i) \
        __builtin_amdgcn_global_load_lds((const unsigned*)((const char*)(gbase) + (voff)[_i]), (PG8_LAS unsigned*)(lds + (bufoff) + ldsw + _i * 8192), 16, 0, 0); } while (0)
#define PG8_LDA(dst, b, h) do { _Pragma("unroll") for (int m = 0; m < 4; ++m) _Pragma("unroll") for (int k = 0; k < 2; ++k) dst[m][k] = *(const PG8_LAS bf16x8*)(lds + PG8_SA(b, h) + aoff + m * 2048 + k * 1024); } while (0)
#define PG8_LDB(dst, b, h) do { _Pragma("unroll") for (int n = 0; n < 2; ++n) _Pragma("unroll") for (int k = 0; k < 2; ++k) dst[n][k] = *(const PG8_LAS bf16x8*)(lds + PG8_SB(b, h) + boff + n * 2048 + k * 1024); } while (0)
#define PG8_MMA(ai, bj, At, Bt) do { __builtin_amdgcn_s_setprio(1); _Pragma("unroll") for (int m = 0; m < 4; ++m) _Pragma("unroll") for (int n = 0; n < 2; ++n) _Pragma("unroll") for (int k = 0; k < 2; ++k) \
        acc[ai][bj][m][n] = __builtin_amdgcn_mfma_f32_16x16x32_bf16(Bt[n][k], At[m][k], acc[ai][bj][m][n], 0, 0, 0); __builtin_amdgcn_s_setprio(0); } while (0)
#define PG8_WAIT_V(n) asm volatile("s_waitcnt vmcnt(" #n ")" ::: "memory")
#define PG8_WAIT_L(n) asm volatile("s_waitcnt lgkmcnt(" #n ")" ::: "memory")
#define PG8_BAR __builtin_amdgcn_s_barrier()
#define PG8_SCHED __builtin_amdgcn_sched_barrier(0)
    Unit cur, nxt; int ui = 0;
    if (!S.next(0, cur)) return;
    f32x4 acc[2][2][4][2];
#pragma unroll
    for (int a = 0; a < 2; ++a)
#pragma unroll
        for (int b = 0; b < 2; ++b)
#pragma unroll
            for (int m = 0; m < 4; ++m)
#pragma unroll
                for (int n = 0; n < 2; ++n) acc[a][b][m][n] = (f32x4){0.f, 0.f, 0.f, 0.f};
    bf16x8 At[4][2], B0[2][2], B1[2][2];
    const char* cA = (const char*)g.A + (size_t)cur.pm * tstep; const char* cB = (const char*)g.Bt + (size_t)cur.pn * tstep;
    S.a_ready(cur);
    PG8_STAGE(PG8_SB(0, 0), cB, voffB); PG8_STAGE(PG8_SA(0, 0), cA, voffA); PG8_STAGE(PG8_SB(0, 1), cB + hstep, voffB); PG8_STAGE(PG8_SA(0, 1), cA + hstep, voffA);
    if (wr == 1) PG8_BAR;
    PG8_WAIT_V(4); PG8_BAR;
    PG8_STAGE(PG8_SB(1, 0), cB + kstep, voffB); PG8_STAGE(PG8_SA(1, 0), cA + kstep, voffA); PG8_STAGE(PG8_SB(1, 1), cB + hstep + kstep, voffB);
    PG8_WAIT_V(6); PG8_BAR;
    for (;;) {
        const bool has_next = S.next(ui + 1, nxt);
        const char* nA = has_next ? (const char*)g.A + (size_t)nxt.pm * tstep : cA; const char* nB = has_next ? (const char*)g.Bt + (size_t)nxt.pn * tstep : cB;
        for (int t = 0; t < nt; t += 2) {
            const bool last = (t == nt - 2);
            const char* a1 = cA + (size_t)(t + 1) * kstep;
            const char* a2 = last ? nA : cA + (size_t)(t + 2) * kstep; const char* b2 = last ? nB : cB + (size_t)(t + 2) * kstep;
            const char* a3 = a2 + kstep; const char* b3 = b2 + kstep;
            if (last && has_next) S.a_ready(nxt);
            PG8_LDB(B0, 0, 0); PG8_SCHED; PG8_LDA(At, 0, 0); PG8_STAGE(PG8_SA(1, 1), a1 + hstep, voffA);
            PG8_WAIT_L(8); PG8_BAR; PG8_WAIT_L(0); PG8_MMA(0, 0, At, B0); PG8_BAR; PG8_SCHED;
            PG8_LDB(B1, 0, 1); PG8_STAGE(PG8_SB(0, 0), b2, voffB);
            PG8_BAR; PG8_WAIT_L(0); PG8_MMA(0, 1, At, B1); PG8_BAR;
            PG8_LDA(At, 0, 1); PG8_STAGE(PG8_SA(0, 0), a2, voffA);
            PG8_BAR; PG8_WAIT_L(0); PG8_MMA(1, 0, At, B0); PG8_BAR; PG8_SCHED;
            PG8_STAGE(PG8_SB(0, 1), b2 + hstep, voffB);
            PG8_WAIT_V(6); PG8_BAR; PG8_MMA(1, 1, At, B1); PG8_BAR;
            PG8_LDB(B0, 1, 0); PG8_SCHED; PG8_LDA(At, 1, 0); PG8_STAGE(PG8_SA(0, 1), a2 + hstep, voffA);
            PG8_WAIT_L(8); PG8_BAR; PG8_WAIT_L(0); PG8_MMA(0, 0, At, B0); PG8_BAR; PG8_SCHED;
            PG8_LDB(B1, 1, 1); PG8_STAGE(PG8_SB(1, 0), b3, voffB);
            PG8_BAR; PG8_WAIT_L(0); PG8_MMA(0, 1, At, B1); PG8_BAR;
            PG8_LDA(At, 1, 1); PG8_STAGE(PG8_SA(1, 0), a3, voffA);
            PG8_BAR; PG8_WAIT_L(0); PG8_MMA(1, 0, At, B0); PG8_BAR; PG8_SCHED;
            PG8_STAGE(PG8_SB(1, 1), b3 + hstep, voffB);
            PG8_WAIT_V(6); PG8_BAR; PG8_MMA(1, 1, At, B1); PG8_BAR;
        }
        if constexpr (!Epi::AFTER_DRAIN) { E(acc, cur, wr, wc, fr, fq); S.done(cur); }
        if (!has_next) break;
#pragma unroll
        for (int a = 0; a < 2; ++a)
#pragma unroll
            for (int b = 0; b < 2; ++b)
#pragma unroll
                for (int m = 0; m < 4; ++m)
#pragma unroll
                    for (int n = 0; n < 2; ++n) acc[a][b][m][n] = (f32x4){0.f, 0.f, 0.f, 0.f};
        cur = nxt; cA = nA; cB = nB; ++ui;
    }
    PG8_WAIT_V(0);
    if (wr == 0) PG8_BAR;
    PG8_BAR;
    if constexpr (Epi::AFTER_DRAIN) { E.fused(acc, cur, wr, wc, fr, fq, lds, wid, lane); S.done(cur); }
#undef PG8_SA
#undef PG8_SB
#undef PG8_STAGE
#undef PG8_LDA
#undef PG8_LDB
#undef PG8_MMA
#undef PG8_WAIT_V
#undef PG8_WAIT_L
#undef PG8_BAR
#undef PG8_SCHED
}
}

using pg8::bf16_t; using pg8::bf16x8; using pg8::f32x4; using pg8::u32x4; using pg8::u32x2;
#define LAS __attribute__((address_space(3)))
constexpr int NTOK = 32768, SEQ = 16384, DM = 1024, FF = 2816;
constexpr int NCH = 64;
constexpr int TCH = SEQ / NCH;
constexpr int LCH = 128;
constexpr int NLCH = SEQ / LCH;
constexpr float ALPHA = 1.681792830507429f;
constexpr int LDS_BYTES = 136 * 1024;

constexpr size_t MiB = 1024 * 1024;
constexpr size_t E_FFIN = (size_t)5632 * 1024, E_FFOUT = (size_t)1024 * 2816, E_SQ = (size_t)1024 * 1024, E_KV = (size_t)2048 * 1024, E_MIXIN = (size_t)2816 * 1024;
constexpr size_t W_FF1IN = 0, W_FF1OUT = W_FF1IN + E_FFIN, W_FF2IN = W_FF1OUT + E_FFOUT, W_FF2OUT = W_FF2IN + E_FFIN, W_Q = W_FF2OUT + E_FFOUT, W_KV = W_Q + E_SQ, W_O = W_KV + E_KV,
                 W_MIXIN = W_O + E_SQ, W_MIXOUT = W_MIXIN + E_MIXIN, W_AUX1 = W_MIXOUT + E_SQ, W_AUX2 = W_AUX1 + (size_t)1536 * 256, W_END = W_AUX2 + (size_t)1024 * 512;
constexpr size_t WS_W = 0;
constexpr size_t WS_XB = 52 * MiB;
constexpr size_t WS_H = WS_XB + 64 * MiB;
constexpr size_t WS_LO = WS_H + 176 * MiB;
constexpr size_t WS_AP = WS_LO + 96 * MiB;
constexpr size_t WS_XC = WS_AP + 16 * MiB;
constexpr size_t WS_LA = WS_XC + 32 * MiB;
constexpr size_t WS_MISC = WS_LA + 64 * MiB;
constexpr size_t WS_BAR = WS_MISC + 4 * MiB;
constexpr size_t WS_MR = WS_BAR + 1 * MiB;
constexpr size_t WS_END = WS_MR + 1 * MiB;
static_assert(W_END * 2 <= 52 * MiB, "weights");
static_assert(WS_END <= 512 * MiB, "workspace");

struct Args { const float* in[39]; float* out; unsigned char* ws; };
typedef const __attribute__((address_space(4))) Args* CArgsP;
__device__ __forceinline__ CArgsP argp() { CArgsP p = (CArgsP)__builtin_amdgcn_kernarg_segment_ptr(); asm volatile("" : "+s"(p)); return p; }

__device__ __forceinline__ float bf2f(unsigned short b) { return __uint_as_float(((unsigned)b) << 16); }
__device__ __forceinline__ float bfs2f(short b) { return __uint_as_float(((unsigned)(unsigned short)b) << 16); }
__device__ __forceinline__ unsigned short f2bf(float f) { unsigned u = __float_as_uint(f); u += 0x7FFFu + ((u >> 16) & 1u); return (unsigned short)(u >> 16); }
__device__ __forceinline__ unsigned pk2(float lo, float hi) { return pg8::cvt_pk_bf16(lo, hi); }
__device__ __forceinline__ float sigmoidf_(float x) { return __builtin_amdgcn_rcpf(1.0f + __expf(-x)); }
__device__ __forceinline__ float siluf_(float x) { return x * sigmoidf_(x); }
__device__ __forceinline__ float tanhf_(float y) { return 1.0f - 2.0f * __builtin_amdgcn_rcpf(1.0f + __expf(2.0f * y)); }
__device__ __forceinline__ float geluf_(float x) { return 0.5f * x * (1.0f + tanhf_(0.7978845608028654f * (x + 0.044715f * x * x * x))); }
__device__ __forceinline__ float softplusf_(float x) { return fmaxf(x, 0.0f) + __logf(1.0f + __expf(-fabsf(x))); }
__device__ __forceinline__ float wave_sum(float v) {
#pragma unroll
    for (int o = 1; o < 64; o <<= 1) v += __shfl_xor(v, o);
    return v;
}
__device__ __forceinline__ int otid() { int t = threadIdx.x; asm volatile("" : "+v"(t)); return t; }
#define LDS_SYNC_WAVE() asm volatile("s_waitcnt lgkmcnt(0)" ::: "memory")

typedef const f32x4 (&AccRef)[2][2][4][2];
struct EpiSwiGLU { static constexpr bool PERM = true, AFTER_DRAIN = false; bf16_t* O;
    __device__ __forceinline__ void operator()(AccRef acc, const pg8::Unit& u, int wr, int wc, int fr, int fq) const {
        const int row0 = u.pm * 256 + wr * 64 + fr, col0 = u.pn * 128 + wc * 32 + 8 * fq;
#pragma unroll
        for (int ai = 0; ai < 2; ++ai)
#pragma unroll
            for (int m = 0; m < 4; ++m) { bf16_t* rowp = O + (size_t)(row0 + ai * 128 + m * 16) * FF + col0;
                const f32x4 g0 = acc[ai][0][m][0], g1 = acc[ai][0][m][1], u0 = acc[ai][1][m][0], u1 = acc[ai][1][m][1];
                u32x4 o; o.x = pk2(siluf_(g0[0]) * u0[0], siluf_(g0[1]) * u0[1]); o.y = pk2(siluf_(g0[2]) * u0[2], siluf_(g0[3]) * u0[3]);
                o.z = pk2(siluf_(g1[0]) * u1[0], siluf_(g1[1]) * u1[1]); o.w = pk2(siluf_(g1[2]) * u1[2], siluf_(g1[3]) * u1[3]);
                *(u32x4*)rowp = o; __builtin_amdgcn_sched_barrier(0); }
    } };
typedef _Float16 h16; typedef h16 h16x4 __attribute__((ext_vector_type(4))); typedef h16 h16x8 __attribute__((ext_vector_type(8)));
struct EpiResid { static constexpr bool PERM = false, AFTER_DRAIN = false; const h16* res; h16* out; const float* MR; const float* g; const float* b; float scale; int first;
    __device__ __forceinline__ void operator()(AccRef acc, const pg8::Unit& u, int wr, int wc, int fr, int fq) const {
        const int row0 = u.pm * 256 + wr * 64 + fr, col0 = u.pn * 256 + wc * 32 + 4 * fq;
        f32x4 g4[2][2], b4[2][2];
#pragma unroll
        for (int bj = 0; bj < 2; ++bj)
#pragma unroll
            for (int n = 0; n < 2; ++n) { if (first) { g4[bj][n] = (f32x4){1.f, 1.f, 1.f, 1.f}; b4[bj][n] = (f32x4){0.f, 0.f, 0.f, 0.f}; } else { g4[bj][n] = *(const f32x4*)(g + col0 + bj * 128 + n * 16); b4[bj][n] = *(const f32x4*)(b + col0 + bj * 128 + n * 16); } }
#pragma unroll
        for (int ai = 0; ai < 2; ++ai)
#pragma unroll
        for (int mh = 0; mh < 4; mh += 2) {
            float mean[2], rstd[2]; h16x4 rr[2][2][2];
#pragma unroll
            for (int mm = 0; mm < 2; ++mm) { const int row = row0 + ai * 128 + (mh + mm) * 16; const size_t off = (size_t)row * DM + col0; mean[mm] = MR[2 * row]; rstd[mm] = MR[2 * row + 1];
#pragma unroll
                for (int bj = 0; bj < 2; ++bj)
#pragma unroll
                    for (int n = 0; n < 2; ++n) rr[mm][bj][n] = *(const h16x4*)(res + off + bj * 128 + n * 16); }
#pragma unroll
            for (int mm = 0; mm < 2; ++mm) { const int m = mh + mm, row = row0 + ai * 128 + m * 16; const size_t off = (size_t)row * DM + col0;
#pragma unroll
                for (int bj = 0; bj < 2; ++bj)
#pragma unroll
                    for (int n = 0; n < 2; ++n) { const f32x4 r = __builtin_convertvector(rr[mm][bj][n], f32x4);
                        const f32x4 x = (r - mean[mm]) * rstd[mm] * g4[bj][n] + b4[bj][n], z = x * ALPHA + acc[ai][bj][m][n] * scale;
                        *(h16x4*)(out + off + bj * 128 + n * 16) = __builtin_convertvector(z, h16x4); } } }
    } };
struct EpiBf16g { static constexpr bool PERM = true, AFTER_DRAIN = false; bf16_t* O; int ldc; int gelu_from; float scale;
    __device__ __forceinline__ void operator()(AccRef acc, const pg8::Unit& u, int wr, int wc, int fr, int fq) const {
        const int row0 = u.pm * 256 + wr * 64 + fr, col0 = u.pn * 256 + wc * 32 + 8 * fq; const bool dog = u.pn >= gelu_from;
#pragma unroll
        for (int ai = 0; ai < 2; ++ai)
#pragma unroll
            for (int m = 0; m < 4; ++m) { bf16_t* rowp = O + (size_t)(row0 + ai * 128 + m * 16) * ldc + col0;
#pragma unroll
                for (int bj = 0; bj < 2; ++bj) { f32x4 v0 = acc[ai][bj][m][0] * scale, v1 = acc[ai][bj][m][1] * scale;
                    if (dog) {
#pragma unroll
                        for (int e = 0; e < 4; ++e) { v0[e] = geluf_(v0[e]); v1[e] = geluf_(v1[e]); } }
                    u32x4 o; o.x = pk2(v0[0], v0[1]); o.y = pk2(v0[2], v0[3]); o.z = pk2(v1[0], v1[1]); o.w = pk2(v1[2], v1[3]);
                    *(u32x4*)(rowp + bj * 128) = o; } }
    } };
struct EpiKV { static constexpr bool PERM = false, AFTER_DRAIN = false; bf16_t* Kb; bf16_t* VT;
    __device__ __forceinline__ void operator()(AccRef acc, const pg8::Unit& u, int wr, int wc, int fr, int fq) const {
        const int row0 = u.pm * 256 + wr * 64 + fr, col0 = u.pn * 256 + wc * 32 + 4 * fq;
#pragma unroll
        for (int ai = 0; ai < 2; ++ai)
#pragma unroll
            for (int m = 0; m < 4; ++m) { const int row = row0 + ai * 128 + m * 16;
#pragma unroll
                for (int bj = 0; bj < 2; ++bj)
#pragma unroll
                    for (int n = 0; n < 2; ++n) { const int col = col0 + bj * 128 + n * 16; const f32x4 v = acc[ai][bj][m][n];
                        if (u.pn < 4) { u32x2 o; o.x = pk2(v[0], v[1]); o.y = pk2(v[2], v[3]); *(u32x2*)(Kb + (size_t)row * 1024 + col) = o; }
                        else { const int cc = col - 1024, hh = cc >> 8, d = cc & 255, b = row >> 8, mm = row & 255;
#pragma unroll
                            for (int e = 0; e < 4; ++e) VT[(size_t)((b * 4 + hh) * 256 + d + e) * 256 + mm] = f2bf(v[e]); } } }
    } };
struct EpiLru { static constexpr bool PERM = true, AFTER_DRAIN = false; const bf16_t* XC; const float* b_a; const float* b_x; const float* lam; bf16_t* LGA; bf16_t* BX;
    __device__ __forceinline__ void operator()(AccRef acc, const pg8::Unit& u, int wr, int wc, int fr, int fq) const {
        const int row0 = u.pm * 256 + wr * 64 + fr, ch0 = u.pn * 128 + wc * 32 + 8 * fq;
#pragma unroll
        for (int n = 0; n < 2; ++n) { float sp[4]; const f32x4 lm = *(const f32x4*)(lam + ch0 + 4 * n), ba = *(const f32x4*)(b_a + ch0 + 4 * n), bx_ = *(const f32x4*)(b_x + ch0 + 4 * n);
#pragma unroll
            for (int e = 0; e < 4; ++e) sp[e] = -8.0f * softplusf_(-lm[e]);
            u32x2 xrr[2][4];
#pragma unroll
            for (int ai = 0; ai < 2; ++ai)
#pragma unroll
                for (int m = 0; m < 4; ++m) xrr[ai][m] = *(const u32x2*)(XC + (size_t)(row0 + ai * 128 + m * 16) * 512 + ch0 + 4 * n);
#pragma unroll
            for (int ai = 0; ai < 2; ++ai)
#pragma unroll
                for (int m = 0; m < 4; ++m) { const size_t off = (size_t)(row0 + ai * 128 + m * 16) * 512 + ch0 + 4 * n;
                    const u32x2 xr = xrr[ai][m]; float xc[4] = {__uint_as_float(xr.x << 16), __uint_as_float(xr.x & 0xffff0000u), __uint_as_float(xr.y << 16), __uint_as_float(xr.y & 0xffff0000u)};
                    float la[4], bb[4];
#pragma unroll
                    for (int e = 0; e < 4; ++e) { const float rec = sigmoidf_(acc[ai][0][m][n][e] + ba[e]), inp = sigmoidf_(acc[ai][1][m][n][e] + bx_[e]);
                        const float lg = sp[e] * rec; la[e] = lg; bb[e] = sqrtf(fmaxf(1.0f - __expf(2.0f * lg), 0.0f)) * (inp * xc[e]); }
                    u32x2 o; o.x = pk2(la[0], la[1]); o.y = pk2(la[2], la[3]); *(u32x2*)(LGA + off) = o;
                    o.x = pk2(bb[0], bb[1]); o.y = pk2(bb[2], bb[3]); *(u32x2*)(BX + off) = o; } }
    } };
struct EpiPool { static constexpr bool PERM = true, AFTER_DRAIN = false; bf16_t* O; const float* scl;
    __device__ __forceinline__ void operator()(AccRef acc, const pg8::Unit& u, int wr, int wc, int fr, int fq) const {
        const int row0 = u.pm * 256 + wr * 64 + fr, col0 = u.pn * 256 + wc * 32 + 8 * fq;
        float sc[2][8];
#pragma unroll
        for (int bj = 0; bj < 2; ++bj)
#pragma unroll
            for (int e = 0; e < 8; ++e) sc[bj][e] = scl[col0 + bj * 128 + e];
#pragma unroll
        for (int ai = 0; ai < 2; ++ai)
#pragma unroll
            for (int m = 0; m < 4; ++m) { bf16_t* rowp = O + (size_t)(row0 + ai * 128 + m * 16) * 1024 + col0;
#pragma unroll
                for (int bj = 0; bj < 2; ++bj) { float v[8];
#pragma unroll
                    for (int e = 0; e < 8; ++e) v[e] = acc[ai][bj][m][e >> 2][e & 3] * sc[bj][e];
                    u32x4 o; o.x = pk2(v[0], v[1]); o.y = pk2(v[2], v[3]); o.z = pk2(v[4], v[5]); o.w = pk2(v[6], v[7]);
                    *(u32x4*)(rowp + bj * 128) = o; } }
    } };

template <class Epi> __device__ __forceinline__ void run_gemm(unsigned char* shm, const bf16_t* A, const bf16_t* Bt, int M, int N, int K, const Epi& E, int G = 0, int c = -1) {
    pg8::Gemm g; g.A = A; g.Bt = Bt; g.M = M; g.N = N; g.K = K;
    pg8::StaticOrder S; S.init(M, N, G > 0 ? G : (int)gridDim.x, c >= 0 ? c : (int)blockIdx.x);
    pg8::gemm_phase<Epi, pg8::StaticOrder>((PG8_LAS unsigned char*)shm, g, S, E);
}

template <int MODE> __device__ __forceinline__ int rowmap(int n) {
    if (MODE == 0) return n;
    const int up = n >= FF, i = up ? n - FF : n; return (i >> 7) * 256 + up * 128 + (i & 127);
}
template <int MODE> __device__ __forceinline__ void conv_tile(const float* src, int K, int N, bf16_t* dst, int tile, float* tb) {
    const int tid = otid(), ntn = N >> 6, k0 = (tile / ntn) << 6, n0 = (tile % ntn) << 6;
#pragma unroll
    for (int i = 0; i < 8; ++i) { const int kk = i * 8 + (tid >> 6), nn = tid & 63; tb[kk * 65 + nn] = src[(size_t)(k0 + kk) * N + n0 + nn]; }
    __syncthreads();
#pragma unroll
    for (int i = 0; i < 4; ++i) { const int nn = i * 16 + (tid >> 5), kk = 2 * (tid & 31);
        *(unsigned*)(dst + (size_t)rowmap<MODE>(n0 + nn) * K + k0 + kk) = pk2(tb[kk * 65 + nn], tb[(kk + 1) * 65 + nn]); }
    __syncthreads();
}

#define XB_TMO      128
#define XB_XCNT(j)  (256  + 64 * (j))
#define XB_XSUB(j)  (1280 + 64 * (j))
#define XB_XGEN(j)  (2304 + 64 * (j))
#define XB_TOP      3328
#define XB_TOPGEN   3392
#define XCD_BAR_WORDS 3456
#define XB_SPIN_CAP (1u << 18)

__device__ __forceinline__ unsigned xb_ld(unsigned* p)              { return __hip_atomic_load(p, __ATOMIC_RELAXED, __HIP_MEMORY_SCOPE_AGENT); }
__device__ __forceinline__ unsigned xb_add(unsigned* p, unsigned v) { return __hip_atomic_fetch_add(p, v, __ATOMIC_RELAXED, __HIP_MEMORY_SCOPE_AGENT); }
__device__ __forceinline__ unsigned xb_xcc_id() { return (unsigned)__builtin_amdgcn_s_getreg((3 << 11) | 20) & 0xFu; }
#define XB_SPIN(cond, bar) do { unsigned _sp = 0; while (cond) { __builtin_amdgcn_s_sleep(1); \
    if ((++_sp & 255u) == 0u) { if (xb_ld(&(bar)[XB_TMO])) break; if (_sp > XB_SPIN_CAP) { atomicAdd(&(bar)[XB_TMO], 1u); break; } } } } while (0)

struct XcdBarrier {
    unsigned* bar; unsigned x;
    volatile LAS unsigned* st;
};

__device__ __forceinline__ XcdBarrier xcd_barrier_post(unsigned* bar, volatile LAS unsigned* st) {
    XcdBarrier b; b.bar = bar; b.x = xb_xcc_id(); b.st = st;
    if (otid() == 0) (void)xb_add(&bar[XB_XCNT(b.x)], 1u);
    return b;
}
__device__ __forceinline__ void xcd_barrier_complete(unsigned* bar, unsigned x, unsigned& nloc, unsigned& nx) {
    const unsigned G = gridDim.x * gridDim.y * gridDim.z;
    unsigned sum, cnt, mine, sp = 0u;
    for (;;) {
        sum = 0u; cnt = 0u; mine = 0u;
#pragma unroll
        for (unsigned j = 0; j < 16; ++j) { const unsigned c = xb_ld(&bar[XB_XCNT(j)]); sum += c; cnt += (c > 0u) ? 1u : 0u; mine = (j == x) ? c : mine; }
        if (sum == G) break;
        __builtin_amdgcn_s_sleep(1);
        if ((++sp & 255u) == 0u) { if (xb_ld(&bar[XB_TMO])) break; if (sp > XB_SPIN_CAP) { atomicAdd(&bar[XB_TMO], 1u); break; } }
    }
    nloc = mine > 0u ? mine : 1u; nx = cnt > 0u ? cnt : 1u;
}

__device__ __forceinline__ void xcd_barrier(const XcdBarrier& b) {
    asm volatile("s_waitcnt vmcnt(0)" ::: "memory");
    __syncthreads();
    if (otid() == 0) {
        unsigned* bar = b.bar;
        __builtin_amdgcn_s_waitcnt(0);
        unsigned nloc = b.st[0], nx = b.st[1];
        if (nloc == 0u) { xcd_barrier_complete(bar, b.x, nloc, nx); b.st[0] = nloc; b.st[1] = nx; }
        const unsigned old = xb_add(&bar[XB_XSUB(b.x)], 1u);
        const unsigned gen = old / nloc;
        if (old + 1u == (gen + 1u) * nloc) {
            __builtin_amdgcn_fence(__ATOMIC_RELEASE, "agent");
            asm volatile("s_waitcnt vmcnt(0)" ::: "memory");
            const unsigned og = xb_add(&bar[XB_TOP], 1u);
            const unsigned tg = og / nx;
            if (og + 1u == (tg + 1u) * nx) xb_add(&bar[XB_TOPGEN], 1u);
            else XB_SPIN(xb_ld(&bar[XB_TOPGEN]) == tg, bar);
            __builtin_amdgcn_fence(__ATOMIC_ACQUIRE, "agent");
            xb_add(&bar[XB_XGEN(b.x)], 1u);
            asm volatile("s_waitcnt vmcnt(0)" ::: "memory");
        } else {
            XB_SPIN(xb_ld(&bar[XB_XGEN(b.x)]) == gen, bar);
            __builtin_amdgcn_fence(__ATOMIC_ACQUIRE, "agent");
            asm volatile("s_waitcnt vmcnt(0)" ::: "memory");
        }
    }
    __syncthreads();
}

struct CvDesc { const float* src; bf16_t* dst; int K, N, mode, tile; };
__device__ __forceinline__ bool cv_decode(CArgsP a, int l, int it, CvDesc& d) {
    bf16_t* W = (bf16_t*)(a->ws + WS_W); const int e = l >> 1, odd = l & 1;
    constexpr int T_FFIN = 8 * 88, T_FFOUT = 22 * 16, T_SQ = 128, T_KV = 8 * 32;
    const int T_MIXIN = odd ? 8 * 44 : 8 * 24;
    int r = it; d.mode = 0;
    if (r < T_FFIN) { d.src = a->in[2] + (size_t)l * 1024 * 5632; d.K = 1024; d.N = 5632; d.dst = W + W_FF1IN; d.mode = 1; d.tile = r; return true; } r -= T_FFIN;
    if (r < T_FFIN) { d.src = a->in[4] + (size_t)l * 1024 * 5632; d.K = 1024; d.N = 5632; d.dst = W + W_FF2IN; d.mode = 1; d.tile = r; return true; } r -= T_FFIN;
    if (r < T_FFOUT) { d.src = a->in[3] + (size_t)l * 2816 * 1024; d.K = 2816; d.N = 1024; d.dst = W + W_FF1OUT; d.tile = r; return true; } r -= T_FFOUT;
    if (r < T_FFOUT) { d.src = a->in[5] + (size_t)l * 2816 * 1024; d.K = 2816; d.N = 1024; d.dst = W + W_FF2OUT; d.tile = r; return true; } r -= T_FFOUT;
    if (r < T_SQ) { d.src = a->in[8] + (size_t)l * 1024 * 1024; d.K = 1024; d.N = 1024; d.dst = W + W_Q; d.tile = r; return true; } r -= T_SQ;
    if (r < T_KV) { d.src = a->in[9] + (size_t)l * 1024 * 2048; d.K = 1024; d.N = 2048; d.dst = W + W_KV; d.tile = r; return true; } r -= T_KV;
    if (r < T_SQ) { d.src = a->in[10] + (size_t)l * 1024 * 1024; d.K = 1024; d.N = 1024; d.dst = W + W_O; d.tile = r; return true; } r -= T_SQ;
    if (r < T_SQ) { d.src = (odd ? a->in[20] : a->in[12]) + (size_t)e * 1024 * 1024; d.K = 1024; d.N = 1024; d.dst = W + W_MIXOUT; d.tile = r; return true; } r -= T_SQ;
    if (r < T_MIXIN) { d.K = 1024; d.dst = W + W_MIXIN; d.tile = r; if (odd) { d.src = a->in[19] + (size_t)e * 1024 * 2816; d.N = 2816; } else { d.src = a->in[11] + (size_t)e * 1024 * 1536; d.N = 1536; } return true; }
    return false;
}
__device__ __forceinline__ void cv_load(const CvDesc& d, int tid, float (&v)[16]) {
    const int ntn = d.N >> 6, k0 = (d.tile / ntn) << 7, n0 = (d.tile % ntn) << 6;
#pragma unroll
    for (int i = 0; i < 16; ++i) v[i] = d.src[(size_t)(k0 + i * 8 + (tid >> 6)) * d.N + n0 + (tid & 63)];
}
__device__ __forceinline__ void convert_layer(CArgsP a, int l, unsigned char* shm) {
    float* tb = (float*)shm; bf16_t* W = (bf16_t*)(a->ws + WS_W);
    const int e = l >> 1, odd = l & 1, tid = otid();
    {
        CvDesc d, nx; float v[16]; int it = blockIdx.x; bool have = cv_decode(a, l, it, d);
        if (have) cv_load(d, tid, v);
        while (have) {
#pragma unroll
            for (int i = 0; i < 16; ++i) tb[(i * 8 + (tid >> 6)) * 65 + (tid & 63)] = v[i];
            __syncthreads();
            it += gridDim.x; const bool hn = cv_decode(a, l, it, nx);
            if (hn) cv_load(nx, tid, v);
            const int ntn = d.N >> 6, k0 = (d.tile / ntn) << 7, n0 = (d.tile % ntn) << 6;
#pragma unroll
            for (int i = 0; i < 8; ++i) { const int nn = i * 8 + (tid >> 6), kk = 2 * (tid & 63), n = n0 + nn; const int row = d.mode ? rowmap<1>(n) : n;
                *(unsigned*)(d.dst + (size_t)row * d.K + k0 + kk) = pk2(tb[kk * 65 + nn], tb[(kk + 1) * 65 + nn]); }
            __syncthreads();
            d = nx; have = hn;
        }
    }
    const int gtid = blockIdx.x * 512 + otid(), nth = gridDim.x * 512;
    if (!odd) {
        const float* pw = a->in[13] + (size_t)e * 4 * 128 * 128;
        for (int idx = gtid; idx < 512 * 512; idx += nth) { const int n = idx >> 9, k = idx & 511, g = n >> 7, d = n & 127, g2 = k >> 7, c = k & 127;
            W[W_AUX1 + idx] = (g == g2) ? f2bf(pw[(g * 128 + c) * 128 + d]) : (bf16_t)0; }
    } else {
        const float* wup = a->in[23] + (size_t)e * 64 * 512; const float* aup = a->in[25] + (size_t)e * 64 * 512; const float* gup = a->in[26] + (size_t)e * 128 * 512;
        for (int idx = gtid; idx < 1536 * 256; idx += nth) { const int n = idx >> 8, k = idx & 255, kind = n >> 9, j = n & 511; float v = 0.f;
            if (kind == 0) { if (k < 64) v = wup[k * 512 + j]; } else if (kind == 1) { if (k >= 64 && k < 128) v = aup[(k - 64) * 512 + j]; } else { if (k >= 128) v = gup[(k - 128) * 512 + j]; }
            W[W_AUX1 + idx] = f2bf(v); }
        const float* wa = a->in[34] + (size_t)e * 8 * 64 * 64; const float* wx = a->in[36] + (size_t)e * 8 * 64 * 64;
        for (int idx = gtid; idx < 1024 * 512; idx += nth) { const int n = idx >> 9, k = idx & 511, pn = n >> 8, bj = (n >> 7) & 1, cc = n & 127, ch = pn * 128 + cc, hb = ch >> 6, jj = ch & 63; float v = 0.f;
            if ((k >> 6) == hb) v = (bj ? wx : wa)[(hb * 64 + (k & 63)) * 64 + jj];
            W[W_AUX2 + idx] = f2bf(v); }
    }
}
__device__ __forceinline__ void prologue_cast(CArgsP a) {
    const int gtid = blockIdx.x * 512 + otid(), nth = gridDim.x * 512;
    const f32x4* x4 = (const f32x4*)a->in[0]; u32x2* xb = (u32x2*)(a->ws + WS_XB);
    for (int i0 = gtid; i0 < NTOK * DM / 4; i0 += nth * 8) { f32x4 v[8];
#pragma unroll
        for (int u = 0; u < 8; ++u) { const int i = i0 + u * nth; v[u] = (i < NTOK * DM / 4) ? x4[i] : (f32x4){0.f, 0.f, 0.f, 0.f}; }
#pragma unroll
        for (int u = 0; u < 8; ++u) { const int i = i0 + u * nth; if (i < NTOK * DM / 4) { u32x2 o; o.x = pk2(v[u][0], v[u][1]); o.y = pk2(v[u][2], v[u][3]); xb[i] = o; ((h16x4*)a->out)[i] = __builtin_convertvector(v[u], h16x4); } } }
    { float* MR = (float*)(a->ws + WS_MR); for (int i = gtid; i < NTOK; i += nth) { MR[2 * i] = 0.f; MR[2 * i + 1] = 1.f; } }
    const f32x4* m4 = (const f32x4*)a->in[1]; u32x2* mb = (u32x2*)(a->ws + WS_MISC + 2 * MiB);
    for (int i = gtid; i < 512 * DM / 4; i += nth) { const f32x4 v = m4[i]; u32x2 o; o.x = pk2(v[0], v[1]); o.y = pk2(v[2], v[3]); mb[i] = o; }
}
#define DPP_F(v, ctrl) __builtin_bit_cast(float, __builtin_amdgcn_update_dpp(0, __builtin_bit_cast(int, (v)), (ctrl), 0xF, 0xF, false))
__device__ __forceinline__ float wsum_fast(float v) {
    v += DPP_F(v, 0xB1); v += DPP_F(v, 0x4E); v += DPP_F(v, 0x141); v += DPP_F(v, 0x140);
    const int iv = __builtin_bit_cast(int, v);
    const float s0 = __builtin_bit_cast(float, __builtin_amdgcn_readlane(iv, 0)), s1 = __builtin_bit_cast(float, __builtin_amdgcn_readlane(iv, 16));
    const float s2 = __builtin_bit_cast(float, __builtin_amdgcn_readlane(iv, 32)), s3 = __builtin_bit_cast(float, __builtin_amdgcn_readlane(iv, 48));
    return (s0 + s1) + (s2 + s3);
}
__device__ __forceinline__ void ln_phase(const void* zin, float* xo, bf16_t* XB, float* MR, const float* g, const float* b, int bofs, int nblk) {
    const int lane = otid() & 63, wave = otid() >> 6;
    int row = ((int)blockIdx.x - bofs) * 8 + wave; const int rstep = nblk * 8;
    {
        f32x4 g4[2][2], b4[2][2];
#pragma unroll
        for (int j = 0; j < 2; ++j)
#pragma unroll
            for (int q = 0; q < 2; ++q) { g4[j][q] = *(const f32x4*)(g + 8 * lane + 512 * j + 4 * q); b4[j][q] = *(const f32x4*)(b + 8 * lane + 512 * j + 4 * q); }
        h16x8 nx[2];
        if (row < NTOK) {
#pragma unroll
            for (int j = 0; j < 2; ++j) nx[j] = *(const h16x8*)((const h16*)zin + (size_t)row * DM + 8 * lane + 512 * j);
        }
        for (; row < NTOK; row += rstep) {
            float v[2][8]; float s = 0.f;
#pragma unroll
            for (int j = 0; j < 2; ++j)
#pragma unroll
                for (int q = 0; q < 8; ++q) { v[j][q] = (float)nx[j][q]; s += v[j][q]; }
            if (row + rstep < NTOK) {
#pragma unroll
                for (int j = 0; j < 2; ++j) nx[j] = *(const h16x8*)((const h16*)zin + (size_t)(row + rstep) * DM + 8 * lane + 512 * j);
            }
            const float mean = wsum_fast(s) * (1.f / DM); float s2 = 0.f;
#pragma unroll
            for (int j = 0; j < 2; ++j)
#pragma unroll
                for (int q = 0; q < 8; ++q) { v[j][q] -= mean; s2 += v[j][q] * v[j][q]; }
            const float rstd = rsqrtf(wsum_fast(s2) * (1.f / DM) + 1e-5f);
            if (lane == 0) { MR[2 * row] = mean; MR[2 * row + 1] = rstd; }
#pragma unroll
            for (int j = 0; j < 2; ++j) { float y[8];
#pragma unroll
                for (int q = 0; q < 8; ++q) y[q] = v[j][q] * rstd * g4[j][q >> 2][q & 3] + b4[j][q >> 2][q & 3];
                u32x4 o; o.x = pk2(y[0], y[1]); o.y = pk2(y[2], y[3]); o.z = pk2(y[4], y[5]); o.w = pk2(y[6], y[7]);
                *(u32x4*)(XB + (size_t)row * DM + 8 * lane + 512 * j) = o; }
        }
    }
}
__device__ __forceinline__ void ln_final_load(const h16* zin, h16x8 (&zr)[16][2]) {
    const int lane = otid() & 63, wave = otid() >> 6;
#pragma unroll
    for (int i = 0; i < 16; ++i) { const int row = (int)blockIdx.x * 8 + wave + i * (int)gridDim.x * 8;
#pragma unroll
        for (int j = 0; j < 2; ++j) zr[i][j] = (row < NTOK) ? *(const h16x8*)(zin + (size_t)row * DM + 8 * lane + 512 * j) : (h16x8)(h16)0; }
}
__device__ __forceinline__ void ln_final_store(const h16x8 (&zr)[16][2], float* xo, const float* g, const float* b) {
    const int lane = otid() & 63, wave = otid() >> 6;
    f32x4 g4[2][2], b4[2][2];
#pragma unroll
    for (int j = 0; j < 2; ++j)
#pragma unroll
        for (int q = 0; q < 2; ++q) { g4[j][q] = *(const f32x4*)(g + 8 * lane + 512 * j + 4 * q); b4[j][q] = *(const f32x4*)(b + 8 * lane + 512 * j + 4 * q); }
#pragma unroll
    for (int i = 0; i < 16; ++i) { const int row = (int)blockIdx.x * 8 + wave + i * (int)gridDim.x * 8; float v[2][8]; float s = 0.f;
#pragma unroll
        for (int j = 0; j < 2; ++j)
#pragma unroll
            for (int q = 0; q < 8; ++q) { v[j][q] = (float)zr[i][j][q]; s += v[j][q]; }
        const float mean = wsum_fast(s) * (1.f / DM); float s2 = 0.f;
#pragma unroll
        for (int j = 0; j < 2; ++j)
#pragma unroll
            for (int q = 0; q < 8; ++q) { v[j][q] -= mean; s2 += v[j][q] * v[j][q]; }
        const float rstd = rsqrtf(wsum_fast(s2) * (1.f / DM) + 1e-5f);
        if (row < NTOK) {
#pragma unroll
            for (int j = 0; j < 2; ++j)
#pragma unroll
                for (int q = 0; q < 2; ++q) { f32x4 y;
#pragma unroll
                    for (int t = 0; t < 4; ++t) y[t] = v[j][4 * q + t] * rstd * g4[j][q][t] + b4[j][q][t];
                    *(f32x4*)(xo + (size_t)row * DM + 8 * lane + 512 * j + 4 * q) = y; } } }
}
constexpr int AT_LD = 528;
__device__ __forceinline__ void attn_fill(LAS unsigned char* lds, const bf16_t* src, int ld_src, int tid) {
#pragma unroll 1
    for (int hb = 0; hb < 16; hb += 8) { u32x4 t[8];
#pragma unroll
        for (int i = 0; i < 8; ++i) { const int id = (hb + i) * 512 + tid, row = id >> 5, c = id & 31; t[i] = *(const u32x4*)(src + (size_t)row * ld_src + c * 8); }
#pragma unroll
        for (int i = 0; i < 8; ++i) { const int id = (hb + i) * 512 + tid, row = id >> 5, c = id & 31; *(LAS u32x4*)(lds + row * AT_LD + c * 16) = t[i]; } }
}
__device__ __forceinline__ void attn_phase(const bf16_t* Q, const bf16_t* Kb, const bf16_t* VT, bf16_t* O, unsigned char* shm) {
    const int tid = otid(), lane = tid & 63, wave = tid >> 6, fr = lane & 15, fq = lane >> 4;
    LAS unsigned char* lds = (LAS unsigned char*)shm;
    for (int item = blockIdx.x; item < 512; item += gridDim.x) {
        const int bh = item & 7, b = bh >> 2, h = bh & 3, row0 = b * SEQ + (item >> 3) * 256 + wave * 32;
        bf16x8 qf[2][8];
#pragma unroll
        for (int t = 0; t < 2; ++t)
#pragma unroll
            for (int ks = 0; ks < 8; ++ks) qf[t][ks] = *(const bf16x8*)(Q + (size_t)(row0 + t * 16 + fr) * DM + h * 256 + ks * 32 + fq * 8);
        attn_fill(lds, Kb + (size_t)(b * 256) * DM + h * 256, DM, tid);
        __syncthreads();
        f32x4 s[2][16];
        {
            bf16x8 kf[3][2]; f32x4 a0 = {0.f, 0.f, 0.f, 0.f}, a1 = {0.f, 0.f, 0.f, 0.f};
            const LAS unsigned char* kb = lds + fr * AT_LD + fq * 16;
#pragma unroll
            for (int pg = 0; pg < 2; ++pg)
#pragma unroll
                for (int ks = 0; ks < 2; ++ks) kf[pg][ks] = *(const LAS bf16x8*)(kb + pg * 128 + ks * 64);
#pragma unroll
            for (int g = 0; g < 64; ++g) { const int mt = g >> 2, qd = g & 3;
                if (g + 2 < 64) { const int ng = g + 2; const LAS unsigned char* np = kb + (ng >> 2) * 16 * AT_LD + (ng & 3) * 128;
#pragma unroll
                    for (int ks = 0; ks < 2; ++ks) kf[ng % 3][ks] = *(const LAS bf16x8*)(np + ks * 64); }
                __builtin_amdgcn_sched_barrier(0);
#pragma unroll
                for (int ks = 0; ks < 2; ++ks) { const bf16x8 kv = kf[g % 3][ks];
                    a0 = __builtin_amdgcn_mfma_f32_16x16x32_bf16(kv, qf[0][qd * 2 + ks], a0, 0, 0, 0); a1 = __builtin_amdgcn_mfma_f32_16x16x32_bf16(kv, qf[1][qd * 2 + ks], a1, 0, 0, 0); }
                if (qd == 3) { s[0][mt] = a0; s[1][mt] = a1; a0 = (f32x4){0.f, 0.f, 0.f, 0.f}; a1 = (f32x4){0.f, 0.f, 0.f, 0.f}; }
                __builtin_amdgcn_sched_barrier(0); }
        }
        bf16x8 pb[2][8]; float inv[2];
#pragma unroll
        for (int t = 0; t < 2; ++t) { float mx = -3.0e38f;
#pragma unroll
            for (int mt = 0; mt < 16; ++mt)
#pragma unroll
                for (int q = 0; q < 4; ++q) mx = fmaxf(mx, s[t][mt][q]);
            mx = fmaxf(mx, __shfl_xor(mx, 16)); mx = fmaxf(mx, __shfl_xor(mx, 32));
            float sum = 0.f;
#pragma unroll
            for (int mt = 0; mt < 16; ++mt)
#pragma unroll
                for (int q = 0; q < 4; ++q) { const float pv = __expf(s[t][mt][q] - mx); s[t][mt][q] = pv; sum += pv; }
            sum += __shfl_xor(sum, 16); sum += __shfl_xor(sum, 32); inv[t] = 1.0f / sum;
#pragma unroll
            for (int kp = 0; kp < 8; ++kp) { u32x4 tt; tt.x = pk2(s[t][2 * kp][0], s[t][2 * kp][1]); tt.y = pk2(s[t][2 * kp][2], s[t][2 * kp][3]); tt.z = pk2(s[t][2 * kp + 1][0], s[t][2 * kp + 1][1]); tt.w = pk2(s[t][2 * kp + 1][2], s[t][2 * kp + 1][3]);
                pb[t][kp] = __builtin_bit_cast(bf16x8, tt); } }
        __syncthreads();
        attn_fill(lds, VT + (size_t)((b * 4 + h) * 256) * 256, 256, tid);
        __syncthreads();
        {
            u32x2 vA[8], vB[8]; f32x4 a0 = {0.f, 0.f, 0.f, 0.f}, a1 = {0.f, 0.f, 0.f, 0.f};
            const LAS unsigned char* vb = lds + fr * AT_LD + fq * 8;
#pragma unroll
            for (int q = 0; q < 8; ++q) vA[q] = *(const LAS u32x2*)(vb + q * 32);
#pragma unroll
            for (int g = 0; g < 32; ++g) { const int dt = g >> 1, hf = g & 1;
                if (g + 1 < 32) { const int ndt = (g + 1) >> 1, nhf = (g + 1) & 1; const LAS unsigned char* np = vb + ndt * 16 * AT_LD + nhf * 256;
#pragma unroll
                    for (int q = 0; q < 8; ++q) { if (g & 1) vA[q] = *(const LAS u32x2*)(np + q * 32); else vB[q] = *(const LAS u32x2*)(np + q * 32); } }
                __builtin_amdgcn_sched_barrier(0);
#pragma unroll
                for (int kq = 0; kq < 4; ++kq) { const u32x2 lo = (g & 1) ? vB[2 * kq] : vA[2 * kq], hi = (g & 1) ? vB[2 * kq + 1] : vA[2 * kq + 1]; u32x4 tt; tt.x = lo.x; tt.y = lo.y; tt.z = hi.x; tt.w = hi.y;
                    const bf16x8 vf = __builtin_bit_cast(bf16x8, tt);
                    a0 = __builtin_amdgcn_mfma_f32_16x16x32_bf16(vf, pb[0][hf * 4 + kq], a0, 0, 0, 0); a1 = __builtin_amdgcn_mfma_f32_16x16x32_bf16(vf, pb[1][hf * 4 + kq], a1, 0, 0, 0); }
                if (hf) { u32x2 o; o.x = pk2(a0[0] * inv[0], a0[1] * inv[0]); o.y = pk2(a0[2] * inv[0], a0[3] * inv[0]);
                    *(u32x2*)(O + (size_t)(row0 + fr) * DM + h * 256 + dt * 16 + fq * 4) = o;
                    o.x = pk2(a1[0] * inv[1], a1[1] * inv[1]); o.y = pk2(a1[2] * inv[1], a1[3] * inv[1]);
                    *(u32x2*)(O + (size_t)(row0 + 16 + fr) * DM + h * 256 + dt * 16 + fq * 4) = o;
                    a0 = (f32x4){0.f, 0.f, 0.f, 0.f}; a1 = (f32x4){0.f, 0.f, 0.f, 0.f}; }
                __builtin_amdgcn_sched_barrier(0); }
        }
        __syncthreads();
    }
}
__device__ __forceinline__ void even_core(CArgsP a, int e, unsigned char* shm) {
    const bf16_t* H = (const bf16_t*)(a->ws + WS_H); bf16_t* POOLED = (bf16_t*)(a->ws + WS_LO); bf16_t* CONCAT = (bf16_t*)(a->ws + WS_XB);
    const int tid = otid(), lane = tid & 63, wave = tid >> 6;
    LAS float* Wl = (LAS float*)shm; LAS float* Vl = Wl + 128 * 129; LAS float* st = Vl + 128 * 128;
    const float* sgw = a->in[17] + (size_t)e * 4 * 128 * 128; const float* sgb = a->in[18] + (size_t)e * 4 * 128;
    const float* lng = a->in[15] + (size_t)e * 512; const float* lnb = a->in[16] + (size_t)e * 512;
    for (int chunk = blockIdx.x; chunk < NTOK / 128; chunk += gridDim.x) {
        const int tok0 = chunk * 128, tseq0 = tok0 & (SEQ - 1);
        {
            const int c = tid, grp = c >> 7; float hist[16]; hist[0] = 0.f;
#pragma unroll
            for (int u = 1; u < 16; ++u) { const int p = u - 16; hist[u] = (tseq0 + p >= 0) ? bf2f(H[(size_t)(tok0 + p) * 1536 + c]) : 0.f; }
            for (int tb = 0; tb < 128; tb += 16) { unsigned short xs[16];
#pragma unroll
                for (int u = 0; u < 16; ++u) xs[u] = H[(size_t)(tok0 + tb + u) * 1536 + c];
#pragma unroll
                for (int u = 0; u < 16; ++u) { const int t = tb + u; const float x = bf2f(xs[u]); hist[u] = x;
                    const float s2 = x + hist[(u + 15) & 15];
                    const float s4 = s2 + hist[(u + 14) & 15] + hist[(u + 13) & 15];
                    const float s8 = s4 + (hist[(u + 12) & 15] + hist[(u + 11) & 15]) + (hist[(u + 10) & 15] + hist[(u + 9) & 15]);
                    const float s16 = s8 + ((hist[(u + 8) & 15] + hist[(u + 7) & 15]) + (hist[(u + 6) & 15] + hist[(u + 5) & 15])) + ((hist[(u + 4) & 15] + hist[(u + 3) & 15]) + (hist[(u + 2) & 15] + hist[(u + 1) & 15]));
                    const float sum = grp == 0 ? s2 : grp == 1 ? s4 : grp == 2 ? s8 : s16; const int win = 2 << grp, pos = tseq0 + t + 1;
                    const float dv = (float)(pos < win ? pos : win);
                    POOLED[(size_t)(tok0 + t) * 512 + c] = f2bf(sum / dv - x); }
            }
        }
        { bf16x8 v8a[16];
#pragma unroll
          for (int i = 0; i < 16; ++i) v8a[i] = *(const bf16x8*)(H + (size_t)(tok0 + wave + 8 * i) * 1536 + 1024 + lane * 8);
          __builtin_amdgcn_sched_barrier(0);
#pragma unroll
          for (int i = 0; i < 16; ++i) { const int t = wave + 8 * i; float f[8], s = 0.f;
#pragma unroll
            for (int q = 0; q < 8; ++q) { f[q] = bfs2f(v8a[i][q]); s += f[q]; }
            const float mean = wsum_fast(s) * (1.f / 512.f); float s2 = 0.f;
#pragma unroll
            for (int q = 0; q < 8; ++q) { const float d = f[q] - mean; s2 += d * d; }
            const float var = wsum_fast(s2) * (1.f / 512.f);
            if (lane == 0) { st[2 * t] = mean; st[2 * t + 1] = rsqrtf(var + 1e-5f); } } }
        __syncthreads();
        for (int h = 0; h < 4; ++h) {
            { f32x4 w4a[8];
#pragma unroll
              for (int it = 0; it < 8; ++it) { const int idx = it * 512 + tid, t = idx >> 5, s0 = (idx & 31) * 4; w4a[it] = *(const f32x4*)(sgw + (size_t)(h * 128 + t) * 128 + s0); }
              __builtin_amdgcn_sched_barrier(0);
#pragma unroll
              for (int it = 0; it < 8; ++it) { const int idx = it * 512 + tid, t = idx >> 5, s0 = (idx & 31) * 4;
#pragma unroll
                  for (int q = 0; q < 4; ++q) Wl[t * 129 + s0 + q] = (s0 + q <= t) ? w4a[it][q] : 0.f; } }
#pragma unroll
            for (int it = 0; it < 4; ++it) { const int idx = it * 512 + tid, s = idx >> 4, d0 = (idx & 15) * 8; const bf16x8 v8 = *(const bf16x8*)(H + (size_t)(tok0 + s) * 1536 + 1024 + h * 128 + d0);
                const float mean = st[2 * s], rstd = st[2 * s + 1];
#pragma unroll
                for (int q = 0; q < 8; ++q) Vl[s * 128 + d0 + q] = (bfs2f(v8[q]) - mean) * rstd * lng[h * 128 + d0 + q] + lnb[h * 128 + d0 + q]; }
            __syncthreads();
            const int d0 = (tid & 15) * 8, t0 = (tid >> 4) * 4;
            float acc[4][8];
#pragma unroll
            for (int i = 0; i < 4; ++i)
#pragma unroll
                for (int q = 0; q < 8; ++q) acc[i][q] = 0.f;
            for (int s = 0; s <= t0 + 3; ++s) { const f32x4 va = *(const LAS f32x4*)(Vl + s * 128 + d0), vb = *(const LAS f32x4*)(Vl + s * 128 + d0 + 4);
#pragma unroll
                for (int i = 0; i < 4; ++i) { const float w = Wl[(t0 + i) * 129 + s];
#pragma unroll
                    for (int q = 0; q < 4; ++q) { acc[i][q] += w * va[q]; acc[i][4 + q] += w * vb[q]; } } }
            bf16x8 u8a[4]; float biasa[4];
#pragma unroll
            for (int i = 0; i < 4; ++i) { u8a[i] = *(const bf16x8*)(H + (size_t)(tok0 + t0 + i) * 1536 + 512 + h * 128 + d0); biasa[i] = sgb[h * 128 + t0 + i]; }
#pragma unroll
            for (int i = 0; i < 4; ++i) { const int t = t0 + i; const float bias = biasa[i]; const bf16x8 u8 = u8a[i];
                float o[8];
#pragma unroll
                for (int q = 0; q < 8; ++q) o[q] = bfs2f(u8[q]) * (acc[i][q] + bias);
                u32x4 ov; ov.x = pk2(o[0], o[1]); ov.y = pk2(o[2], o[3]); ov.z = pk2(o[4], o[5]); ov.w = pk2(o[6], o[7]);
                *(u32x4*)(CONCAT + (size_t)(tok0 + t) * 1024 + 512 + h * 128 + d0) = ov; }
            __syncthreads();
        }
    }
}
__device__ __forceinline__ void odd_prep(CArgsP a, int e) {
    const bf16_t* H = (const bf16_t*)(a->ws + WS_H); bf16_t* AP = (bf16_t*)(a->ws + WS_AP); bf16_t* XC = (bf16_t*)(a->ws + WS_XC);
    const float* mu = a->in[21] + (size_t)e * 1792; const float* cw = a->in[32] + (size_t)e * 4 * 512; const float* cb = a->in[33] + (size_t)e * 512;
    const int gtid = blockIdx.x * 512 + otid(), nth = gridDim.x * 512;
    const bf16x8 z8 = {0, 0, 0, 0, 0, 0, 0, 0};
    float muA[8], cbX[8], cwX[4][8];
    { const int cA = (gtid & 31) * 8, cX = (gtid & 63) * 8;
#pragma unroll
      for (int q = 0; q < 8; ++q) { muA[q] = mu[1536 + cA + q]; cbX[q] = cb[cX + q];
#pragma unroll
          for (int i = 0; i < 4; ++i) cwX[i][q] = cw[i * 512 + cX + q]; } }
    for (int it0 = gtid; it0 < NTOK * 32; it0 += nth * 4) { bf16x8 cur[4], prv[4];
#pragma unroll
        for (int u = 0; u < 4; ++u) { const int it = it0 + u * nth, tok = it >> 5, c0 = (it & 31) * 8; const bool ok = it < NTOK * 32;
            cur[u] = ok ? *(const bf16x8*)(H + (size_t)tok * 2816 + 1536 + c0) : z8;
            prv[u] = (ok && (tok & (SEQ - 1))) ? *(const bf16x8*)(H + (size_t)(tok - 1) * 2816 + 1536 + c0) : z8; }
#pragma unroll
        for (int u = 0; u < 4; ++u) { const int it = it0 + u * nth, tok = it >> 5, c0 = (it & 31) * 8; if (it < NTOK * 32) { float v[8];
#pragma unroll
            for (int q = 0; q < 8; ++q) { const float c = bfs2f(cur[u][q]), z = c + muA[q] * (bfs2f(prv[u][q]) - c); v[q] = c0 < 64 ? tanhf_(z) : (c0 < 128 ? z : sigmoidf_(z)); }
            u32x4 o; o.x = pk2(v[0], v[1]); o.y = pk2(v[2], v[3]); o.z = pk2(v[4], v[5]); o.w = pk2(v[6], v[7]); *(u32x4*)(AP + (size_t)tok * 256 + c0) = o; } } }
    for (int it0 = gtid; it0 < NTOK * 64; it0 += nth * 4) { bf16x8 x8[4][4];
#pragma unroll
        for (int u = 0; u < 4; ++u) { const int it = it0 + u * nth, tok = it >> 6, c0 = (it & 63) * 8, tseq = tok & (SEQ - 1); const bool ok = it < NTOK * 64;
#pragma unroll
            for (int i = 0; i < 4; ++i) x8[u][i] = (ok && tseq - 3 + i >= 0) ? *(const bf16x8*)(H + (size_t)(tok - 3 + i) * 2816 + 2304 + c0) : z8; }
#pragma unroll
        for (int u = 0; u < 4; ++u) { const int it = it0 + u * nth, tok = it >> 6, c0 = (it & 63) * 8; if (it < NTOK * 64) { float v[8];
#pragma unroll
            for (int q = 0; q < 8; ++q) v[q] = cbX[q];
#pragma unroll
            for (int i = 0; i < 4; ++i)
#pragma unroll
                for (int q = 0; q < 8; ++q) v[q] += cwX[i][q] * bfs2f(x8[u][i][q]);
            u32x4 o; o.x = pk2(v[0], v[1]); o.y = pk2(v[2], v[3]); o.z = pk2(v[4], v[5]); o.w = pk2(v[6], v[7]); *(u32x4*)(XC + (size_t)tok * 512 + c0) = o; } } }
}
constexpr int RW_STEP = 448, RW_WAVE = 8 * RW_STEP + 8;
typedef float f32x2 __attribute__((ext_vector_type(2)));
__device__ __forceinline__ float red8(float v) {
    v += __builtin_bit_cast(float, __builtin_amdgcn_update_dpp(0, __builtin_bit_cast(int, v), 0xB1, 0xF, 0xF, false));
    v += __builtin_bit_cast(float, __builtin_amdgcn_update_dpp(0, __builtin_bit_cast(int, v), 0x4E, 0xF, 0xF, false));
    v += __builtin_bit_cast(float, __builtin_amdgcn_update_dpp(0, __builtin_bit_cast(int, v), 0x141, 0xF, 0xF, false));
    return v;
}
__device__ __forceinline__ float red4(float v) { v += DPP_F(v, 0xB1); v += DPP_F(v, 0x4E); return v; }
#define LD8P(dst, ptr) do { _Pragma("unroll") for (int _q = 0; _q < 4; ++_q) { const f32x4 _t = *(const LAS f32x4*)((ptr) + 4 * _q); dst[2 * _q] = (f32x2){_t[0], _t[1]}; dst[2 * _q + 1] = (f32x2){_t[2], _t[3]}; } } while (0)
template <int MODE> __device__ __forceinline__ void rwkv_scan(CArgsP a, int e, int bh, int c, LAS float* wl) {
    const int lane = otid() & 63, b = bh >> 3, h = bh & 7, cj = h * 64 + lane, ib = lane >> 2, jb = lane & 3;
    const bf16_t* H = (const bf16_t*)(a->ws + WS_H); const bf16_t* LO = (const bf16_t*)(a->ws + WS_LO); bf16_t* CONCAT = (bf16_t*)(a->ws + WS_XB);
    float* Lc = (float*)(a->ws + WS_AP); float* Mc = Lc + (size_t)16 * NCH * 4096; float* Ss = Mc + (size_t)16 * NCH * 4096;
    const size_t sidx = ((size_t)bh * NCH + c) * 4096 + (size_t)(ib * 4) * 64 + jb * 16;
    const int tok0 = b * SEQ + c * TCH;
    const float* mu = a->in[21] + (size_t)e * 1792;
    const float mu_r = mu[cj], mu_k = mu[512 + cj], mu_v = mu[1024 + cj], kkc = a->in[27][e * 512 + cj], kac = a->in[28][e * 512 + cj], rkc = a->in[29][e * 512 + cj];
    const float gng = a->in[30][e * 512 + cj], gnb = a->in[31][e * 512 + cj];
    const float w0c = a->in[22][e * 512 + cj], a0c = a->in[24][e * 512 + cj];
    f32x2 S[4][8];
    if (MODE == 2) {
#pragma unroll
        for (int r = 0; r < 4; ++r)
#pragma unroll
            for (int q = 0; q < 4; ++q) { const f32x4 t = *(const f32x4*)(Ss + sidx + r * 64 + 4 * q); S[r][2 * q] = (f32x2){t[0], t[1]}; S[r][2 * q + 1] = (f32x2){t[2], t[3]}; }
    } else {
#pragma unroll
        for (int r = 0; r < 4; ++r)
#pragma unroll
            for (int q = 0; q < 8; ++q) { const int row = ib * 4 + r, col = jb * 16 + 2 * q; S[r][q][0] = (MODE == 1 && row == col) ? 1.f : 0.f; S[r][q][1] = (MODE == 1 && row == col + 1) ? 1.f : 0.f; }
    }
    float pr = 0.f, pk = 0.f, pv = 0.f;
    if (c > 0) { const bf16_t* hp = H + (size_t)(tok0 - 1) * 2816 + cj; pr = bf2f(hp[0]); pk = bf2f(hp[512]); pv = bf2f(hp[1024]); }
    unsigned short rw[8][6];
#define RW_LOAD(T0) do { _Pragma("unroll") for (int s = 0; s < 8; ++s) { const size_t tok = (size_t)(tok0 + (T0) + s); const bf16_t* hp = H + tok * 2816 + cj; const bf16_t* lp = LO + tok * 1536 + cj; \
        rw[s][0] = hp[0]; rw[s][1] = hp[512]; rw[s][2] = hp[1024]; rw[s][3] = lp[0]; rw[s][4] = lp[512]; if (MODE == 2) rw[s][5] = lp[1024]; } } while (0)
    RW_LOAD(0);
    for (int t0 = 0; t0 < TCH; t0 += 8) {
#pragma unroll
        for (int s = 0; s < 8; ++s) {
            const float rr = bf2f(rw[s][0]), kr = bf2f(rw[s][1]), vr = bf2f(rw[s][2]), ee = __expf(-softplusf_(-(w0c + bf2f(rw[s][3]))) - 0.5f), aa = sigmoidf_(a0c + bf2f(rw[s][4]));
            const float rl = rr + mu_r * (pr - rr), kl = kr + mu_k * (pk - kr), vl = vr + mu_v * (pv - vr); pr = rr; pk = kr; pv = vr;
            const float kkj = kl * kkc, ss = wsum_fast(kkj * kkj), kn = kkj * rsqrtf(fmaxf(ss, 1e-24f));
            const float kp = kl * (1.0f + (aa - 1.0f) * kac), dec = __expf(-ee);
            LAS float* base = wl + s * RW_STEP;
            base[lane] = -kn; base[64 + lane] = dec; base[128 + lane] = kn * aa; base[192 + lane] = kp; base[320 + lane] = vl;
            if (MODE == 2) { base[256 + lane] = rl; base[384 + lane] = bf2f(rw[s][5]); const float bd = wsum_fast(rl * kp * rkc); if (lane == 0) wl[8 * RW_STEP + s] = bd; } }
        if (t0 + 8 < TCH) RW_LOAD(t0 + 8);
        LDS_SYNC_WAVE();
#pragma unroll 2
        for (int s = 0; s < 8; ++s) { const LAS float* base = wl + s * RW_STEP;
            f32x2 av[8], dc[8], bv[8], kp[8]; f32x4 vr4 = {0.f, 0.f, 0.f, 0.f};
            LD8P(av, base + jb * 16); LD8P(dc, base + 64 + jb * 16); LD8P(bv, base + 128 + jb * 16);
            if (MODE != 1) { LD8P(kp, base + 192 + jb * 16); vr4 = *(const LAS f32x4*)(base + 320 + ib * 4); }
            float sa[4];
#pragma unroll
            for (int r = 0; r < 4; ++r) { f32x2 p = S[r][0] * av[0];
#pragma unroll
                for (int q = 1; q < 8; ++q) p += S[r][q] * av[q];
                sa[r] = red4(p[0] + p[1]); }
#pragma unroll
            for (int r = 0; r < 4; ++r) { const f32x2 sa2 = (f32x2){sa[r], sa[r]};
                if (MODE == 1) {
#pragma unroll
                    for (int q = 0; q < 8; ++q) S[r][q] = S[r][q] * dc[q] + sa2 * bv[q];
                } else { const f32x2 v2 = (f32x2){vr4[r], vr4[r]};
#pragma unroll
                    for (int q = 0; q < 8; ++q) S[r][q] = S[r][q] * dc[q] + (sa2 * bv[q] + v2 * kp[q]); } }
            if (MODE == 2) { f32x2 rv[8]; LD8P(rv, base + 256 + jb * 16);
                float y = 0.f;
#pragma unroll
                for (int r = 0; r < 4; ++r) { f32x2 p = S[r][0] * rv[0];
#pragma unroll
                    for (int q = 1; q < 8; ++q) p += S[r][q] * rv[q];
                    const float yr = red4(p[0] + p[1]); y = (jb == r) ? yr : y; }
                const float vi = base[320 + lane];
                const float mean = wsum_fast(y) * (1.f / 64.f), ey2 = wsum_fast(y * y) * (1.f / 64.f), dl = y - mean, var = fmaxf(ey2 - mean * mean, 0.f);
                const float yn = dl * rsqrtf(var + 64e-5f) * gng + gnb;
                const float o = (yn + wl[8 * RW_STEP + s] * vi) * base[384 + lane];
                CONCAT[(size_t)(tok0 + t0 + s) * 1024 + cj] = f2bf(o); } }
        LDS_SYNC_WAVE();
    }
#undef RW_LOAD
    if (MODE != 2) { float* dst = (MODE == 0 ? Lc : Mc) + sidx;
#pragma unroll
        for (int r = 0; r < 4; ++r)
#pragma unroll
            for (int q = 0; q < 4; ++q) { f32x4 t; t[0] = S[r][2 * q][0]; t[1] = S[r][2 * q][1]; t[2] = S[r][2 * q + 1][0]; t[3] = S[r][2 * q + 1][1]; *(f32x4*)(dst + r * 64 + 4 * q) = t; } }
}
template <int MODE> __device__ __forceinline__ void rwkv_pass1_pair(CArgsP a, int e, int bh, int c, LAS float* pl) {
    const int lane = otid() & 63, b = bh >> 3, h = bh & 7, cj = h * 64 + lane, ib = lane >> 2, jb = lane & 3;
    const bf16_t* H = (const bf16_t*)(a->ws + WS_H); const bf16_t* LO = (const bf16_t*)(a->ws + WS_LO);
    float* Lc = (float*)(a->ws + WS_AP); float* Mc = Lc + (size_t)16 * NCH * 4096;
    const size_t sidx = ((size_t)bh * NCH + c) * 4096 + (size_t)(ib * 4) * 64 + jb * 16;
    const int tok0 = b * SEQ + c * TCH;
    const float* mu = a->in[21] + (size_t)e * 1792;
    const float mu_k = mu[512 + cj], mu_v = mu[1024 + cj], kkc = a->in[27][e * 512 + cj], kac = a->in[28][e * 512 + cj];
    const float w0c = a->in[22][e * 512 + cj], a0c = a->in[24][e * 512 + cj];
    f32x2 S[4][8];
#pragma unroll
    for (int r = 0; r < 4; ++r)
#pragma unroll
        for (int q = 0; q < 8; ++q) { const int row = ib * 4 + r, col = jb * 16 + 2 * q; S[r][q][0] = (MODE == 1 && row == col) ? 1.f : 0.f; S[r][q][1] = (MODE == 1 && row == col + 1) ? 1.f : 0.f; }
    unsigned short rw[5][4];
#define RW1_LOAD(T0) do { _Pragma("unroll") for (int s = 0; s < 5; ++s) { const int tk = tok0 + (T0) + MODE * 4 + s - 1; const bf16_t* hp = H + (size_t)tk * 2816 + cj; const bf16_t* lp = LO + (size_t)tk * 1536 + cj; \
        if (s == 0) { const bool have = (c > 0) || ((T0) + MODE * 4 > 0); rw[0][0] = have ? hp[512] : (unsigned short)0; rw[0][1] = have ? hp[1024] : (unsigned short)0; } \
        else { rw[s][0] = hp[512]; rw[s][1] = hp[1024]; rw[s][2] = lp[0]; rw[s][3] = lp[512]; } } } while (0)
    RW1_LOAD(0);
    for (int t0 = 0; t0 < TCH; t0 += 8) {
        float pk = bf2f(rw[0][0]), pv = bf2f(rw[0][1]);
#pragma unroll
        for (int u = 0; u < 4; ++u) { const int s = MODE * 4 + u;
            const float kr = bf2f(rw[u + 1][0]), vr = bf2f(rw[u + 1][1]), ee = __expf(-softplusf_(-(w0c + bf2f(rw[u + 1][2]))) - 0.5f), aa = sigmoidf_(a0c + bf2f(rw[u + 1][3]));
            const float kl = kr + mu_k * (pk - kr), vl = vr + mu_v * (pv - vr); pk = kr; pv = vr;
            const float kkj = kl * kkc, ss = wsum_fast(kkj * kkj), kn = kkj * rsqrtf(fmaxf(ss, 1e-24f));
            const float kp = kl * (1.0f + (aa - 1.0f) * kac), dec = __expf(-ee);
            LAS float* base = pl + s * RW_STEP;
            base[lane] = -kn; base[64 + lane] = dec; base[128 + lane] = kn * aa; base[192 + lane] = kp; base[320 + lane] = vl; }
        if (t0 + 8 < TCH) RW1_LOAD(t0 + 8);
        __syncthreads();
#pragma unroll 2
        for (int s = 0; s < 8; ++s) { const LAS float* base = pl + s * RW_STEP;
            f32x2 av[8], dc[8], bv[8], kp[8]; f32x4 vr4 = {0.f, 0.f, 0.f, 0.f};
            LD8P(av, base + jb * 16); LD8P(dc, base + 64 + jb * 16); LD8P(bv, base + 128 + jb * 16);
            if (MODE == 0) { LD8P(kp, base + 192 + jb * 16); vr4 = *(const LAS f32x4*)(base + 320 + ib * 4); }
            float sa[4];
#pragma unroll
            for (int r = 0; r < 4; ++r) { f32x2 pp = S[r][0] * av[0];
#pragma unroll
                for (int q = 1; q < 8; ++q) pp += S[r][q] * av[q];
                sa[r] = red4(pp[0] + pp[1]); }
#pragma unroll
            for (int r = 0; r < 4; ++r) { const f32x2 sa2 = (f32x2){sa[r], sa[r]};
                if (MODE == 1) {
#pragma unroll
                    for (int q = 0; q < 8; ++q) S[r][q] = S[r][q] * dc[q] + sa2 * bv[q];
                } else { const f32x2 v2 = (f32x2){vr4[r], vr4[r]};
#pragma unroll
                    for (int q = 0; q < 8; ++q) S[r][q] = S[r][q] * dc[q] + (sa2 * bv[q] + v2 * kp[q]); } } }
        __syncthreads();
    }
#undef RW1_LOAD
    float* dst = (MODE == 0 ? Lc : Mc) + sidx;
#pragma unroll
    for (int r = 0; r < 4; ++r)
#pragma unroll
        for (int q = 0; q < 4; ++q) { f32x4 t; t[0] = S[r][2 * q][0]; t[1] = S[r][2 * q][1]; t[2] = S[r][2 * q + 1][0]; t[3] = S[r][2 * q + 1][1]; *(f32x4*)(dst + r * 64 + 4 * q) = t; }
}
#define LD4P(dst, ptr) do { const f32x4 _t0 = *(const LAS f32x4*)(ptr), _t1 = *(const LAS f32x4*)((ptr) + 4); dst[0] = (f32x2){_t0[0], _t0[1]}; dst[1] = (f32x2){_t0[2], _t0[3]}; dst[2] = (f32x2){_t1[0], _t1[1]}; dst[3] = (f32x2){_t1[2], _t1[3]}; } while (0)
constexpr int RW_PAIR = RW_WAVE + 1024;
__device__ __forceinline__ void rwkv_pass2_pair(CArgsP a, int e, int bh, int c, int hf, LAS float* pl) {
    const int lane = otid() & 63, b = bh >> 3, h = bh & 7, cj = h * 64 + lane, ib = lane >> 3, jb = lane & 7;
    const bf16_t* H = (const bf16_t*)(a->ws + WS_H); const bf16_t* LO = (const bf16_t*)(a->ws + WS_LO); bf16_t* CONCAT = (bf16_t*)(a->ws + WS_XB);
    const float* Ss = (const float*)(a->ws + WS_AP) + (size_t)2 * 16 * NCH * 4096;
    const size_t sidx = ((size_t)bh * NCH + c) * 4096 + (size_t)(hf * 32 + ib * 4) * 64 + jb * 8;
    const int tok0 = b * SEQ + c * TCH;
    const float* mu = a->in[21] + (size_t)e * 1792;
    const float mu_r = mu[cj], mu_k = mu[512 + cj], mu_v = mu[1024 + cj], kkc = a->in[27][e * 512 + cj], kac = a->in[28][e * 512 + cj], rkc = a->in[29][e * 512 + cj];
    const float gng = a->in[30][e * 512 + cj], gnb = a->in[31][e * 512 + cj];
    const float w0c = a->in[22][e * 512 + cj], a0c = a->in[24][e * 512 + cj];
    LAS float* yb = pl + RW_WAVE;
    f32x2 S[4][4];
#pragma unroll
    for (int r = 0; r < 4; ++r) { const f32x4 t0 = *(const f32x4*)(Ss + sidx + r * 64), t1 = *(const f32x4*)(Ss + sidx + r * 64 + 4);
        S[r][0] = (f32x2){t0[0], t0[1]}; S[r][1] = (f32x2){t0[2], t0[3]}; S[r][2] = (f32x2){t1[0], t1[1]}; S[r][3] = (f32x2){t1[2], t1[3]}; }
    unsigned short rw[5][6];
#define RW2_LOAD(T0) do { _Pragma("unroll") for (int s = 0; s < 5; ++s) { const int tk = tok0 + (T0) + hf * 4 + s - 1; const bool ok = ((tk & (SEQ - 1)) != SEQ - 1) || s > 0 || true; \
        const bf16_t* hp = H + (size_t)tk * 2816 + cj; const bf16_t* lp = LO + (size_t)tk * 1536 + cj; (void)ok; \
        if (s == 0) { const bool have = (c > 0) || ((T0) + hf * 4 > 0); rw[0][0] = have ? hp[0] : (unsigned short)0; rw[0][1] = have ? hp[512] : (unsigned short)0; rw[0][2] = have ? hp[1024] : (unsigned short)0; } \
        else { rw[s][0] = hp[0]; rw[s][1] = hp[512]; rw[s][2] = hp[1024]; rw[s][3] = lp[0]; rw[s][4] = lp[512]; rw[s][5] = lp[1024]; } } } while (0)
    RW2_LOAD(0);
    for (int t0 = 0; t0 < TCH; t0 += 8) {
        float pr = bf2f(rw[0][0]), pk = bf2f(rw[0][1]), pv = bf2f(rw[0][2]);
#pragma unroll
        for (int u = 0; u < 4; ++u) { const int s = hf * 4 + u;
            const float rr = bf2f(rw[u + 1][0]), kr = bf2f(rw[u + 1][1]), vr = bf2f(rw[u + 1][2]), ee = __expf(-softplusf_(-(w0c + bf2f(rw[u + 1][3]))) - 0.5f), aa = sigmoidf_(a0c + bf2f(rw[u + 1][4]));
            const float rl = rr + mu_r * (pr - rr), kl = kr + mu_k * (pk - kr), vl = vr + mu_v * (pv - vr); pr = rr; pk = kr; pv = vr;
            const float kkj = kl * kkc, ss = wsum_fast(kkj * kkj), kn = kkj * rsqrtf(fmaxf(ss, 1e-24f));
            const float kp = kl * (1.0f + (aa - 1.0f) * kac), dec = __expf(-ee);
            LAS float* base = pl + s * RW_STEP;
            base[lane] = -kn; base[64 + lane] = dec; base[128 + lane] = kn * aa; base[192 + lane] = kp; base[256 + lane] = rl; base[320 + lane] = vl; base[384 + lane] = bf2f(rw[u + 1][5]);
            const float bd = wsum_fast(rl * kp * rkc); if (lane == 0) pl[8 * RW_STEP + s] = bd; }
        if (t0 + 8 < TCH) RW2_LOAD(t0 + 8);
        __syncthreads();
#pragma unroll 2
        for (int s = 0; s < 8; ++s) { const LAS float* base = pl + s * RW_STEP;
            f32x2 av[4], dc[4], bv[4], kp[4], rv[4];
            LD4P(av, base + jb * 8); LD4P(dc, base + 64 + jb * 8); LD4P(bv, base + 128 + jb * 8); LD4P(kp, base + 192 + jb * 8); LD4P(rv, base + 256 + jb * 8);
            const f32x4 v4 = *(const LAS f32x4*)(base + 320 + hf * 32 + ib * 4);
            float sa[4];
#pragma unroll
            for (int r = 0; r < 4; ++r) { f32x2 pp = S[r][0] * av[0]; pp += S[r][1] * av[1]; pp += S[r][2] * av[2]; pp += S[r][3] * av[3]; sa[r] = red8(pp[0] + pp[1]); }
            float ysel = 0.f;
#pragma unroll
            for (int r = 0; r < 4; ++r) { const f32x2 sa2 = (f32x2){sa[r], sa[r]}, v2 = (f32x2){v4[r], v4[r]};
#pragma unroll
                for (int q = 0; q < 4; ++q) S[r][q] = S[r][q] * dc[q] + (sa2 * bv[q] + v2 * kp[q]);
                f32x2 pp = S[r][0] * rv[0]; pp += S[r][1] * rv[1]; pp += S[r][2] * rv[2]; pp += S[r][3] * rv[3]; const float yr = red8(pp[0] + pp[1]); ysel = (jb == r) ? yr : ysel; }
            if (jb < 4) yb[s * 64 + hf * 32 + ib * 4 + jb] = ysel; }
        __syncthreads();
#pragma unroll
        for (int u = 0; u < 4; ++u) { const int s = hf * 4 + u; const LAS float* base = pl + s * RW_STEP; const float y = yb[s * 64 + lane], vi = base[320 + lane];
            const float mean = wsum_fast(y) * (1.f / 64.f), ey2 = wsum_fast(y * y) * (1.f / 64.f), dl = y - mean, var = fmaxf(ey2 - mean * mean, 0.f);
            const float yn = dl * rsqrtf(var + 64e-5f) * gng + gnb;
            const float o = (yn + pl[8 * RW_STEP + s] * vi) * base[384 + lane];
            CONCAT[(size_t)(tok0 + t0 + s) * 1024 + cj] = f2bf(o); }
        __syncthreads();
    }
#undef RW2_LOAD
}
__device__ __forceinline__ void rwkv_combine(CArgsP a, int blk, unsigned char* shm) {
    float* Lc = (float*)(a->ws + WS_AP); float* Mc = Lc + (size_t)16 * NCH * 4096; float* Ss = Mc + (size_t)16 * NCH * 4096;
    LAS float* Sc = (LAS float*)shm; LAS float* Mb = Sc + 512;
    const int tid = otid(), bh = blk >> 3, rg = blk & 7, r = tid >> 6, j = tid & 63;
    const size_t mbase = (size_t)bh * NCH * 4096, rowoff = (size_t)(rg * 8 + r) * 64 + j;
    float cur = 0.f;
    f32x4 mn0 = *(const f32x4*)(Mc + mbase + tid * 8), mn1 = *(const f32x4*)(Mc + mbase + tid * 8 + 4); float ln = Lc[mbase + rowoff];
    for (int c = 0; c < NCH; ++c) {
        Ss[mbase + (size_t)c * 4096 + rowoff] = cur;
        Sc[r * 64 + j] = cur; *(LAS f32x4*)(Mb + tid * 8) = mn0; *(LAS f32x4*)(Mb + tid * 8 + 4) = mn1;
        float acc = ln;
        __syncthreads();
        if (c + 1 < NCH) { const size_t nb = mbase + (size_t)(c + 1) * 4096; mn0 = *(const f32x4*)(Mc + nb + tid * 8); mn1 = *(const f32x4*)(Mc + nb + tid * 8 + 4); ln = Lc[nb + rowoff]; }
        { float mb[64]; f32x4 sv[16];
#pragma unroll
          for (int k = 0; k < 64; ++k) mb[k] = Mb[k * 64 + j];
#pragma unroll
          for (int k = 0; k < 16; ++k) sv[k] = *(const LAS f32x4*)(Sc + r * 64 + 4 * k);
          __builtin_amdgcn_sched_barrier(0);
          float a0 = acc, a1 = 0.f, a2 = 0.f, a3 = 0.f;
#pragma unroll
          for (int k = 0; k < 16; ++k) { a0 += sv[k][0] * mb[4 * k]; a1 += sv[k][1] * mb[4 * k + 1]; a2 += sv[k][2] * mb[4 * k + 2]; a3 += sv[k][3] * mb[4 * k + 3]; }
          acc = (a0 + a1) + (a2 + a3); }
        cur = acc;
        __syncthreads();
    }
}
__device__ __forceinline__ void lru_pass_a(CArgsP a, int gtid, int nth) {
    const bf16_t* LGA = (const bf16_t*)(a->ws + WS_LA); const bf16_t* BX = LGA + (size_t)NTOK * 512; float2* PE = (float2*)(a->ws + WS_MISC + 3 * MiB);
    for (int it = gtid; it < 2 * NLCH * 512; it += nth) { const int ch = it & 511, cc = (it >> 9) & (NLCH - 1), b = it >> 16; const size_t base = ((size_t)b * SEQ + (size_t)cc * LCH) * 512 + ch;
        float P = 1.f, E = 0.f;
#pragma unroll 1
        for (int tb = 0; tb < LCH; tb += 16) { unsigned short la[16], bx[16];
#pragma unroll
            for (int u = 0; u < 16; ++u) { la[u] = LGA[base + (size_t)(tb + u) * 512]; bx[u] = BX[base + (size_t)(tb + u) * 512]; }
            __builtin_amdgcn_sched_barrier(0);
#pragma unroll
            for (int u = 0; u < 16; ++u) { const float av = __expf(bf2f(la[u])); P *= av; E = av * E + bf2f(bx[u]); } }
        PE[it] = make_float2(P, E); }
}
__device__ __forceinline__ void lru_pass_c2(CArgsP a, int gtid, int nth) {
    const unsigned* LGA = (const unsigned*)(a->ws + WS_LA); const unsigned* BX = LGA + (size_t)NTOK * 256; const f32x4* PE = (const f32x4*)(a->ws + WS_MISC + 3 * MiB);
    const unsigned* H = (const unsigned*)(a->ws + WS_H); unsigned* CONCAT = (unsigned*)(a->ws + WS_XB);
    for (int it = gtid; it < 2 * NLCH * 256; it += nth) { const int chp = it & 255, cc = (it >> 8) & (NLCH - 1), b = it >> 15; const size_t tokb = (size_t)b * SEQ + (size_t)cc * LCH;
        float h0 = 0.f, h1 = 0.f;
#pragma unroll 1
        for (int c0 = 0; c0 < cc; c0 += 8) { f32x4 pe[8];
#pragma unroll
            for (int u = 0; u < 8; ++u) pe[u] = (c0 + u < cc) ? PE[(b << 15) + ((c0 + u) << 8) + chp] : (f32x4){1.f, 0.f, 1.f, 0.f};
            __builtin_amdgcn_sched_barrier(0);
#pragma unroll
            for (int u = 0; u < 8; ++u) { h0 = pe[u][0] * h0 + pe[u][1]; h1 = pe[u][2] * h1 + pe[u][3]; } }
        const unsigned* lp = LGA + tokb * 256 + chp; const unsigned* bp = BX + tokb * 256 + chp; const unsigned* gp = H + tokb * 1408 + 896 + chp; unsigned* op = CONCAT + tokb * 512 + 256 + chp;
#pragma unroll 1
        for (int tb = 0; tb < LCH; tb += 8) { unsigned la[8], bx[8], gt[8];
#pragma unroll
            for (int u = 0; u < 8; ++u) { la[u] = lp[(tb + u) * 256]; bx[u] = bp[(tb + u) * 256]; gt[u] = gp[(size_t)(tb + u) * 1408]; }
#pragma unroll
            for (int u = 0; u < 8; ++u) {
                h0 = __expf(__uint_as_float(la[u] << 16)) * h0 + __uint_as_float(bx[u] << 16); h1 = __expf(__uint_as_float(la[u] & 0xffff0000u)) * h1 + __uint_as_float(bx[u] & 0xffff0000u);
                op[(tb + u) * 512] = pk2(h0 * geluf_(__uint_as_float(gt[u] << 16)), h1 * geluf_(__uint_as_float(gt[u] & 0xffff0000u))); } } }
}
__device__ __forceinline__ void lru_carry(CArgsP a, int gtid) {
    if (gtid >= 1024) return;
    const float2* PE = (const float2*)(a->ws + WS_MISC + 3 * MiB); float* CY = (float*)(a->ws + WS_MR + 512 * 1024);
    const int b = gtid >> 9, ch = gtid & 511; float hsv = 0.f;
#pragma unroll 16
    for (int cc = 0; cc < NLCH; ++cc) { const int idx = (b << 16) + (cc << 9) + ch; const float2 pe = PE[idx]; CY[idx] = hsv; hsv = pe.x * hsv + pe.y; }
}
__device__ __forceinline__ void lru_pass_c(CArgsP a, int gtid, int nth) {
    const bf16_t* LGA = (const bf16_t*)(a->ws + WS_LA); const bf16_t* BX = LGA + (size_t)NTOK * 512; const float2* PE = (const float2*)(a->ws + WS_MISC + 3 * MiB);
    const bf16_t* H = (const bf16_t*)(a->ws + WS_H); bf16_t* CONCAT = (bf16_t*)(a->ws + WS_XB);
    for (int it = gtid; it < 2 * NLCH * 512; it += nth) { const int ch = it & 511, cc = (it >> 9) & (NLCH - 1), b = it >> 16; const size_t tokb = (size_t)b * SEQ + (size_t)cc * LCH;
        float hsv = ((const float*)(a->ws + WS_MR + 512 * 1024))[it];
#pragma unroll 8
        for (int t = 0; t < LCH; ++t) { const size_t tok = tokb + t; const float av = __expf(bf2f(LGA[tok * 512 + ch])), bx = bf2f(BX[tok * 512 + ch]); hsv = av * hsv + bx;
            const float gt = bf2f(H[tok * 2816 + 1792 + ch]);
            CONCAT[tok * 1024 + 512 + ch] = f2bf(hsv * geluf_(gt)); } }
}
#ifndef REP_FFN
#define REP_FFN 1
#endif
#ifndef REP_P1
#define REP_P1 1
#endif
#ifndef REP_CB
#define REP_CB 1
#endif
#ifndef REP_P2
#define REP_P2 1
#endif
#ifndef REP_OPRE
#define REP_OPRE 1
#endif
#ifndef REP_AE
#define REP_AE 1
#endif
#ifndef REP_AT
#define REP_AT 1
#endif
#ifndef REP_LN
#define REP_LN 1
#endif
#ifndef REP_IN
#define REP_IN 1
#endif
#ifndef REP_CV
#define REP_CV 1
#endif
#ifndef REP_LC
#define REP_LC 1
#endif
#ifndef REP_R2
#define REP_R2 1
#endif
#ifndef REP_SYNC
#define REP_SYNC 0
#endif
#ifdef SKIP_E
#define SK_E(x)
#else
#define SK_E(x) x
#endif
#ifdef SKIP_O
#define SK_O(x)
#else
#define SK_O(x) x
#endif
#ifdef SKIP_S
#define SK_S(x)
#else
#define SK_S(x) x
#endif
#ifdef SKIP_A
#define SK_A(x)
#else
#define SK_A(x) x
#endif
__global__ __launch_bounds__(512, 2) void mega_fwd(Args a_unused) {
    extern __shared__ __attribute__((aligned(16))) unsigned char shm[];
    cg::grid_group grid = cg::this_grid();
#define a argp()
#define ws (a->ws)
#define P_W ((bf16_t*)(ws + WS_W))
#define P_XB ((bf16_t*)(ws + WS_XB))
#define P_H ((bf16_t*)(ws + WS_H))
#define P_LO ((bf16_t*)(ws + WS_LO))
#define P_AP ((bf16_t*)(ws + WS_AP))
#define P_XC ((bf16_t*)(ws + WS_XC))
#define P_LGA ((bf16_t*)(ws + WS_LA))
#define P_BX (P_LGA + (size_t)NTOK * 512)
#define P_Kb ((bf16_t*)(ws + WS_MISC))
#define P_VT ((bf16_t*)(ws + WS_MISC + MiB))
#define P_MEMB ((bf16_t*)(ws + WS_MISC + 2 * MiB))
#define P_Qb P_H
#define P_Ob (P_H + (size_t)NTOK * DM)
    volatile LAS unsigned* xst = (volatile LAS unsigned*)(shm + LDS_BYTES - 16);
    if (otid() == 0) { xst[0] = 0u; xst[1] = 0u; }
    __syncthreads();
    const XcdBarrier xb = xcd_barrier_post((unsigned*)(ws + WS_BAR), xst);
    prologue_cast(a); convert_layer(a, 0, shm); grid.sync();
#define GSYNC() xcd_barrier(xb)
    for (int ls = 0; ls < 16; ++ls) {
        const int l = ls >> 2, st = ls & 3, e = l >> 1, odd = l & 1;
        const bf16_t* A2; const bf16_t* W2; int K2; float scale2;
        if (st == 0 || st == 3) {
            EpiSwiGLU E; E.O = P_H;
            for (int rep = 0; rep < REP_FFN; ++rep) { run_gemm(shm, P_XB, P_W + (st == 0 ? W_FF1IN : W_FF2IN), NTOK, 5632, 1024, E); GSYNC(); }
            A2 = P_H; W2 = P_W + (st == 0 ? W_FF1OUT : W_FF2OUT); K2 = 2816; scale2 = 0.5f;
        } else {
            EpiBf16g E; int N; const bf16_t* Win; E.O = P_H;
            if (st == 1) { Win = P_W + W_MIXIN; E.scale = 1.0f; if (odd) { N = 2816; E.ldc = 2816; E.gelu_from = 1000; } else { N = 1536; E.ldc = 1536; E.gelu_from = 2; } }
            else { Win = P_W + W_Q; N = 1024; E.ldc = 1024; E.gelu_from = 1000; E.scale = 0.0625f; }
            for (int rep = 0; rep < REP_IN; ++rep) { run_gemm(shm, P_XB, Win, NTOK, N, 1024, E); if (rep + 1 < REP_IN) GSYNC(); }
            GSYNC();
            if (st == 1) {
                if (!odd) {
                    for (int rep = 0; rep < REP_AE; ++rep) { SK_E(even_core(a, e, shm);) GSYNC(); }
                    EpiPool EP; EP.O = P_XB; EP.scl = a->in[14] + (size_t)e * 512;
                    run_gemm(shm, P_LO, P_W + W_AUX1, NTOK, 512, 512, EP); GSYNC();
                } else {
                    for (int rep = 0; rep < REP_OPRE; ++rep) {
                        SK_O(odd_prep(a, e);) GSYNC();
                        { EpiBf16g EL; EL.O = P_LO; EL.ldc = 1536; EL.gelu_from = 1000; EL.scale = 1.0f; run_gemm(shm, P_AP, P_W + W_AUX1, NTOK, 1536, 256, EL); }
                        { EpiLru ER; ER.XC = P_XC; ER.b_a = a->in[35] + (size_t)e * 512; ER.b_x = a->in[37] + (size_t)e * 512; ER.lam = a->in[38] + (size_t)e * 512; ER.LGA = P_LGA; ER.BX = P_BX;
                          run_gemm(shm, P_XC, P_W + W_AUX2, NTOK, 1024, 512, ER); }
                        GSYNC();
                    }
                    for (int rep = 0; rep < REP_P1; ++rep) {
                        const int wave = otid() >> 6; LAS float* pl = (LAS float*)shm + (wave >> 1) * RW_PAIR;
                        for (int it0 = blockIdx.x * 4; it0 < 16 * NCH; it0 += gridDim.x * 4) { const int item = it0 + (wave >> 1);
                            if (wave & 1) rwkv_pass1_pair<1>(a, e, item / NCH, item % NCH, pl); else rwkv_pass1_pair<0>(a, e, item / NCH, item % NCH, pl); }
                        SK_O(lru_pass_a(a, blockIdx.x * 512 + otid(), gridDim.x * 512);)
                        GSYNC();
                    }
                    for (int rep = 0; rep < REP_CB; ++rep) {
                        if (blockIdx.x < 128) { SK_O(rwkv_combine(a, blockIdx.x, shm);) }
                        else { SK_O(lru_pass_c2(a, ((int)blockIdx.x - 128) * 512 + otid(), ((int)gridDim.x - 128) * 512);) }
                        GSYNC();
                    }
                    for (int rep = 0; rep < REP_P2; ++rep) {
                        const int wave = otid() >> 6; LAS float* pl = (LAS float*)shm + (wave >> 1) * RW_PAIR;
                        for (int it0 = blockIdx.x * 4; it0 < 16 * NCH; it0 += gridDim.x * 4) { const int item = it0 + (wave >> 1); rwkv_pass2_pair(a, e, item / NCH, item % NCH, wave & 1, pl); }
                        GSYNC();
                    }
                }
                A2 = P_XB; W2 = P_W + W_MIXOUT; K2 = 1024; scale2 = 1.0f;
            } else {
                for (int rep = 0; rep < REP_AT; ++rep) { SK_A(attn_phase(P_Qb, P_Kb, P_VT, P_Ob, shm);) GSYNC(); }
                A2 = P_Ob; W2 = P_W + W_O; K2 = 1024; scale2 = 1.0f;
            }
        }
        {
            EpiResid ER; ER.res = (const h16*)a->out; ER.out = (h16*)a->out; ER.MR = (const float*)(ws + WS_MR); ER.first = (ls == 0);
            ER.g = a->in[6] + (size_t)(ls > 0 ? ls - 1 : 0) * DM; ER.b = a->in[7] + (size_t)(ls > 0 ? ls - 1 : 0) * DM; ER.scale = scale2; run_gemm(shm, A2, W2, NTOK, 1024, K2, ER); }
        GSYNC();
        for (int rep = 0; rep < REP_SYNC; ++rep) GSYNC();
        if (st == 1) {
            if (blockIdx.x < 16) { EpiKV EK; EK.Kb = P_Kb; EK.VT = P_VT; run_gemm(shm, P_MEMB, P_W + W_KV, 512, 2048, 1024, EK, 16, (int)blockIdx.x); }
            else ln_phase(a->out, nullptr, P_XB, (float*)(ws + WS_MR), a->in[6] + (size_t)ls * DM, a->in[7] + (size_t)ls * DM, 16, (int)gridDim.x - 16);
        } else if (ls < 15) { for (int rep = 0; rep < REP_LN; ++rep) { ln_phase(a->out, nullptr, P_XB, (float*)(ws + WS_MR), a->in[6] + (size_t)ls * DM, a->in[7] + (size_t)ls * DM, 0, (int)gridDim.x); if (rep + 1 < REP_LN) GSYNC(); }
            if (st == 3) for (int rep = 0; rep < REP_CV; ++rep) { convert_layer(a, l + 1, shm); if (rep + 1 < REP_CV) GSYNC(); } }
        else { h16x8 zr[16][2]; ln_final_load((const h16*)a->out, zr); GSYNC(); ln_final_store(zr, a->out, a->in[6] + (size_t)ls * DM, a->in[7] + (size_t)ls * DM); }
        GSYNC();
    }
}

#undef a
#undef ws
#undef P_W
#undef P_XB
#undef P_H
#undef P_LO
#undef P_AP
#undef P_XC
#undef P_LGA
#undef P_BX
#undef P_Kb
#undef P_VT
#undef P_MEMB
#undef P_Qb
#undef P_Ob
extern "C" void kernel_launch(void* const* d_in, const int* in_sizes, int n_in, void* d_out, int out_size, void* d_ws, size_t ws_size, hipStream_t stream) {
    static int grid = 0;
    if (grid == 0) {
        if (n_in != 39 || out_size != NTOK * DM || ws_size < WS_END) { fprintf(stderr, "kernel_launch: unexpected shapes (n_in %d out %d ws %zu need %zu)\n", n_in, out_size, ws_size, (size_t)WS_END); grid = -1; return; }
        int dev = 0, cus = 0, per_cu = 0;
        hipGetDevice(&dev); hipDeviceGetAttribute(&cus, hipDeviceAttributeMultiprocessorCount, dev);
        if (hipFuncSetAttribute((const void*)mega_fwd, hipFuncAttributeMaxDynamicSharedMemorySize, LDS_BYTES) != hipSuccess) { fprintf(stderr, "kernel_launch: hipFuncSetAttribute failed\n"); }
        if (hipOccupancyMaxActiveBlocksPerMultiprocessor(&per_cu, (const void*)mega_fwd, 512, LDS_BYTES) != hipSuccess || per_cu < 1) { fprintf(stderr, "kernel_launch: occupancy query says %d\n", per_cu); per_cu = 1; }
        (void)hipGetLastError();
        grid = cus > 0 ? cus : 256;
    }
    if (grid < 0) return;
    if (hipMemsetAsync((char*)d_ws + WS_BAR, 0, 16384, stream) != hipSuccess) { fprintf(stderr, "kernel_launch: memset failed\n"); return; }
    Args a{};
    for (int i = 0; i < 39; ++i) a.in[i] = (const float*)d_in[i];
    a.out = (float*)d_out; a.ws = (unsigned char*)d_ws;
    void* args[] = {&a};
    hipError_t e = hipLaunchCooperativeKernel((const void*)mega_fwd, dim3(grid), dim3(512), args, LDS_BYTES, stream);
    if (e != hipSuccess) fprintf(stderr, "cooperative launch failed: %s (grid %d)\n", hipGetErrorString(e), grid);
}
```
